# Optimizing an MI355X kernel written in HIP

```python
import jax, jax.numpy as jnp
from jax import lax
import numpy as np

D_MODEL = 2048
BATCH = 2
SEQ = 8192
DEPTH = 2

GRID_W = 64
CTX_LEN = 256
N_MOD = 9
EPS = 1e-6
D_FF = 5632
ATTN_HEADS = 8
ATTN_KV_HEADS = 2
HEAD_DIM = 128
ATTN_WIDTH = ATTN_HEADS * HEAD_DIM
KV_WIDTH = ATTN_KV_HEADS * HEAD_DIM
WINDOW = 128
BLOCK = 128
ROPE_BASE = 10000.0
NEG_INF = -1e30
SCONV_WIDTH = 1024
SCONV_K = 3
SCONV_LEFT = 1
AB_IN_WIDTH = ATTN_WIDTH + 2 * KV_WIDTH + 3 * SCONV_WIDTH
AB_MIX_WIDTH = ATTN_WIDTH + SCONV_WIDTH
D_RNN = 2048
RNN_HEADS = 16
RNN_BLOCK = D_RNN // RNN_HEADS
RG_CONV_K = 4
RG_CONV_LEFT = 2
RG_C = 8.0
N_EVEN = (DEPTH + 1) // 2
N_ODD = DEPTH // 2

kernel_name = "hybrid_swa_shortconv_rglru_macaron_dit"


def rms_norm(x, g):
    xf = x.astype(jnp.float32)
    y = xf * lax.rsqrt(jnp.mean(xf * xf, axis=-1, keepdims=True) + EPS)
    return y.astype(x.dtype) * g


def modulate(x, g, shift, scale):
    return rms_norm(x, g) * (1 + scale) + shift


def swiglu(h, w_in, w_out):
    gate, up = jnp.split(h @ w_in, 2, axis=-1)
    return (jax.nn.silu(gate) * up) @ w_out


def depthwise_conv(x, w, left):
    k_width = w.shape[0]
    t = x.shape[1]
    xp = jnp.pad(x, ((0, 0), (left, k_width - 1 - left), (0, 0)))
    return sum(xp[:, k:k + t] * w[k] for k in range(k_width))


def axial_rope_tables(seq, dtype):
    rows = seq // GRID_W
    row = jnp.repeat(jnp.arange(rows), GRID_W)
    col = jnp.tile(jnp.arange(GRID_W), rows)
    n_freq = HEAD_DIM // 4
    inv_freq = ROPE_BASE ** (-jnp.arange(n_freq, dtype=jnp.float32) / n_freq)
    ang = jnp.stack([row, col], axis=-1).astype(jnp.float32)[..., None] * inv_freq
    return jnp.cos(ang).astype(dtype), jnp.sin(ang).astype(dtype)


def apply_axial_rope(x, cos, sin):
    xs = x.reshape(x.shape[:-1] + (2, 2, HEAD_DIM // 4))
    x1, x2 = xs[..., 0, :], xs[..., 1, :]
    c, s = cos[None, :, None], sin[None, :, None]
    out = jnp.stack([x1 * c - x2 * s, x2 * c + x1 * s], axis=-2)
    return out.reshape(x.shape)


def windowed_attention(q, k, v, kc, vc, sink):
    bsz, seq = q.shape[:2]
    nb = seq // BLOCK
    g = ATTN_HEADS // ATTN_KV_HEADS
    scale = HEAD_DIM ** -0.5
    qb = q.reshape(bsz, nb, BLOCK, ATTN_KV_HEADS, g, HEAD_DIM)

    def band(t):
        tp = jnp.pad(t, ((0, 0), (BLOCK, BLOCK), (0, 0), (0, 0)))
        tp = tp.reshape(bsz, nb + 2, BLOCK, ATTN_KV_HEADS, HEAD_DIM)
        return jnp.concatenate([tp[:, :-2], tp[:, 1:-1], tp[:, 2:]], axis=2)

    kb, vb = band(k), band(v)
    s_loc = jnp.einsum('bnqkgd,bnjkd->bnkgqj', qb, kb).astype(jnp.float32) * scale
    q_pos = jnp.arange(nb)[:, None] * BLOCK + jnp.arange(BLOCK)[None, :]
    k_pos = (jnp.arange(nb)[:, None] - 1) * BLOCK + jnp.arange(3 * BLOCK)[None, :]
    kp = k_pos[:, None, :]
    valid = (jnp.abs(q_pos[:, :, None] - kp) <= WINDOW) & (kp >= 0) & (kp < seq)
    s_loc = jnp.where(valid[None, :, None, None], s_loc, NEG_INF)
    s_ctx = jnp.einsum('bnqkgd,bjkd->bnkgqj', qb, kc).astype(jnp.float32) * scale
    sink_col = jnp.broadcast_to(
        sink.astype(jnp.float32).reshape(ATTN_KV_HEADS, g)[None, None, :, :, None, None],
        s_loc.shape[:-1] + (1,))
    p = jax.nn.softmax(jnp.concatenate([s_loc, s_ctx, sink_col], axis=-1), axis=-1).astype(v.dtype)
    n_loc = 3 * BLOCK
    n_ctx = kc.shape[1]
    o = (jnp.einsum('bnkgqj,bnjkd->bnqkgd', p[..., :n_loc], vb)
         + jnp.einsum('bnkgqj,bjkd->bnqkgd', p[..., n_loc:n_loc + n_ctx], vc))
    return o.reshape(bsz, seq, ATTN_WIDTH)


def context_attention(qc, kc, vc, sink):
    bsz, n_ctx = qc.shape[:2]
    g = ATTN_HEADS // ATTN_KV_HEADS
    qg = qc.reshape(bsz, n_ctx, ATTN_KV_HEADS, g, HEAD_DIM)
    s = jnp.einsum('bqkgd,bjkd->bkgqj', qg, kc).astype(jnp.float32) * (HEAD_DIM ** -0.5)
    sink_col = jnp.broadcast_to(
        sink.astype(jnp.float32).reshape(ATTN_KV_HEADS, g)[None, :, :, None, None], s.shape[:-1] + (1,))
    p = jax.nn.softmax(jnp.concatenate([s, sink_col], axis=-1), axis=-1)[..., :n_ctx].astype(vc.dtype)
    o = jnp.einsum('bkgqj,bjkd->bqkgd', p, vc)
    return o.reshape(bsz, n_ctx, ATTN_WIDTH)


def attn_conv_mixer(h, hc, w_in, w_out, sink, conv_w, cos, sin, need_ctx):
    cuts = [ATTN_WIDTH, ATTN_WIDTH + KV_WIDTH, ATTN_WIDTH + 2 * KV_WIDTH,
            ATTN_WIDTH + 2 * KV_WIDTH + SCONV_WIDTH, ATTN_WIDTH + 2 * KV_WIDTH + 2 * SCONV_WIDTH]

    def project(t):
        bsz, n = t.shape[:2]
        q, k, v, bg, cg, u = jnp.split(t @ w_in, cuts, axis=-1)
        return (q.reshape(bsz, n, ATTN_HEADS, HEAD_DIM), k.reshape(bsz, n, ATTN_KV_HEADS, HEAD_DIM),
                v.reshape(bsz, n, ATTN_KV_HEADS, HEAD_DIM), bg, cg, u)

    q, k, v, bg, cg, u = project(h)
    qc, kc, vc, bgc, cgc, uc = project(hc)
    q = apply_axial_rope(q, cos, sin)
    k = apply_axial_rope(k, cos, sin)
    attn = windowed_attention(q, k, v, kc, vc, sink)
    conv = bg * depthwise_conv(cg * u, conv_w, SCONV_LEFT)
    out = jnp.concatenate([attn, conv], axis=-1) @ w_out
    if not need_ctx:
        return out, None
    attn_c = context_attention(qc, kc, vc, sink)
    conv_c = bgc * depthwise_conv(cgc * uc, conv_w, SCONV_LEFT)
    out_c = jnp.concatenate([attn_c, conv_c], axis=-1) @ w_out
    return out, out_c


def linear_scan(a, b, h0, reverse):
    if reverse:
        a, b = jnp.flip(a, axis=1), jnp.flip(b, axis=1)
    b = b.at[:, 0].add(a[:, 0] * h0)

    def combine(lhs, rhs):
        a1, b1 = lhs
        a2, b2 = rhs
        return a1 * a2, a2 * b1 + b2

    _, h = lax.associative_scan(combine, (a, b), axis=1)
    if reverse:
        h = jnp.flip(h, axis=1)
    return h


def rglru_direction(u, h0, w_a, b_a, w_x, b_x, lam, reverse):
    bsz, t = u.shape[:2]
    ub = u.reshape(bsz, t, RNN_HEADS, RNN_BLOCK)
    r = jax.nn.sigmoid((jnp.einsum('bthi,hij->bthj', ub, w_a).reshape(bsz, t, D_RNN) + b_a).astype(jnp.float32))
    i = jax.nn.sigmoid((jnp.einsum('bthi,hij->bthj', ub, w_x).reshape(bsz, t, D_RNN) + b_x).astype(jnp.float32))
    log_a = -RG_C * r * jax.nn.softplus(-lam.astype(jnp.float32))
    a = jnp.exp(log_a)
    b = jnp.sqrt(-jnp.expm1(2 * log_a)) * i * u.astype(jnp.float32)
    return linear_scan(a, b, h0, reverse)


def rglru_mixer(h, hc, w_in, conv_w, conv_b, w_a, b_a, w_x, b_x, lam, w_out, need_ctx):
    gate, u = jnp.split(h @ w_in, 2, axis=-1)
    gate_c, u_c = jnp.split(hc @ w_in, 2, axis=-1)
    u = depthwise_conv(u, conv_w, RG_CONV_LEFT) + conv_b
    u_c = depthwise_conv(u_c, conv_w, RG_CONV_LEFT) + conv_b
    h_zero = jnp.zeros((hc.shape[0], D_RNN), jnp.float32)
    y = 0.0
    y_c = 0.0
    for d, reverse in enumerate((False, True)):
        hs_c = rglru_direction(u_c, h_zero, w_a[d], b_a[d], w_x[d], b_x[d], lam[d], reverse)
        h_last = hs_c[:, 0] if reverse else hs_c[:, -1]
        y = y + rglru_direction(u, h_last, w_a[d], b_a[d], w_x[d], b_x[d], lam[d], reverse)
        y_c = y_c + hs_c
    out = (y.astype(h.dtype) * jax.nn.gelu(gate)) @ w_out
    if not need_ctx:
        return out, None
    out_c = (y_c.astype(hc.dtype) * jax.nn.gelu(gate_c)) @ w_out
    return out, out_c


def setup_inputs(seed: int = 0) -> dict:
    key = jax.random.key(seed)
    ks = iter(jax.random.split(key, 32))

    def nrm(shape, scale):
        return jax.random.normal(next(ks), shape, jnp.float32) * scale

    d = D_MODEL
    u = jax.random.uniform(next(ks), (N_ODD, 2, D_RNN), jnp.float32, 0.9, 0.999)
    s = u ** (1.0 / RG_C)
    return {
        "x": nrm((BATCH, SEQ, d), 1.0),
        "c": nrm((BATCH, d), 1.0),
        "ctx": nrm((BATCH, CTX_LEN, d), 1.0),
        "c_ctx": nrm((d,), 1.0),
        "w_mod": nrm((DEPTH, d, N_MOD * d), 0.5 * d ** -0.5),
        "b_mod": nrm((DEPTH, N_MOD * d), 0.02),
        "norm_ffn1": 1.0 + nrm((DEPTH, d), 0.1),
        "norm_mix": 1.0 + nrm((DEPTH, d), 0.1),
        "norm_ffn2": 1.0 + nrm((DEPTH, d), 0.1),
        "ffn1_w_in": nrm((DEPTH, d, 2 * D_FF), d ** -0.5),
        "ffn1_w_out": nrm((DEPTH, D_FF, d), D_FF ** -0.5),
        "ffn2_w_in": nrm((DEPTH, d, 2 * D_FF), d ** -0.5),
        "ffn2_w_out": nrm((DEPTH, D_FF, d), D_FF ** -0.5),
        "ab_w_in": nrm((N_EVEN, d, AB_IN_WIDTH), d ** -0.5),
        "ab_w_out": nrm((N_EVEN, AB_MIX_WIDTH, d), AB_MIX_WIDTH ** -0.5),
        "ab_sink": nrm((N_EVEN, ATTN_HEADS), 0.5),
        "ab_conv_w": nrm((N_EVEN, SCONV_K, SCONV_WIDTH), SCONV_K ** -0.5),
        "rg_w_in": nrm((N_ODD, d, 2 * D_RNN), d ** -0.5),
        "rg_conv_w": nrm((N_ODD, RG_CONV_K, D_RNN), RG_CONV_K ** -0.5),
        "rg_conv_b": nrm((N_ODD, D_RNN), 0.02),
        "rg_w_a": nrm((N_ODD, 2, RNN_HEADS, RNN_BLOCK, RNN_BLOCK), RNN_BLOCK ** -0.5),
        "rg_b_a": nrm((N_ODD, 2, D_RNN), 0.02),
        "rg_w_x": nrm((N_ODD, 2, RNN_HEADS, RNN_BLOCK, RNN_BLOCK), RNN_BLOCK ** -0.5),
        "rg_b_x": nrm((N_ODD, 2, D_RNN), 0.02),
        "rg_lambda": jnp.log(s) - jnp.log1p(-s),
        "rg_w_out": nrm((N_ODD, D_RNN, d), D_RNN ** -0.5),
        "final_norm": 1.0 + nrm((d,), 0.1),
    }


def reference(x, c, ctx, c_ctx, w_mod, b_mod, norm_ffn1, norm_mix, norm_ffn2,
              ffn1_w_in, ffn1_w_out, ffn2_w_in, ffn2_w_out,
              ab_w_in, ab_w_out, ab_sink, ab_conv_w,
              rg_w_in, rg_conv_w, rg_conv_b, rg_w_a, rg_b_a, rg_w_x, rg_b_x, rg_lambda, rg_w_out,
              final_norm):
    seq = x.shape[1]
    cos, sin = axial_rope_tables(seq, x.dtype)
    xc = ctx
    for l in range(DEPTH):
        need_ctx = l < DEPTH - 1
        m = jnp.split((jax.nn.silu(c) @ w_mod[l] + b_mod[l])[:, None, :], N_MOD, axis=-1)
        mc = jnp.split((jax.nn.silu(c_ctx) @ w_mod[l] + b_mod[l])[None, None, :], N_MOD, axis=-1)
        x = x + 0.5 * m[2] * swiglu(modulate(x, norm_ffn1[l], m[0], m[1]), ffn1_w_in[l], ffn1_w_out[l])
        xc = xc + 0.5 * mc[2] * swiglu(modulate(xc, norm_ffn1[l], mc[0], mc[1]), ffn1_w_in[l], ffn1_w_out[l])
        h = modulate(x, norm_mix[l], m[3], m[4])
        hc = modulate(xc, norm_mix[l], mc[3], mc[4])
        j = l // 2
        if l % 2 == 0:
            o, oc = attn_conv_mixer(h, hc, ab_w_in[j], ab_w_out[j], ab_sink[j], ab_conv_w[j], cos, sin, need_ctx)
        else:
            o, oc = rglru_mixer(h, hc, rg_w_in[j], rg_conv_w[j], rg_conv_b[j], rg_w_a[j], rg_b_a[j],
                                rg_w_x[j], rg_b_x[j], rg_lambda[j], rg_w_out[j], need_ctx)
        x = x + m[5] * o
        x = x + 0.5 * m[8] * swiglu(modulate(x, norm_ffn2[l], m[6], m[7]), ffn2_w_in[l], ffn2_w_out[l])
        if need_ctx:
            xc = xc + mc[5] * oc
            xc = xc + 0.5 * mc[8] * swiglu(modulate(xc, norm_ffn2[l], mc[6], mc[7]), ffn2_w_in[l], ffn2_w_out[l])
    return rms_norm(x, final_norm)
```

```cpp
#include <hip/hip_runtime.h>
#include <cstdio>
#include <cstdint>
namespace pg8 {
#define PG8_LAS __attribute__((address_space(3)))
typedef unsigned short bf16_t;
typedef short bf16x8 __attribute__((ext_vector_type(8)));
typedef float f32x4 __attribute__((ext_vector_type(4)));
typedef unsigned u32x4 __attribute__((ext_vector_type(4)));
constexpr int BM = 256, BK = 64, HALF = 128, HTB = HALF * BK * 2  , STAGE_BYTES = 8 * HTB, NXCD = 8, WGM = 8;

__host__ __device__ __forceinline__ int lds_byte(int r, int c) { const int st = (r >> 4) * 2 + (c >> 5), rr = r & 15, cc = c & 31, ob = rr * 64 + cc * 2; return st * 1024 + (ob ^ (((ob >> 9) & 1) << 5)); }
__host__ __device__ __forceinline__ void stage_rc(int b, int& R, int& C) { const int st = b / 1024, sb = b % 1024, swz = sb ^ (((sb >> 9) & 1) << 5); R = (st >> 1) * 16 + swz / 64; C = (st & 1) * 32 + (swz % 64) / 2; }
__host__ __device__ __forceinline__ int perm32(int rho) { const int n = rho >> 4, i = rho & 15; return 8 * (i >> 2) + 4 * n + (i & 3); }

struct Unit { int pm, pn; };
struct Gemm { const bf16_t* A; const bf16_t* Bt; int M, N, K; };

template <int NM_, int NN_> struct StaticOrderC {
    static constexpr int nM = NM_, nN = NN_, nwg = NM_ * NN_;
    int G, c;
    __host__ __device__ void init(int G_, int c_) { G = G_; c = c_; }
    __host__ __device__ bool next(int i, Unit& u) const {
        const int L = i * G + c; if (L >= nwg) return false;
        int wgid = L; { constexpr int q = nwg / NXCD, r = nwg % NXCD; const int xcd = wgid % NXCD, off = wgid / NXCD; wgid = (xcd < r ? xcd * (q + 1) : r * (q + 1) + (xcd - r) * q) + off; }
        constexpr int nig = WGM * nN; const int gid = wgid / nig, fm = gid * WGM, gsz = (nM - fm) < WGM ? (nM - fm) : WGM;
        const int w = wgid - gid * nig;
        if (gsz == WGM) { u.pm = fm + (w % WGM); u.pn = w / WGM; } else { u.pm = fm + (w % gsz); u.pn = w / gsz; }
        return true;
    }
    __device__ __forceinline__ void a_ready(const Unit&) const {}
    __device__ __forceinline__ void done(const Unit&) const {}
};


__device__ __forceinline__ unsigned cvt_pk_bf16(float lo, float hi) { unsigned r; asm volatile("v_cvt_pk_bf16_f32 %0, %1, %2" : "=v"(r) : "v"(lo), "v"(hi)); return r; }
constexpr int ROWS_LAT = 16384, D_MODEL = 2048;

struct EpiBf16 {
    static constexpr bool PERM = true, AFTER_DRAIN = false;
    bf16_t* O; int ldc;
    __device__ __forceinline__ void operator()(const f32x4 (&acc)[2][2][4][2], const Unit& u, int wr, int wc, int fr, int fq) const {
        const int row0 = u.pm * BM + wr * 64 + fr; const int col0 = u.pn * BM + wc * 32 + 8 * fq;
#pragma unroll
        for (int ai = 0; ai < 2; ++ai)
#pragma unroll
            for (int m = 0; m < 4; ++m) { bf16_t* rowp = O + (size_t)(row0 + ai * HALF + m * 16) * ldc + col0;
#pragma unroll
                for (int bj = 0; bj < 2; ++bj) { const f32x4 v0 = acc[ai][bj][m][0], v1 = acc[ai][bj][m][1];
                    u32x4 w; w.x = cvt_pk_bf16(v0[0], v0[1]); w.y = cvt_pk_bf16(v0[2], v0[3]); w.z = cvt_pk_bf16(v1[0], v1[1]); w.w = cvt_pk_bf16(v1[2], v1[3]);
                    *(u32x4*)(rowp + bj * HALF) = w; } }
    }
};
__device__ __forceinline__ float silu_f(float g) { return g * __builtin_amdgcn_rcpf(1.0f + __expf(-g)); }
struct EpiSwiGLU {
    static constexpr bool PERM = true, AFTER_DRAIN = false;
    bf16_t* H; int ldh;
    __device__ __forceinline__ void operator()(const f32x4 (&acc)[2][2][4][2], const Unit& u, int wr, int wc, int fr, int fq) const {
        const int row0 = u.pm * BM + wr * 64 + fr; const int col0 = u.pn * HALF + wc * 32 + 8 * fq;
#pragma unroll
        for (int ai = 0; ai < 2; ++ai)
#pragma unroll
            for (int m = 0; m < 4; ++m) { bf16_t* rowp = H + (size_t)(row0 + ai * HALF + m * 16) * ldh + col0;
                const f32x4 g0 = acc[ai][0][m][0], g1 = acc[ai][0][m][1], u0 = acc[ai][1][m][0], u1 = acc[ai][1][m][1];
                u32x4 w;
                w.x = cvt_pk_bf16(silu_f(g0[0]) * u0[0], silu_f(g0[1]) * u0[1]); w.y = cvt_pk_bf16(silu_f(g0[2]) * u0[2], silu_f(g0[3]) * u0[3]);
                w.z = cvt_pk_bf16(silu_f(g1[0]) * u1[0], silu_f(g1[1]) * u1[1]); w.w = cvt_pk_bf16(silu_f(g1[2]) * u1[2], silu_f(g1[3]) * u1[3]);
                *(u32x4*)rowp = w; }
    }
};
struct EpiResid {
    static constexpr bool PERM = false, AFTER_DRAIN = false;
    const float* resLat; const float* resCtx; float* X; const float* gate; int gstride; float gscale;
    __device__ __forceinline__ void operator()(const f32x4 (&acc)[2][2][4][2], const Unit& u, int wr, int wc, int fr, int fq) const {
        const int v = u.pm < 32 ? 0 : (u.pm < 64 ? 1 : 2);
        const float* gv = gate + (size_t)v * gstride;
        const int col0 = u.pn * BM + wc * 32 + 4 * fq;
        f32x4 gvec[2][2];
#pragma unroll
        for (int bj = 0; bj < 2; ++bj)
#pragma unroll
            for (int n = 0; n < 2; ++n) gvec[bj][n] = *(const f32x4*)(gv + col0 + bj * HALF + n * 16) * gscale;
#pragma unroll
        for (int ai = 0; ai < 2; ++ai)
#pragma unroll
            for (int m = 0; m < 4; ++m) { const int row = u.pm * BM + ai * HALF + wr * 64 + m * 16 + fr;
                const float* rp = (row < ROWS_LAT) ? resLat + (size_t)row * D_MODEL : resCtx + (size_t)(row - ROWS_LAT) * D_MODEL;
                float* xp = X + (size_t)row * D_MODEL;
#pragma unroll
                for (int bj = 0; bj < 2; ++bj)
#pragma unroll
                    for (int n = 0; n < 2; ++n) { const int c = col0 + bj * HALF + n * 16; const f32x4 r = *(const f32x4*)(rp + c);
                        *(f32x4*)(xp + c) = r + gvec[bj][n] * acc[ai][bj][m][n]; }
                if (m & 1) asm volatile("" ::: "memory"); }
    }
};
template <class Epi, class Sched, bool ALIGN_EPI = false, bool SP2 = false>
__device__ __forceinline__ void gemm_phase(PG8_LAS unsigned char* lds, const Gemm g, const Sched& S, const Epi& E) {
    const int tid = threadIdx.x, wid = __builtin_amdgcn_readfirstlane(tid >> 6), lane = tid & 63, wr = wid >> 2, wc = wid & 3, fr = lane & 15, fq = lane >> 4;
    const int K = g.K, nt = K / BK;
    unsigned voffA[2], voffB[2];
#pragma unroll
    for (int i = 0; i < 2; ++i) { int R, C; stage_rc(tid * 16 + i * 8192, R, C); const int Rb = Epi::PERM ? ((R & ~31) + perm32(R & 31)) : R;
        voffA[i] = (unsigned)(R * K + C) * 2u; voffB[i] = (unsigned)(Rb * K + C) * 2u; }
    const size_t kstep = (size_t)(BK * 2);
    const size_t hstep = (size_t)HALF * K * 2;
    const size_t tstep = 2 * hstep;
    const unsigned ldsw = (unsigned)wid * 1024u;
    const int aoff = lds_byte(wr * 64 + fr, fq * 8), boff = lds_byte(wc * 32 + fr, fq * 8);
#define PG8_SA(b, h) (((b) * 2 + (h)) * HTB)
#define PG8_SB(b, h) ((4 + (b) * 2 + (h)) * HTB)
#define PG8_STAGE(bufoff, gbase, voff) do { _Pragma("unroll") for (int _i = 0; _i < 2; ++_i) \
        __builtin_amdgcn_global_load_lds((const unsigned*)((const char*)(gbase) + (voff)[_i]), (PG8_LAS unsigned*)(lds + (bufoff) + ldsw + _i * 8192), 16, 0, 0); } while (0)
#define PG8_LDA(dst, b, h) do { _Pragma("unroll") for (int m = 0; m < 4; ++m) _Pragma("unroll") for (int k = 0; k < 2; ++k) dst[m][k] = *(const PG8_LAS bf16x8*)(lds + PG8_SA(b, h) + aoff + m * 2048 + k * 1024); } while (0)
#define PG8_LDB(dst, b, h) do { _Pragma("unroll") for (int n = 0; n < 2; ++n) _Pragma("unroll") for (int k = 0; k < 2; ++k) dst[n][k] = *(const PG8_LAS bf16x8*)(lds + PG8_SB(b, h) + boff + n * 2048 + k * 1024); } while (0)
#define PG8_MMA(ai, bj, At, Bt) do { __builtin_amdgcn_s_setprio(1); _Pragma("unroll") for (int m = 0; m < 4; ++m) _Pragma("unroll") for (int n = 0; n < 2; ++n) _Pragma("unroll") for (int k = 0; k < 2; ++k) \
        acc[ai][bj][m][n] = __builtin_amdgcn_mfma_f32_16x16x32_bf16(Bt[n][k], At[m][k], acc[ai][bj][m][n], 0, 0, 0); __builtin_amdgcn_s_setprio(0); } while (0)
#define PG8_WAIT_V(n) asm volatile("s_waitcnt vmcnt(" #n ")" ::: "memory")
#define PG8_WAIT_L(n) asm volatile("s_waitcnt lgkmcnt(" #n ")" ::: "memory")
#define PG8_BAR __builtin_amdgcn_s_barrier()
#define PG8_SCHED __builtin_amdgcn_sched_barrier(0)
    Unit cur, nxt; int ui = 0;
    if (!S.next(0, cur)) return;
    f32x4 acc[2][2][4][2];
#pragma unroll
    for (int a = 0; a < 2; ++a)
#pragma unroll
        for (int b = 0; b < 2; ++b)
#pragma unroll
            for (int m = 0; m < 4; ++m)
#pragma unroll
                for (int n = 0; n < 2; ++n) acc[a][b][m][n] = (f32x4){0.f, 0.f, 0.f, 0.f};
    bf16x8 At[4][2], B0[2][2], B1[2][2];
    const char* cA = (const char*)g.A + (size_t)cur.pm * tstep; const char* cB = (const char*)g.Bt + (size_t)cur.pn * tstep;
    S.a_ready(cur);
    if constexpr (SP2) {
        PG8_STAGE(PG8_SB(0, 0), cB, voffB); PG8_STAGE(PG8_SB(0, 1), cB + hstep, voffB); PG8_STAGE(PG8_SA(0, 0), cA, voffA); PG8_STAGE(PG8_SA(0, 1), cA + hstep, voffA);
        if (wr == 1) PG8_BAR;
        PG8_WAIT_V(2); PG8_BAR;
        PG8_STAGE(PG8_SB(1, 0), cB + kstep, voffB); PG8_STAGE(PG8_SA(1, 0), cA + kstep, voffA); PG8_STAGE(PG8_SB(1, 1), cB + hstep + kstep, voffB);
        PG8_WAIT_V(6); PG8_BAR;
    } else {
        PG8_STAGE(PG8_SB(0, 0), cB, voffB); PG8_STAGE(PG8_SA(0, 0), cA, voffA); PG8_STAGE(PG8_SB(0, 1), cB + hstep, voffB); PG8_STAGE(PG8_SA(0, 1), cA + hstep, voffA);
        if (wr == 1) PG8_BAR;
        PG8_WAIT_V(4); PG8_BAR;
        PG8_STAGE(PG8_SB(1, 0), cB + kstep, voffB); PG8_STAGE(PG8_SA(1, 0), cA + kstep, voffA); PG8_STAGE(PG8_SB(1, 1), cB + hstep + kstep, voffB);
        PG8_WAIT_V(6); PG8_BAR;
    }
    for (;;) {
        const bool has_next = S.next(ui + 1, nxt);
        const char* nA = has_next ? (const char*)g.A + (size_t)nxt.pm * tstep : cA; const char* nB = has_next ? (const char*)g.Bt + (size_t)nxt.pn * tstep : cB;
        for (int t = 0; t < nt; t += 2) {
            const bool last = (t == nt - 2);
            const char* a1 = cA + (size_t)(t + 1) * kstep;
            const char* a2 = last ? nA : cA + (size_t)(t + 2) * kstep; const char* b2 = last ? nB : cB + (size_t)(t + 2) * kstep;
            const char* a3 = a2 + kstep; const char* b3 = b2 + kstep;
            if (last && has_next) S.a_ready(nxt);
            if constexpr (SP2) {
            PG8_LDB(B0, 0, 0); PG8_LDB(B1, 0, 1); PG8_SCHED; PG8_LDA(At, 0, 0); PG8_STAGE(PG8_SA(1, 1), a1 + hstep, voffA);
            PG8_WAIT_V(8); PG8_WAIT_L(0); PG8_BAR; PG8_MMA(0, 0, At, B0); PG8_MMA(0, 1, At, B1); PG8_BAR; PG8_SCHED;
            PG8_LDA(At, 0, 1); PG8_STAGE(PG8_SB(0, 0), b2, voffB); PG8_STAGE(PG8_SB(0, 1), b2 + hstep, voffB); PG8_STAGE(PG8_SA(0, 0), a2, voffA);
            PG8_WAIT_V(8); PG8_WAIT_L(0); PG8_BAR; PG8_MMA(1, 0, At, B0); PG8_MMA(1, 1, At, B1); PG8_BAR; PG8_SCHED;
            PG8_LDB(B0, 1, 0); PG8_LDB(B1, 1, 1); PG8_SCHED; PG8_LDA(At, 1, 0); PG8_STAGE(PG8_SA(0, 1), a2 + hstep, voffA);
            PG8_WAIT_V(8); PG8_WAIT_L(0); PG8_BAR; PG8_MMA(0, 0, At, B0); PG8_MMA(0, 1, At, B1); PG8_BAR; PG8_SCHED;
            PG8_LDA(At, 1, 1); PG8_STAGE(PG8_SB(1, 0), b3, voffB); PG8_STAGE(PG8_SB(1, 1), b3 + hstep, voffB); PG8_STAGE(PG8_SA(1, 0), a3, voffA);
            PG8_WAIT_V(8); PG8_WAIT_L(0); PG8_BAR; PG8_MMA(1, 0, At, B0); PG8_MMA(1, 1, At, B1); PG8_BAR; PG8_SCHED;
            } else {
            PG8_LDB(B0, 0, 0); PG8_SCHED; PG8_LDA(At, 0, 0); PG8_STAGE(PG8_SA(1, 1), a1 + hstep, voffA);
            PG8_WAIT_L(8); PG8_BAR; PG8_WAIT_L(0); PG8_MMA(0, 0, At, B0); PG8_BAR; PG8_SCHED;
            PG8_LDB(B1, 0, 1); PG8_STAGE(PG8_SB(0, 0), b2, voffB);
            PG8_BAR; PG8_WAIT_L(0); PG8_MMA(0, 1, At, B1); PG8_BAR;
            PG8_LDA(At, 0, 1); PG8_STAGE(PG8_SA(0, 0), a2, voffA);
            PG8_BAR; PG8_WAIT_L(0); PG8_MMA(1, 0, At, B0); PG8_BAR; PG8_SCHED;
            PG8_STAGE(PG8_SB(0, 1), b2 + hstep, voffB);
            PG8_WAIT_V(6); PG8_BAR; PG8_MMA(1, 1, At, B1); PG8_BAR;
            PG8_LDB(B0, 1, 0); PG8_SCHED; PG8_LDA(At, 1, 0); PG8_STAGE(PG8_SA(0, 1), a2 + hstep, voffA);
            PG8_WAIT_L(8); PG8_BAR; PG8_WAIT_L(0); PG8_MMA(0, 0, At, B0); PG8_BAR; PG8_SCHED;
            PG8_LDB(B1, 1, 1); PG8_STAGE(PG8_SB(1, 0), b3, voffB);
            PG8_BAR; PG8_WAIT_L(0); PG8_MMA(0, 1, At, B1); PG8_BAR;
            PG8_LDA(At, 1, 1); PG8_STAGE(PG8_SA(1, 0), a3, voffA);
            PG8_BAR; PG8_WAIT_L(0); PG8_MMA(1, 0, At, B0); PG8_BAR; PG8_SCHED;
            PG8_STAGE(PG8_SB(1, 1), b3 + hstep, voffB);
            PG8_WAIT_V(6); PG8_BAR; PG8_MMA(1, 1, At, B1); PG8_BAR;
            }
        }
        if constexpr (ALIGN_EPI) { if (wr == 0) PG8_BAR; }
        if constexpr (!Epi::AFTER_DRAIN) { E(acc, cur, wr, wc, fr, fq); S.done(cur); }
        if (!has_next) break;
#pragma unroll
        for (int a = 0; a < 2; ++a)
#pragma unroll
            for (int b = 0; b < 2; ++b)
#pragma unroll
                for (int m = 0; m < 4; ++m)
#pragma unroll
                    for (int n = 0; n < 2; ++n) acc[a][b][m][n] = (f32x4){0.f, 0.f, 0.f, 0.f};
        cur = nxt; cA = nA; cB = nB; ++ui;
        if constexpr (ALIGN_EPI) { if (wr == 1) PG8_BAR; }
    }
    PG8_WAIT_V(0);
    if constexpr (!ALIGN_EPI) { if (wr == 0) PG8_BAR; }
    PG8_BAR;
    if constexpr (Epi::AFTER_DRAIN) { E.fused(acc, cur, wr, wc, fr, fq, lds, wid, lane); S.done(cur); }
#undef PG8_SA
#undef PG8_SB
#undef PG8_STAGE
#undef PG8_LDA
#undef PG8_LDB
#undef PG8_MMA
#undef PG8_WAIT_V
#undef PG8_WAIT_L
#undef PG8_BAR
#undef PG8_SCHED
}
}
#define GAS __attribute__((address_space(1)))
#define LAS __attribute__((address_space(3)))
typedef unsigned short bf16;
typedef unsigned v4u __attribute__((ext_vector_type(4)));
typedef float f32x4 __attribute__((ext_vector_type(4)));
typedef short bf16x8 __attribute__((ext_vector_type(8)));
typedef GAS unsigned gu32;
typedef GAS unsigned long long gu64;
#define RLX_AGENT __ATOMIC_RELAXED, __HIP_MEMORY_SCOPE_AGENT
#define LDS_WAIT() asm volatile("s_waitcnt lgkmcnt(0)" ::: "memory")
#define VM_WAIT() asm volatile("s_waitcnt vmcnt(0)" ::: "memory")
__device__ __forceinline__ unsigned long long rt() { return __builtin_amdgcn_s_memrealtime(); }
__device__ __forceinline__ unsigned f2bf(float f) { unsigned u = __builtin_bit_cast(unsigned, f); return (u + 0x7fffu + ((u >> 16) & 1u)) >> 16; }
__device__ __forceinline__ unsigned pk2(float lo, float hi) { return f2bf(lo) | (f2bf(hi) << 16); }

#define XB_TMO      128
#define XB_XCNT(j)  (256  + 64 * (j))
#define XB_XSUB(j)  (1280 + 64 * (j))
#define XB_XGEN(j)  (2304 + 64 * (j))
#define XB_TOP      3328
#define XB_TOPGEN   3392
#define XCD_BAR_WORDS 3456
#define XB_SPIN_CAP (1u << 18)

__device__ __forceinline__ unsigned xb_ld(unsigned* p)              { return __hip_atomic_load(p, __ATOMIC_RELAXED, __HIP_MEMORY_SCOPE_AGENT); }
__device__ __forceinline__ unsigned xb_add(unsigned* p, unsigned v) { return __hip_atomic_fetch_add(p, v, __ATOMIC_RELAXED, __HIP_MEMORY_SCOPE_AGENT); }
__device__ __forceinline__ unsigned xb_xcc_id() { return (unsigned)__builtin_amdgcn_s_getreg((3 << 11) | 20) & 0xFu; }
#define XB_SPIN(cond, bar) do { unsigned _sp = 0; while (cond) { __builtin_amdgcn_s_sleep(1); \
    if ((++_sp & 255u) == 0u) { if (xb_ld(&(bar)[XB_TMO])) break; if (_sp > XB_SPIN_CAP) { atomicAdd(&(bar)[XB_TMO], 1u); break; } } } } while (0)

struct XcdBarrier {
    unsigned* bar; unsigned x;
    volatile LAS unsigned* st;
};

__device__ __forceinline__ XcdBarrier xcd_barrier_post(unsigned* bar, volatile LAS unsigned* st) {
    XcdBarrier b; b.bar = bar; b.x = xb_xcc_id(); b.st = st;
    if (threadIdx.x == 0) (void)xb_add(&bar[XB_XCNT(b.x)], 1u);
    return b;
}
__device__ __forceinline__ void xcd_barrier_complete(unsigned* bar, unsigned x, unsigned& nloc, unsigned& nx) {
    const unsigned G = gridDim.x * gridDim.y * gridDim.z;
    unsigned sum, cnt, mine, sp = 0u;
    for (;;) {
        sum = 0u; cnt = 0u; mine = 0u;
#pragma unroll
        for (unsigned j = 0; j < 16; ++j) { const unsigned c = xb_ld(&bar[XB_XCNT(j)]); sum += c; cnt += (c > 0u) ? 1u : 0u; mine = (j == x) ? c : mine; }
        if (sum == G) break;
        __builtin_amdgcn_s_sleep(1);
        if ((++sp & 255u) == 0u) { if (xb_ld(&bar[XB_TMO])) break; if (sp > XB_SPIN_CAP) { atomicAdd(&bar[XB_TMO], 1u); break; } }
    }
    nloc = mine > 0u ? mine : 1u; nx = cnt > 0u ? cnt : 1u;
}

__device__ __forceinline__ void xcd_barrier(const XcdBarrier& b) {
    asm volatile("s_waitcnt vmcnt(0)" ::: "memory");
    __syncthreads();
    if (threadIdx.x == 0) {
        unsigned* bar = b.bar;
        __builtin_amdgcn_s_waitcnt(0);
        unsigned nloc = b.st[0], nx = b.st[1];
        if (nloc == 0u) { xcd_barrier_complete(bar, b.x, nloc, nx); b.st[0] = nloc; b.st[1] = nx; }
        const unsigned old = xb_add(&bar[XB_XSUB(b.x)], 1u);
        const unsigned gen = old / nloc;
        if (old + 1u == (gen + 1u) * nloc) {
            __builtin_amdgcn_fence(__ATOMIC_RELEASE, "agent");
            asm volatile("s_waitcnt vmcnt(0)" ::: "memory");
            const unsigned og = xb_add(&bar[XB_TOP], 1u);
            const unsigned tg = og / nx;
            if (og + 1u == (tg + 1u) * nx) xb_add(&bar[XB_TOPGEN], 1u);
            else XB_SPIN(xb_ld(&bar[XB_TOPGEN]) == tg, bar);
            __builtin_amdgcn_fence(__ATOMIC_ACQUIRE, "agent");
            xb_add(&bar[XB_XGEN(b.x)], 1u);
            asm volatile("s_waitcnt vmcnt(0)" ::: "memory");
        } else {
            XB_SPIN(xb_ld(&bar[XB_XGEN(b.x)]) == gen, bar);
            __builtin_amdgcn_fence(__ATOMIC_ACQUIRE, "agent");
            asm volatile("s_waitcnt vmcnt(0)" ::: "memory");
        }
    }
    __syncthreads();
}

constexpr int NWAVES = 8, NTHR = 512;
constexpr int DM = 2048, DFF = 5632, SEQ = 8192, CTXL = 256, NB = 2;
constexpr int NLAT = NB * SEQ, NCTXR = NB * CTXL, MROWS = NLAT + NCTXR;
constexpr int NMOD = 9, MODW = NMOD * DM;
constexpr int ABW = 4608, RGW = 4096, HD = 128;
constexpr float EPS = 1e-6f;
enum { I_X = 0, I_C, I_CTX, I_CCTX, I_WMOD, I_BMOD, I_NF1, I_NMIX, I_NF2, I_F1IN, I_F1OUT, I_F2IN, I_F2OUT, I_ABIN, I_ABOUT, I_SINK, I_ABCONV,
       I_RGIN, I_RGCONVW, I_RGCONVB, I_RGWA, I_RGBA, I_RGWX, I_RGBX, I_RGLAM, I_RGOUT, I_FNORM, N_IN };

constexpr size_t MiB = 1u << 20;
constexpr size_t WS_CTL = 0, CTL_ZERO_BYTES = 1 * MiB;
constexpr size_t WS_MOD = 1 * MiB;
constexpr size_t WS_ROPE = 1 * MiB + 512 * 1024;
constexpr size_t WS_WIN = 2 * MiB, WIN_BYTES = 44 * MiB;
constexpr size_t WS_WOUT = WS_WIN + 4 * WIN_BYTES, WOUT_BYTES = 22 * MiB;
constexpr size_t WS_WABIN = WS_WOUT + 4 * WOUT_BYTES;
constexpr size_t WS_WABOUT = WS_WABIN + 18 * MiB;
constexpr size_t WS_WRGIN = WS_WABOUT + 8 * MiB;
constexpr size_t WS_WRGOUT = WS_WRGIN + 16 * MiB;
constexpr size_t WS_WGATE = WS_WRGOUT + 8 * MiB;
constexpr size_t WS_X = WS_WGATE + 2 * MiB;
constexpr size_t WS_XN = WS_X + 132 * MiB;
constexpr size_t WS_H = WS_XN + 66 * MiB;
constexpr size_t WS_MIX = WS_H + 182 * MiB;
constexpr size_t WS_CS = WS_MIX + 66 * MiB;
constexpr size_t WS_PS = WS_CS + 17 * MiB;
constexpr size_t WS_END = WS_PS + 3 * MiB;
static_assert(WS_END <= 1100 * MiB, "d_ws map");
constexpr int CW_BAR = 4096;

constexpr int RING_OFF = 0, RING_BYTES = 131072;
constexpr int LDSCTL_OFF = RING_BYTES, MISC_OFF = LDSCTL_OFF + 320;
constexpr int LDS_BYTES = 147456;
struct Args { const float* in[27]; float* out; unsigned char* ws; int ph_lo, ph_hi; };

typedef float f32x2 __attribute__((ext_vector_type(2)));
typedef unsigned u32x2 __attribute__((ext_vector_type(2)));
typedef unsigned u32x4 __attribute__((ext_vector_type(4)));
__device__ __forceinline__ float wave_sum(float v) {
#pragma unroll
    for (int o = 1; o < 64; o <<= 1) v += __shfl_xor(v, o);
    return v;
}
__device__ __forceinline__ float bf_lo(unsigned w) { return __builtin_bit_cast(float, w << 16); }
__device__ __forceinline__ float bf_hi(unsigned w) { return __builtin_bit_cast(float, w & 0xffff0000u); }
__device__ __forceinline__ unsigned cvtpk(float lo, float hi) { unsigned r; asm volatile("v_cvt_pk_bf16_f32 %0, %1, %2" : "=v"(r) : "v"(lo), "v"(hi)); return r; }

__device__ __forceinline__ void conv_tile(const float* __restrict__ W, int N, bf16* __restrict__ Wt, int K, int k0, int n0, int drow0, LAS unsigned* scr, int lane) {
    const int kpl = lane >> 4, ng = lane & 15;
#pragma unroll 4
    for (int i = 0; i < 8; ++i) {
        const int kp = 4 * i + kpl;
        const float* src = W + (size_t)(k0 + 2 * kp) * N + n0 + 4 * ng;
        const f32x4 a = *(const f32x4*)src, b = *(const f32x4*)(src + N);
        LAS unsigned* d = scr + (4 * ng) * 33 + kp;
        d[0] = pk2(a.x, b.x); d[33] = pk2(a.y, b.y); d[66] = pk2(a.z, b.z); d[99] = pk2(a.w, b.w);
    }
    LDS_WAIT(); asm volatile("" ::: "memory");
    const int c = lane & 7;
#pragma unroll
    for (int j = 0; j < 8; ++j) { const int n = (lane >> 3) + 8 * j; const LAS unsigned* s = scr + n * 33 + 4 * c;
        v4u o; o.x = s[0]; o.y = s[1]; o.z = s[2]; o.w = s[3];
        *(GAS v4u*)(Wt + (size_t)(drow0 + n) * K + k0 + 8 * c) = o; }
    LDS_WAIT(); asm volatile("" ::: "memory");
}
__device__ __forceinline__ void conv_mat_tile(const float* W, int K, int N, bf16* Wt, int mode, int r, LAS unsigned* scr, int lane) {
    const int nblk = N / 64, kb = r / nblk, nb = r % nblk, n0 = 64 * nb;
    int drow0 = n0;
    if (mode == 1) { const int half = n0 >= DFF ? 1 : 0, nn = n0 - half * DFF; drow0 = (nn >> 7) * 256 + half * 128 + (nn & 127); }
    conv_tile(W, N, Wt, K, 64 * kb, n0, drow0, scr, lane);
}
constexpr int T_WIN = (DM / 64) * (2 * DFF / 64), T_WOUT = (DFF / 64) * (DM / 64), T_ABIN = (DM / 64) * (ABW / 64), T_SQ = (DM / 64) * (DM / 64), T_RGIN = (DM / 64) * (RGW / 64), T_GATE = 64 * 4;
constexpr int T_TOTAL = 4 * T_WIN + 4 * T_WOUT + T_ABIN + T_SQ + T_RGIN + T_SQ + T_GATE;

__device__ __forceinline__ void p0_convert(const Args& a, unsigned char* ws, LAS unsigned char* lds, int gw, int ngw, int wave, int lane) {
    LAS unsigned* scr = (LAS unsigned*)(lds + 32768 + wave * 8704);
    for (int it = gw; it < T_TOTAL; it += ngw) {
        int r = it;
        if (r < 4 * T_WIN) { const int s = r / T_WIN; r -= s * T_WIN; const int l = s >> 1;
            const float* W = ((s & 1) ? a.in[I_F2IN] : a.in[I_F1IN]) + (size_t)l * DM * 2 * DFF;
            conv_mat_tile(W, DM, 2 * DFF, (bf16*)(ws + WS_WIN + (size_t)s * WIN_BYTES), 1, r, scr, lane); continue; }
        r -= 4 * T_WIN;
        if (r < 4 * T_WOUT) { const int s = r / T_WOUT; r -= s * T_WOUT; const int l = s >> 1;
            const float* W = ((s & 1) ? a.in[I_F2OUT] : a.in[I_F1OUT]) + (size_t)l * DFF * DM;
            conv_mat_tile(W, DFF, DM, (bf16*)(ws + WS_WOUT + (size_t)s * WOUT_BYTES), 0, r, scr, lane); continue; }
        r -= 4 * T_WOUT;
        if (r < T_ABIN) { conv_mat_tile(a.in[I_ABIN], DM, ABW, (bf16*)(ws + WS_WABIN), 0, r, scr, lane); continue; }
        r -= T_ABIN;
        if (r < T_SQ) { conv_mat_tile(a.in[I_ABOUT], DM, DM, (bf16*)(ws + WS_WABOUT), 0, r, scr, lane); continue; }
        r -= T_SQ;
        if (r < T_RGIN) { conv_mat_tile(a.in[I_RGIN], DM, RGW, (bf16*)(ws + WS_WRGIN), 0, r, scr, lane); continue; }
        r -= T_RGIN;
        if (r < T_SQ) { conv_mat_tile(a.in[I_RGOUT], DM, DM, (bf16*)(ws + WS_WRGOUT), 0, r, scr, lane); continue; }
        r -= T_SQ;
        {
            const int mi = r >> 2, t = r & 3, d = mi >> 5, g = (mi >> 4) & 1, h = mi & 15;
            const float* W = (g ? a.in[I_RGWX] : a.in[I_RGWA]) + (size_t)(d * 16 + h) * 128 * 128;
            conv_mat_tile(W, 128, 128, (bf16*)(ws + WS_WGATE) + (size_t)mi * 128 * 128, 0, t, scr, lane);
        }
    }
}
__device__ __forceinline__ void p0_mod_task(const Args& a, unsigned char* ws, LAS unsigned char* lds, int t, int tid, int wave, int lane) {
    LAS float* SC = (LAS float*)lds;
    LAS float* RED = (LAS float*)(lds + 24576 + 0);
    const int l = t / 72, cb = t % 72, n = 256 * cb + 4 * lane;
    const float* W = a.in[I_WMOD] + ((size_t)l * DM + 256 * wave) * MODW + n;
    f32x4 acc0 = {0.f, 0.f, 0.f, 0.f}, acc1 = acc0, acc2 = acc0;
#pragma unroll 8
    for (int k = 0; k < 256; ++k) {
        const f32x4 w = *(const f32x4*)(W + (size_t)k * MODW);
        const int kk = 256 * wave + k;
        acc0 += w * SC[kk]; acc1 += w * SC[2048 + kk]; acc2 += w * SC[4096 + kk];
    }
    LAS f32x4* R4 = (LAS f32x4*)RED;
    R4[(wave * 3 + 0) * 64 + lane] = acc0; R4[(wave * 3 + 1) * 64 + lane] = acc1; R4[(wave * 3 + 2) * 64 + lane] = acc2;
    __syncthreads();
    for (int o = tid; o < 768; o += NTHR) { const int v = o >> 8, j = o & 255; float s = a.in[I_BMOD][(size_t)l * MODW + 256 * cb + j];
#pragma unroll
        for (int w = 0; w < 8; ++w) s += RED[(w * 3 + v) * 256 + j];
        ((float*)(ws + WS_MOD))[((size_t)l * 3 + v) * MODW + 256 * cb + j] = s; }
    __syncthreads();
}
__device__ __forceinline__ void p0_prologue(const Args& a, unsigned char* ws, LAS unsigned char* lds, int G, int bid, int tid, int wave, int lane) {
    if (bid < 144) {
        LAS float* SC = (LAS float*)lds;
        for (int i = tid; i < 3 * DM; i += NTHR) { const int v = i / DM, k = i % DM; const float c = (v < 2) ? a.in[I_C][v * DM + k] : a.in[I_CCTX][k];
            SC[i] = c / (1.0f + __expf(-c)); }
        __syncthreads();
        for (int t = bid; t < 144; t += G) p0_mod_task(a, ws, lds, t, tid, wave, lane);
    }
    if (bid == G - 1) {
        float* ct = (float*)(ws + WS_ROPE); float* st = ct + 4096;
        for (int i = tid; i < 4096; i += NTHR) { const int pos = i >> 5, f = i & 31; const float inv = powf(10000.0f, -(float)f / 32.0f); const float ang = (float)pos * inv;
            ct[i] = cosf(ang); st[i] = sinf(ang); }
    }
    __syncthreads();
    p0_convert(a, ws, lds, bid * NWAVES + wave, G * NWAVES, wave, lane);
}

__device__ __forceinline__ void norm_phase(const float* srcLat, const float* srcCtx, int nrows, const float* g, const float* shift, const float* scale  , bf16* XN, int gw, int ngw, int lane) {
    const int per = (nrows + ngw - 1) / ngw; const int r0 = gw * per, r1 = (r0 + per < nrows) ? r0 + per : nrows;
    int vcur = -1; f32x4 gs[8], sh[8];
    for (int row = r0; row < r1; ++row) {
        const int v = row < SEQ ? 0 : (row < NLAT ? 1 : 2);
        if (v != vcur) { vcur = v;
#pragma unroll
            for (int j = 0; j < 8; ++j) { const int c = 4 * lane + 256 * j; const f32x4 gg = *(const f32x4*)(g + c), sc = *(const f32x4*)(scale + (size_t)v * MODW + c);
                gs[j] = gg * (sc + 1.0f); sh[j] = *(const f32x4*)(shift + (size_t)v * MODW + c); } }
        const float* xr = (row < NLAT) ? srcLat + (size_t)row * DM : srcCtx + (size_t)(row - NLAT) * DM;
        f32x4 x[8]; float s = 0.f;
#pragma unroll
        for (int j = 0; j < 8; ++j) { x[j] = *(const f32x4*)(xr + 4 * lane + 256 * j); s += (x[j].x * x[j].x + x[j].y * x[j].y) + (x[j].z * x[j].z + x[j].w * x[j].w); }
        const float rstd = 1.0f / sqrtf(wave_sum(s) * (1.0f / DM) + EPS);
        bf16* orow = XN + (size_t)row * DM;
#pragma unroll
        for (int j = 0; j < 8; ++j) { const f32x4 y = x[j] * rstd * gs[j] + sh[j]; u32x2 w; w.x = cvtpk(y.x, y.y); w.y = cvtpk(y.z, y.w);
            *(u32x2*)(orow + 4 * lane + 256 * j) = w; }
    }
}
__device__ __forceinline__ void final_norm_phase(const float* X, const float* g, float* out, int gw, int ngw, int lane) {
    f32x4 gg[8];
#pragma unroll
    for (int j = 0; j < 8; ++j) gg[j] = *(const f32x4*)(g + 4 * lane + 256 * j);
    for (int row = gw; row < NLAT; row += ngw) {
        const float* xr = X + (size_t)row * DM; f32x4 x[8]; float s = 0.f;
#pragma unroll
        for (int j = 0; j < 8; ++j) { x[j] = *(const f32x4*)(xr + 4 * lane + 256 * j); s += (x[j].x * x[j].x + x[j].y * x[j].y) + (x[j].z * x[j].z + x[j].w * x[j].w); }
        const float rstd = 1.0f / sqrtf(wave_sum(s) * (1.0f / DM) + EPS);
#pragma unroll
        for (int j = 0; j < 8; ++j) *(f32x4*)(out + (size_t)row * DM + 4 * lane + 256 * j) = x[j] * rstd * gg[j];
    }
}

typedef float f32x16 __attribute__((ext_vector_type(16)));
typedef short s16x4 __attribute__((ext_vector_type(4)));
constexpr int KSTR = 136, VSTR = 160;
constexpr int AT_K = 0, AT_V = 64 * KSTR * 2, AT_WS = AT_V + 64 * VSTR * 2, AT_END = AT_WS + NWAVES * 256;
constexpr float ATT_C2 = 0.08838834764831845f * 1.4426950408889634f;
constexpr float LOG2E = 1.4426950408889634f;
__device__ __forceinline__ int crow(int r, int hi) { return (r & 3) + 8 * (r >> 2) + 4 * hi; }

__device__ __forceinline__ void rope_pair(v4u& p1, v4u& p2, const float* ropeC, const float* ropeS, int pos, int f0) {
    const f32x4 c0 = *(const f32x4*)(ropeC + pos * 32 + f0), c1 = *(const f32x4*)(ropeC + pos * 32 + f0 + 4);
    const f32x4 s0 = *(const f32x4*)(ropeS + pos * 32 + f0), s1 = *(const f32x4*)(ropeS + pos * 32 + f0 + 4);
    const float cc[8] = {c0.x, c0.y, c0.z, c0.w, c1.x, c1.y, c1.z, c1.w}, ss[8] = {s0.x, s0.y, s0.z, s0.w, s1.x, s1.y, s1.z, s1.w};
    unsigned a[4] = {p1.x, p1.y, p1.z, p1.w}, b[4] = {p2.x, p2.y, p2.z, p2.w};
#pragma unroll
    for (int i = 0; i < 4; ++i) {
        const float x1l = bf_lo(a[i]), x1h = bf_hi(a[i]), x2l = bf_lo(b[i]), x2h = bf_hi(b[i]);
        a[i] = cvtpk(x1l * cc[2 * i] - x2l * ss[2 * i], x1h * cc[2 * i + 1] - x2h * ss[2 * i + 1]);
        b[i] = cvtpk(x2l * cc[2 * i] + x1l * ss[2 * i], x2h * cc[2 * i + 1] + x1h * ss[2 * i + 1]);
    }
    p1 = (v4u){a[0], a[1], a[2], a[3]}; p2 = (v4u){b[0], b[1], b[2], b[3]};
}

__device__ __forceinline__ void attn_unit(const bf16* __restrict__ PROJ, bf16* __restrict__ MIX, const float* sink, const float* ropeC, const float* ropeS,
                                          LAS unsigned char* lds, int u, int tid, int wave, int lane) {
    const bool isctx = u >= 512;
    int b, kvh, qb;
    if (!isctx) { b = u >> 8; kvh = (u >> 7) & 1; qb = u & 127; } else { const int uu = u - 512; b = uu >> 3; kvh = (uu >> 2) & 1; qb = uu & 3; }
    const int g = wave >> 1, rg = wave & 1, head = kvh * 4 + g;
    const int r32 = lane & 31, hi = lane >> 5;
    const size_t seqbase = isctx ? (size_t)NLAT + (size_t)b * CTXL : (size_t)b * SEQ;
    const size_t ctxbase = (size_t)NLAT + (size_t)b * CTXL;
    const int qpos = 64 * qb + 32 * rg + r32;
    v4u qraw[8];
    { const bf16* qrow = PROJ + (seqbase + qpos) * ABW + head * HD + 8 * hi;
#pragma unroll
      for (int kk = 0; kk < 8; ++kk) qraw[kk] = *(const v4u*)(qrow + 16 * kk); }
    if (!isctx) {
        rope_pair(qraw[0], qraw[2], ropeC, ropeS, qpos >> 6, 8 * hi);
        rope_pair(qraw[1], qraw[3], ropeC, ropeS, qpos >> 6, 16 + 8 * hi);
        rope_pair(qraw[4], qraw[6], ropeC, ropeS, qpos & 63, 8 * hi);
        rope_pair(qraw[5], qraw[7], ropeC, ropeS, qpos & 63, 16 + 8 * hi);
    }
    bf16x8 qf[8];
#pragma unroll
    for (int kk = 0; kk < 8; ++kk) qf[kk] = __builtin_bit_cast(bf16x8, qraw[kk]);
    float m_run = sink[head] * LOG2E, l_run = 1.0f;
    f32x16 O[4];
#pragma unroll
    for (int d = 0; d < 4; ++d)
#pragma unroll
        for (int r = 0; r < 16; ++r) O[d][r] = 0.f;
    LAS float* wsf = (LAS float*)(lds + AT_WS) + wave * 64;
    const int srow = tid >> 3, sc = (tid & 3) + 8 * ((tid >> 2) & 1);
    const int t_lo = isctx ? 5 : 0;
    v4u kA, kB, vA, vB; int kposS = 0; bool kropeS = false;
#define AT_VALID(t) ((t) >= 5 || ((64 * qb - 128 + 64 * (t)) >= 0 && (64 * qb - 128 + 64 * (t)) < SEQ))
#define AT_LOAD(t) do { const bool loc_ = (t) < 5; const int kp_ = loc_ ? (64 * qb - 128 + 64 * (t) + srow) : (64 * ((t) - 5) + srow); \
        const bf16* kr_ = PROJ + ((loc_ ? seqbase : ctxbase) + kp_) * ABW + 1024 + 128 * kvh + 8 * sc; \
        kA = *(const v4u*)kr_; kB = *(const v4u*)(kr_ + 32); vA = *(const v4u*)(kr_ + 256); vB = *(const v4u*)(kr_ + 288); kposS = kp_; kropeS = loc_; } while (0)
    int t = t_lo; while (t < 9 && !AT_VALID(t)) ++t;
    AT_LOAD(t);
    while (t < 9) {
        __syncthreads();
        if (kropeS) rope_pair(kA, kB, ropeC, ropeS, (sc >> 3) ? (kposS & 63) : (kposS >> 6), 8 * (sc & 3));
        *(LAS v4u*)(lds + AT_K + srow * (KSTR * 2) + 16 * sc) = kA; *(LAS v4u*)(lds + AT_K + srow * (KSTR * 2) + 16 * (sc + 4)) = kB;
        *(LAS v4u*)(lds + AT_V + srow * (VSTR * 2) + 16 * sc) = vA; *(LAS v4u*)(lds + AT_V + srow * (VSTR * 2) + 16 * (sc + 4)) = vB;
        __syncthreads();
        const int tcur = t;
        ++t; while (t < 9 && !AT_VALID(t)) ++t;
        if (t < 9) AT_LOAD(t);
        f32x16 p0, p1;
#pragma unroll
        for (int r = 0; r < 16; ++r) { p0[r] = 0.f; p1[r] = 0.f; }
        { const LAS unsigned char* kb = lds + AT_K + r32 * (KSTR * 2) + 16 * hi;
#pragma unroll
          for (int kk = 0; kk < 8; ++kk) {
              const bf16x8 a0 = *(const LAS bf16x8*)(kb + 32 * kk), a1 = *(const LAS bf16x8*)(kb + 32 * (KSTR * 2) + 32 * kk);
              p0 = __builtin_amdgcn_mfma_f32_32x32x16_bf16(a0, qf[kk], p0, 0, 0, 0);
              p1 = __builtin_amdgcn_mfma_f32_32x32x16_bf16(a1, qf[kk], p1, 0, 0, 0); } }
        const int qrel = 32 * rg + r32;
        float mx = -INFINITY;
#pragma unroll
        for (int r = 0; r < 16; ++r) {
            const int kv0 = crow(r, hi), kv1 = kv0 + 32;
            float s0 = p0[r] * ATT_C2, s1 = p1[r] * ATT_C2;
            if (tcur == 0) { if (kv0 < qrel) s0 = -INFINITY; if (kv1 < qrel) s1 = -INFINITY; }
            if (tcur == 4) { if (kv0 > qrel) s0 = -INFINITY; if (kv1 > qrel) s1 = -INFINITY; }
            p0[r] = s0; p1[r] = s1; mx = fmaxf(mx, fmaxf(s0, s1));
        }
        mx = fmaxf(mx, __shfl_xor(mx, 32));
        const float m_new = fmaxf(m_run, mx), alpha = exp2f(m_run - m_new);
        float rs = 0.f;
#pragma unroll
        for (int r = 0; r < 16; ++r) { p0[r] = exp2f(p0[r] - m_new); p1[r] = exp2f(p1[r] - m_new); rs += p0[r] + p1[r]; }
        rs += __shfl_xor(rs, 32);
        l_run = l_run * alpha + rs; m_run = m_new;
        if (hi == 0) wsf[r32] = alpha;
        LDS_WAIT(); asm volatile("" ::: "memory");
        { float al[16];
#pragma unroll
          for (int r = 0; r < 16; ++r) al[r] = wsf[crow(r, hi)];
#pragma unroll
          for (int d = 0; d < 4; ++d)
#pragma unroll
              for (int r = 0; r < 16; ++r) O[d][r] *= al[r]; }
        const LAS unsigned char* vb = lds + AT_V + (4 * hi + ((lane & 15) >> 2)) * (VSTR * 2) + (16 * ((lane >> 4) & 1) + 4 * (lane & 3)) * 2;
#pragma unroll
        for (int half = 0; half < 2; ++half)
#pragma unroll
            for (int s = 0; s < 2; ++s) {
                u32x4 pw;
                if (half == 0) { pw.x = cvtpk(p0[8 * s + 0], p0[8 * s + 1]); pw.y = cvtpk(p0[8 * s + 2], p0[8 * s + 3]); pw.z = cvtpk(p0[8 * s + 4], p0[8 * s + 5]); pw.w = cvtpk(p0[8 * s + 6], p0[8 * s + 7]); }
                else           { pw.x = cvtpk(p1[8 * s + 0], p1[8 * s + 1]); pw.y = cvtpk(p1[8 * s + 2], p1[8 * s + 3]); pw.z = cvtpk(p1[8 * s + 4], p1[8 * s + 5]); pw.w = cvtpk(p1[8 * s + 6], p1[8 * s + 7]); }
                const bf16x8 pa = __builtin_bit_cast(bf16x8, pw);
                const LAS unsigned char* vr = vb + (32 * half + 16 * s) * (VSTR * 2);
#pragma unroll
                for (int d = 0; d < 4; ++d) {
                    const s16x4 lo = __builtin_bit_cast(s16x4, __builtin_amdgcn_ds_read_tr16_b64_v4i16((LAS s16x4*)(vr + 64 * d)));
                    const s16x4 hh = __builtin_bit_cast(s16x4, __builtin_amdgcn_ds_read_tr16_b64_v4i16((LAS s16x4*)(vr + 8 * (VSTR * 2) + 64 * d)));
                    const bf16x8 vf = (bf16x8){lo[0], lo[1], lo[2], lo[3], hh[0], hh[1], hh[2], hh[3]};
                    O[d] = __builtin_amdgcn_mfma_f32_32x32x16_bf16(pa, vf, O[d], 0, 0, 0);
                }
            }
    }
#undef AT_VALID
#undef AT_LOAD
    if (hi == 0) wsf[32 + r32] = 1.0f / l_run;
    LDS_WAIT(); asm volatile("" ::: "memory");
    bf16* orow = MIX + (seqbase + 64 * qb + 32 * rg) * DM + head * HD + r32;
#pragma unroll
    for (int r = 0; r < 16; ++r) { const int q = crow(r, hi); const float il = wsf[32 + q];
#pragma unroll
        for (int d = 0; d < 4; ++d) orow[(size_t)q * DM + 32 * d] = (bf16)f2bf(O[d][r] * il); }
    LDS_WAIT(); asm volatile("" ::: "memory");
}

__device__ __forceinline__ void sconv_items(const bf16* __restrict__ PROJ, bf16* __restrict__ MIX, const float* cw  , int gtid, int ngt) {
    for (int it = gtid; it < MROWS * 128; it += ngt) {
        const int row = it >> 7, c = (it & 127) * 8;
        int pos, len; if (row < NLAT) { pos = row & (SEQ - 1); len = SEQ; } else { pos = (row - NLAT) & (CTXL - 1); len = CTXL; }
        const bf16* pr = PROJ + (size_t)row * ABW;
        const v4u bgv = *(const v4u*)(pr + 1536 + c);
        float acc[8];
#pragma unroll
        for (int j = 0; j < 8; ++j) acc[j] = 0.f;
#pragma unroll
        for (int k = 0; k < 3; ++k) {
            const int p2 = pos + k - 1;
            if (p2 >= 0 && p2 < len) {
                const bf16* q = pr + (ptrdiff_t)(k - 1) * ABW;
                const v4u cg = *(const v4u*)(q + 2560 + c), uu = *(const v4u*)(q + 3584 + c);
                const f32x4 w0 = *(const f32x4*)(cw + k * 1024 + c), w1 = *(const f32x4*)(cw + k * 1024 + c + 4);
                const unsigned cgw[4] = {cg.x, cg.y, cg.z, cg.w}, uw[4] = {uu.x, uu.y, uu.z, uu.w};
                const float ww[8] = {w0.x, w0.y, w0.z, w0.w, w1.x, w1.y, w1.z, w1.w};
#pragma unroll
                for (int i = 0; i < 4; ++i) { acc[2 * i] += ww[2 * i] * (bf_lo(cgw[i]) * bf_lo(uw[i])); acc[2 * i + 1] += ww[2 * i + 1] * (bf_hi(cgw[i]) * bf_hi(uw[i])); }
            }
        }
        const unsigned bw[4] = {bgv.x, bgv.y, bgv.z, bgv.w};
        v4u o;
        o.x = cvtpk(acc[0] * bf_lo(bw[0]), acc[1] * bf_hi(bw[0])); o.y = cvtpk(acc[2] * bf_lo(bw[1]), acc[3] * bf_hi(bw[1]));
        o.z = cvtpk(acc[4] * bf_lo(bw[2]), acc[5] * bf_hi(bw[2])); o.w = cvtpk(acc[6] * bf_lo(bw[3]), acc[7] * bf_hi(bw[3]));
        *(v4u*)(MIX + (size_t)row * DM + 1024 + c) = o;
    }
}

constexpr int UCF_STR = 132;
constexpr int SC_UCF = 0, SC_UCB = SC_UCF + 32 * UCF_STR * 4, SC_AB = SC_UCB + 32 * KSTR * 2, SC_Y = SC_AB + 2 * 32 * 128 * 8, SC_END = SC_Y + 2 * 32 * 128 * 4;
static_assert(SC_END <= RING_BYTES && (SC_UCB % 16) == 0 && (SC_AB % 16) == 0, "scan LDS map");
__device__ __forceinline__ float sigmoid_f(float x) { return 1.0f / (1.0f + __expf(-x)); }
__device__ __forceinline__ float gelu_tanh_f(float x) { const float z = 0.7978845608028654f * (x + 0.044715f * x * x * x); const float t = 1.0f - 2.0f / (__expf(2.0f * z) + 1.0f); return 0.5f * x * (1.0f + t); }

template <bool PASS3>
__device__ __forceinline__ void scan_unit(const Args& a, unsigned char* ws, LAS unsigned char* lds, int p, int h, int tid, int wave, int lane) {
    const bf16* PROJ2 = (const bf16*)(ws + WS_H);
    bf16* MIX = (bf16*)(ws + WS_MIX);
    float* CS = (float*)(ws + WS_CS); float* PS = (float*)(ws + WS_PS);
    const bf16* WG = (const bf16*)(ws + WS_WGATE);
    LAS float* UCF = (LAS float*)(lds + SC_UCF);
    LAS f32x2* AB = (LAS f32x2*)(lds + SC_AB);
    LAS float* Y = (LAS float*)(lds + SC_Y);
    const int r32 = lane & 31, hi = lane >> 5;
    const int d = wave >> 2, cq = wave & 3;
    const int cabs = h * 128 + 32 * cq + r32;
    const int pseq0 = p < 64 ? (p & ~31) : p;
    const int seqlen = p < 64 ? SEQ : CTXL;
    const int pos0 = (p - pseq0) * 256;
    bf16x8 wfa[8], wfx[8];
    { const bf16* wa = WG + ((size_t)((d * 2 + 0) * 16 + h) * 128 + 32 * cq + r32) * 128 + 8 * hi;
      const bf16* wx = WG + ((size_t)((d * 2 + 1) * 16 + h) * 128 + 32 * cq + r32) * 128 + 8 * hi;
#pragma unroll
      for (int kk = 0; kk < 8; ++kk) { wfa[kk] = *(const bf16x8*)(wa + 16 * kk); wfx[kk] = *(const bf16x8*)(wx + 16 * kk); } }
    const float ba = a.in[I_RGBA][d * DM + cabs], bx = a.in[I_RGBX][d * DM + cabs];
    const float sp8 = 8.0f * log1pf(expf(-a.in[I_RGLAM][d * DM + cabs]));
    const int ct = tid >> 4, cc = (tid & 15) * 8;
    const float* cwp = a.in[I_RGCONVW] + h * 128 + cc; const float* cbp = a.in[I_RGCONVB] + h * 128 + cc;
    const int sd = (tid >> 7) & 1, sch = tid & 127, scabs = h * 128 + sch;
    float cin[8];
    float PA = 1.0f, PH = 0.0f;
    if (PASS3 && tid < 256) {
        const int b = p >> 5;
        float carry = PS[((size_t)((64 + b) * 2 + sd) * 2 + 1) * DM + scabs];
        if (sd == 0) { for (int pp = 32 * b; pp < p; ++pp) carry = PS[((size_t)(pp * 2 + 0) * 2 + 0) * DM + scabs] * carry + PS[((size_t)(pp * 2 + 0) * 2 + 1) * DM + scabs]; }
        else         { for (int pp = 32 * b + 31; pp > p; --pp) carry = PS[((size_t)(pp * 2 + 1) * 2 + 0) * DM + scabs] * carry + PS[((size_t)(pp * 2 + 1) * 2 + 1) * DM + scabs]; }
        if (sd == 0) { cin[0] = carry;
#pragma unroll
            for (int k = 0; k < 7; ++k) cin[k + 1] = CS[((size_t)((p * 8 + k) * 2 + 0) * 2 + 0) * DM + scabs] * cin[k] + CS[((size_t)((p * 8 + k) * 2 + 0) * 2 + 1) * DM + scabs]; }
        else { cin[7] = carry;
#pragma unroll
            for (int k = 7; k > 0; --k) cin[k - 1] = CS[((size_t)((p * 8 + k) * 2 + 1) * 2 + 0) * DM + scabs] * cin[k] + CS[((size_t)((p * 8 + k) * 2 + 1) * 2 + 1) * DM + scabs]; }
    }
#pragma unroll 1
    for (int k = 0; k < 8; ++k) {
        { const int pos = pos0 + 32 * k + ct; const size_t row = (size_t)p * 256 + 32 * k + ct;
          float acc[8];
          { const f32x4 b0 = *(const f32x4*)cbp, b1 = *(const f32x4*)(cbp + 4); acc[0] = b0.x; acc[1] = b0.y; acc[2] = b0.z; acc[3] = b0.w; acc[4] = b1.x; acc[5] = b1.y; acc[6] = b1.z; acc[7] = b1.w; }
#pragma unroll
          for (int kk = 0; kk < 4; ++kk) { const int p2 = pos + kk - 2;
              if (p2 >= 0 && p2 < seqlen) { const v4u uu = *(const v4u*)(PROJ2 + (size_t)((ptrdiff_t)row + kk - 2) * RGW + 2048 + h * 128 + cc);
                  const unsigned uw[4] = {uu.x, uu.y, uu.z, uu.w};
                  const f32x4 w0 = *(const f32x4*)(cwp + kk * DM), w1 = *(const f32x4*)(cwp + kk * DM + 4);
                  const float ww[8] = {w0.x, w0.y, w0.z, w0.w, w1.x, w1.y, w1.z, w1.w};
#pragma unroll
                  for (int i = 0; i < 4; ++i) { acc[2 * i] += ww[2 * i] * bf_lo(uw[i]); acc[2 * i + 1] += ww[2 * i + 1] * bf_hi(uw[i]); } } }
          *(LAS f32x4*)(UCF + ct * UCF_STR + cc) = (f32x4){acc[0], acc[1], acc[2], acc[3]}; *(LAS f32x4*)(UCF + ct * UCF_STR + cc + 4) = (f32x4){acc[4], acc[5], acc[6], acc[7]};
          v4u o; o.x = cvtpk(acc[0], acc[1]); o.y = cvtpk(acc[2], acc[3]); o.z = cvtpk(acc[4], acc[5]); o.w = cvtpk(acc[6], acc[7]);
          *(LAS v4u*)(lds + SC_UCB + ct * (KSTR * 2) + cc * 2) = o; }
        __syncthreads();
        f32x16 gr, gi;
#pragma unroll
        for (int r = 0; r < 16; ++r) { gr[r] = 0.f; gi[r] = 0.f; }
        { const LAS unsigned char* ub = lds + SC_UCB + r32 * (KSTR * 2) + 16 * hi;
#pragma unroll
          for (int kk = 0; kk < 8; ++kk) { const bf16x8 af = *(const LAS bf16x8*)(ub + 32 * kk);
              gr = __builtin_amdgcn_mfma_f32_32x32x16_bf16(af, wfa[kk], gr, 0, 0, 0);
              gi = __builtin_amdgcn_mfma_f32_32x32x16_bf16(af, wfx[kk], gi, 0, 0, 0); } }
#pragma unroll
        for (int r = 0; r < 16; ++r) { const int t = crow(r, hi);
            const float rr = sigmoid_f(gr[r] + ba), ii = sigmoid_f(gi[r] + bx);
            const float la = -sp8 * rr, av = expf(la), mult = sqrtf(-expm1f(2.0f * la));
            AB[(d * 32 + t) * 128 + 32 * cq + r32] = (f32x2){av, mult * ii * UCF[t * UCF_STR + 32 * cq + r32]};
            if ((r & 3) == 3) asm volatile("" ::: "memory"); }
        __syncthreads();
        if (tid < 256) {
            if (!PASS3) {
                float A = 1.0f, H = 0.0f;
                if (sd == 0) {
_Pragma("unroll 4")
 for (int t = 0; t < 32; ++t) { const f32x2 ab = AB[(sd * 32 + t) * 128 + sch]; H = ab.x * H + ab.y; A *= ab.x; } }
                else         {
_Pragma("unroll 4")
 for (int t = 31; t >= 0; --t) { const f32x2 ab = AB[(sd * 32 + t) * 128 + sch]; H = ab.x * H + ab.y; A *= ab.x; } }
                CS[((size_t)((p * 8 + k) * 2 + sd) * 2 + 0) * DM + scabs] = A; CS[((size_t)((p * 8 + k) * 2 + sd) * 2 + 1) * DM + scabs] = H;
                if (sd == 0) { PH = A * PH + H; PA *= A; } else { PH = PA * H + PH; PA *= A; }
            } else {
                float hh = cin[0];
#pragma unroll
                for (int j = 1; j < 8; ++j) hh = (k == j) ? cin[j] : hh;
                if (sd == 0) {
_Pragma("unroll 4")
 for (int t = 0; t < 32; ++t) { const f32x2 ab = AB[(sd * 32 + t) * 128 + sch]; hh = ab.x * hh + ab.y; Y[(sd * 32 + t) * 128 + sch] = hh; } }
                else         {
_Pragma("unroll 4")
 for (int t = 31; t >= 0; --t) { const f32x2 ab = AB[(sd * 32 + t) * 128 + sch]; hh = ab.x * hh + ab.y; Y[(sd * 32 + t) * 128 + sch] = hh; } }
            }
        }
        __syncthreads();
        if (PASS3) {
            const size_t row = (size_t)p * 256 + 32 * k + ct;
            const v4u gv = *(const v4u*)(PROJ2 + row * RGW + h * 128 + cc);
            const f32x4 y0 = *(const LAS f32x4*)(Y + ct * 128 + cc) + *(const LAS f32x4*)(Y + (32 + ct) * 128 + cc);
            const f32x4 y1 = *(const LAS f32x4*)(Y + ct * 128 + cc + 4) + *(const LAS f32x4*)(Y + (32 + ct) * 128 + cc + 4);
            v4u o;
            o.x = cvtpk(y0.x * gelu_tanh_f(bf_lo(gv.x)), y0.y * gelu_tanh_f(bf_hi(gv.x))); o.y = cvtpk(y0.z * gelu_tanh_f(bf_lo(gv.y)), y0.w * gelu_tanh_f(bf_hi(gv.y)));
            o.z = cvtpk(y1.x * gelu_tanh_f(bf_lo(gv.z)), y1.y * gelu_tanh_f(bf_hi(gv.z))); o.w = cvtpk(y1.z * gelu_tanh_f(bf_lo(gv.w)), y1.w * gelu_tanh_f(bf_hi(gv.w)));
            *(v4u*)(MIX + row * DM + h * 128 + cc) = o;
        }
    }
    if (!PASS3 && tid < 256) { PS[((size_t)(p * 2 + sd) * 2 + 0) * DM + scabs] = PA; PS[((size_t)(p * 2 + sd) * 2 + 1) * DM + scabs] = PH; }
}

#ifndef MK_ONE_LAUNCH
#define MK_ONE_LAUNCH 0
#endif
constexpr int N_PHASES = 23;
#ifdef DIS_NORM
#define norm_phase(...) do {} while (0)
#define final_norm_phase(...) do {} while (0)
#endif
template <class Epi, class Sched> __device__ __forceinline__ void run_gemm(LAS unsigned char* lds, const bf16* A, const bf16* Bt, int M, int N, int K, int G, int bid, const Epi& E) {
    pg8::Gemm g{A, Bt, M, N, K}; Sched S; S.init(G, bid); pg8::gemm_phase<Epi, Sched, true, true>(lds, g, S, E);
}
__global__ void __launch_bounds__(NTHR, 2) fwd_kernel(Args args) {
    extern __shared__ __attribute__((aligned(16))) unsigned char lds_raw[];
    LAS unsigned char* lds = (LAS unsigned char*)lds_raw;
    volatile LAS unsigned* MISC = (volatile LAS unsigned*)(lds + MISC_OFF);
    const int tid = threadIdx.x, lane = tid & 63, wave = __builtin_amdgcn_readfirstlane(tid >> 6);
    const int G = gridDim.x, bid = blockIdx.x;
    unsigned char* ws = args.ws;
    for (int u = tid; u < (LDS_BYTES - LDSCTL_OFF) / 4; u += NTHR) ((LAS unsigned*)(lds + LDSCTL_OFF))[u] = 0u;
    __syncthreads();
    const int lo = args.ph_lo, hi = args.ph_hi;
    XcdBarrier bar; bar.bar = (unsigned*)(ws + WS_CTL) + CW_BAR; bar.x = 0; bar.st = nullptr;
    if (hi - lo > 1) bar = xcd_barrier_post((unsigned*)(ws + WS_CTL) + CW_BAR, MISC + 8);
#define IN(k) (lo <= (k) && (k) < hi)
#define SEAM(k) do { if (IN(k) && IN((k) + 1)) xcd_barrier(bar); } while (0)
    const int gw = bid * NWAVES + wave, ngw = G * NWAVES;
    float* MOD = (float*)(ws + WS_MOD);
    float* X = (float*)(ws + WS_X);
    bf16* XN = (bf16*)(ws + WS_XN);
    bf16* HB = (bf16*)(ws + WS_H);
    bf16* MIX = (bf16*)(ws + WS_MIX);

#ifndef DIS_P0
    if (IN(0)) { p0_prologue(args, ws, lds, G, bid, tid, wave, lane); }
#endif
    SEAM(0);

#define FFN_BLOCK(MP, s, base) do { \
        const int l_ = (s) >> 1, which_ = (s) & 1; \
        const float* modl_ = MOD + (size_t)l_ * 3 * MODW; \
        const float* srcLat_ = ((s) == 0) ? args.in[I_X] : X; \
        const float* srcCtx_ = ((s) == 0) ? args.in[I_CTX] : X + (size_t)NLAT * DM; \
        if (IN(base)) { const float* g_ = (which_ ? args.in[I_NF2] : args.in[I_NF1]) + (size_t)l_ * DM; \
            norm_phase(srcLat_, srcCtx_, (MP) * 256, g_, modl_ + (which_ ? 6 : 0) * DM, modl_ + (which_ ? 7 : 1) * DM, XN, gw, ngw, lane); } \
        SEAM(base); \
        if (IN((base) + 1)) { pg8::EpiSwiGLU E_{HB, DFF}; \
            run_gemm<pg8::EpiSwiGLU, pg8::StaticOrderC<MP, 44>>(lds + RING_OFF, XN, (const bf16*)(ws + WS_WIN + (size_t)(s) * WIN_BYTES), (MP) * 256, 2 * DFF, DM, G, bid, E_); } \
        SEAM((base) + 1); \
        if (IN((base) + 2)) { pg8::EpiResid E_{srcLat_, srcCtx_, X, modl_ + (which_ ? 8 : 2) * DM, MODW, 0.5f}; \
            run_gemm<pg8::EpiResid, pg8::StaticOrderC<MP, 8>>(lds + RING_OFF, HB, (const bf16*)(ws + WS_WOUT + (size_t)(s) * WOUT_BYTES), (MP) * 256, DM, DFF, G, bid, E_); } \
        SEAM((base) + 2); \
    } while (0)

    FFN_BLOCK(66, 0, 1);
    { const float* modl = MOD;
            if (IN(4)) norm_phase(X, X + (size_t)NLAT * DM, MROWS, args.in[I_NMIX], modl + 3 * DM, modl + 4 * DM, XN, gw, ngw, lane);
            SEAM(4);
            if (IN(5)) { pg8::EpiBf16 E{HB, ABW};
                run_gemm<pg8::EpiBf16, pg8::StaticOrderC<66, 18>>(lds + RING_OFF, XN, (const bf16*)(ws + WS_WABIN), MROWS, ABW, DM, G, bid, E); }
            SEAM(5);
            if (IN(6)) {
                const float* ropeC = (const float*)(ws + WS_ROPE); const float* ropeS = ropeC + 4096;
#ifndef DIS_ATTN
                for (int u = bid; u < 528; u += G) attn_unit(HB, MIX, args.in[I_SINK], ropeC, ropeS, lds, u, tid, wave, lane);
#endif
                sconv_items(HB, MIX, args.in[I_ABCONV], bid * NTHR + tid, G * NTHR);
            }
            SEAM(6);
            if (IN(7)) { pg8::EpiResid E{X, X + (size_t)NLAT * DM, X, modl + 5 * DM, MODW, 1.0f};
                run_gemm<pg8::EpiResid, pg8::StaticOrderC<66, 8>>(lds + RING_OFF, MIX, (const bf16*)(ws + WS_WABOUT), MROWS, DM, DM, G, bid, E); }
            SEAM(7);
    }
    FFN_BLOCK(66, 1, 8);
    FFN_BLOCK(66, 2, 11);
    { const float* modl = MOD + (size_t)3 * MODW;
            if (IN(14)) norm_phase(X, X + (size_t)NLAT * DM, MROWS, args.in[I_NMIX] + DM, modl + 3 * DM, modl + 4 * DM, XN, gw, ngw, lane);
            SEAM(14);
            if (IN(15)) { pg8::EpiBf16 E{HB, RGW};
                run_gemm<pg8::EpiBf16, pg8::StaticOrderC<66, 16>>(lds + RING_OFF, XN, (const bf16*)(ws + WS_WRGIN), MROWS, RGW, DM, G, bid, E); }
            SEAM(15);
#ifndef DIS_SCAN
            if (IN(16)) { for (int u = bid; u < 66 * 16; u += G) scan_unit<false>(args, ws, lds, u >> 4, u & 15, tid, wave, lane); }
            SEAM(16);
            if (IN(17)) { for (int u = bid; u < 64 * 16; u += G) scan_unit<true>(args, ws, lds, u >> 4, u & 15, tid, wave, lane); }
#endif
            SEAM(17);
            if (IN(18)) { pg8::EpiResid E{X, X + (size_t)NLAT * DM, X, modl + 5 * DM, MODW, 1.0f};
                run_gemm<pg8::EpiResid, pg8::StaticOrderC<64, 8>>(lds + RING_OFF, MIX, (const bf16*)(ws + WS_WRGOUT), NLAT, DM, DM, G, bid, E); }
            SEAM(18);
    }
    FFN_BLOCK(64, 3, 19);
    if (IN(22)) final_norm_phase(X, args.in[I_FNORM], args.out, gw, ngw, lane);
#undef IN
#undef SEAM
}

extern "C" void kernel_launch(void* const* d_in, const int* in_sizes, int n_in, void* d_out, int out_size, void* d_ws, size_t ws_size, hipStream_t stream) {
    static int grid = 0;
    if (grid == 0) {
        if (n_in != N_IN || in_sizes[0] != NLAT * DM || out_size != NLAT * DM || ws_size < WS_END) { fprintf(stderr, "kernel_launch: unexpected shapes (n_in %d, ws %zu)\n", n_in, ws_size); grid = -1; return; }
        int dev = 0, cus = 0, per_cu = 0;
        if (hipGetDevice(&dev) != hipSuccess || hipDeviceGetAttribute(&cus, hipDeviceAttributeMultiprocessorCount, dev) != hipSuccess) { grid = -1; return; }
        if (hipFuncSetAttribute((const void*)fwd_kernel, hipFuncAttributeMaxDynamicSharedMemorySize, LDS_BYTES) != hipSuccess) { fprintf(stderr, "kernel_launch: hipFuncSetAttribute failed\n"); grid = -1; return; }
        if (hipOccupancyMaxActiveBlocksPerMultiprocessor(&per_cu, (const void*)fwd_kernel, NTHR, LDS_BYTES) != hipSuccess || per_cu < 1) fprintf(stderr, "kernel_launch: occupancy query reports %d\n", per_cu);
        (void)hipGetLastError();
        grid = cus;
    }
    if (grid < 0) return;
    if (hipMemsetAsync((char*)d_ws + WS_CTL, 0, CTL_ZERO_BYTES, stream) != hipSuccess) return;
    Args a{};
    for (int i = 0; i < N_IN; ++i) a.in[i] = (const float*)d_in[i];
    a.out = (float*)d_out; a.ws = (unsigned char*)d_ws;
#if MK_ONE_LAUNCH
    a.ph_lo = 0; a.ph_hi = N_PHASES;
    hipLaunchKernelGGL(fwd_kernel, dim3(grid), dim3(NTHR), LDS_BYTES, stream, a);
#else
    for (int p = 0; p < N_PHASES; ++p) { a.ph_lo = p; a.ph_hi = p + 1; hipLaunchKernelGGL(fwd_kernel, dim3(grid), dim3(NTHR), LDS_BYTES, stream, a); }
#endif
}
```

```cpp
#include <hip/hip_runtime.h>
#include <cstdio>
#include <cstdint>
#ifndef PG8_WGM
#define PG8_WGM 8
#endif
namespace pg8 {
#define PG8_LAS __attribute__((address_space(3)))
typedef unsigned short bf16_t;
typedef short bf16x8 __attribute__((ext_vector_type(8)));
typedef float f32x4 __attribute__((ext_vector_type(4)));
typedef unsigned u32x4 __attribute__((ext_vector_type(4)));
constexpr int BM = 256, BK = 64, HALF = 128, HTB = HALF * BK * 2  , STAGE_BYTES = 8 * HTB, NXCD = 8, WGM = PG8_WGM;

__host__ __device__ __forceinline__ int lds_byte(int r, int c) { const int st = (r >> 4) * 2 + (c >> 5), rr = r & 15, cc = c & 31, ob = rr * 64 + cc * 2; return st * 1024 + (ob ^ (((ob >> 9) & 1) << 5)); }
__host__ __device__ __forceinline__ void stage_rc(int b, int& R, int& C) { const int st = b / 1024, sb = b % 1024, swz = sb ^ (((sb >> 9) & 1) << 5); R = (st >> 1) * 16 + swz / 64; C = (st & 1) * 32 + (swz % 64) / 2; }
__host__ __device__ __forceinline__ int perm32(int rho) { const int n = rho >> 4, i = rho & 15; return 8 * (i >> 2) + 4 * n + (i & 3); }

struct Unit { int pm, pn, kt0, nt, ks; };
struct Gemm { const bf16_t* A; const bf16_t* Bt; int ld; size_t kstepA, kstepB; int thr; };

__host__ __device__ __forceinline__ int xrank(int c, int slow) { return slow < 0 ? c : (((c & 7) == slow) ? 0x3fffffff : c - ((c + 7 - slow) >> 3)); }
template <int NM_, int NN_, int KT, int WGM_ = WGM> struct StaticOrderC {
    static constexpr int nM = NM_, nN = NN_, nwg = NM_ * NN_;
    int G, c, slow;
    __host__ __device__ __forceinline__ void init(int G_, int c_, int slow_ = -1) { G = G_; c = c_; slow = (G_ == 256) ? slow_ : -1; }
    static __host__ __device__ __forceinline__ void map(int L, int& pm, int& pn) {
        int wgid = L; { constexpr int q = nwg / NXCD, r = nwg % NXCD; const int xcd = wgid % NXCD, off = wgid / NXCD; wgid = (xcd < r ? xcd * (q + 1) : r * (q + 1) + (xcd - r) * q) + off; }
        constexpr int WGMv = WGM_; constexpr int nig = WGMv * nN; const int gid = wgid / nig, fm = gid * WGMv, gsz = (nM - fm) < WGMv ? (nM - fm) : WGMv;
        const int w = wgid - gid * nig;
        if (gsz == WGMv) { pm = fm + (w % WGMv); pn = w / WGMv; } else { pm = fm + (w % gsz); pn = w / gsz; }
    }
    __host__ __device__ __forceinline__ bool next(int i, Unit& u) const {
        const int full = nwg / G;
        int L = i * G + c;
        if (i >= full) { if (i > full) return false; const int rk = xrank(c, slow); if (rk >= nwg - full * G) return false; L = full * G + rk; }
        int pm, pn; map(L, pm, pn);
        u.pm = pm; u.pn = pn; u.kt0 = 0; u.nt = KT; u.ks = -1;
        return true;
    }
    __device__ __forceinline__ void a_ready(const Unit&) const {}
    __device__ __forceinline__ void done(const Unit&) const {}
};

template <int NN_, int KT> struct SplitCtxOrder {
    static constexpr int NPIECE = (KT == 88) ? 11 : 8, NLATU = 64 * NN_, NSUB = 2 * NN_ * NPIECE;
    int G, c, slow;
    __host__ __device__ __forceinline__ void init(int G_, int c_, int slow_ = -1) { G = G_; c = c_; slow = (G_ == 256) ? slow_ : -1; }
    static __host__ __device__ __forceinline__ void piece(int p, int& kt0, int& nt) {
        if (KT == 88) { nt = 8; kt0 = 8 * p; } else { nt = 4; kt0 = 4 * p; }
    }
    __host__ __device__ __forceinline__ bool next(int i, Unit& u) const {
        int pm, pn, kt0 = 0, nt = KT, ks = -1;
        const int rk = xrank(c, slow); const bool has_piece = rk < NSUB;
        if (has_piece && i == 0) { const int un = rk % (2 * NN_); ks = rk / (2 * NN_); pm = 64 + (un & 1); pn = un >> 1; piece(ks, kt0, nt); }
        else { const int L = (has_piece ? i - 1 : i) * G + c; if (L >= NLATU) return false; StaticOrderC<64, NN_, KT, (KT == 88 ? 4 : WGM)>::map(L, pm, pn); }
        u.pm = pm; u.pn = pn; u.kt0 = kt0; u.nt = nt; u.ks = ks;
        return true;
    }
    __device__ __forceinline__ void a_ready(const Unit&) const {}
    __device__ __forceinline__ void done(const Unit&) const {}
};

__device__ __forceinline__ unsigned cvt_pk_bf16(float lo, float hi) { unsigned r; asm volatile("v_cvt_pk_bf16_f32 %0, %1, %2" : "=v"(r) : "v"(lo), "v"(hi)); return r; }
constexpr int ROWS_LAT = 16384, D_MODEL = 2048;

struct EpiBf16 {
    static constexpr bool PERM = true, AFTER_DRAIN = false;
    bf16_t* O; int ldc;
    __device__ __forceinline__ void operator()(const f32x4 (&acc)[2][2][4][2], const Unit& u, int wr, int wc, int fr, int fq) const {
        const int row0 = u.pm * BM + wr * 64 + fr; const int col0 = u.pn * BM + wc * 32 + 8 * fq;
#pragma unroll
        for (int ai = 0; ai < 2; ++ai)
#pragma unroll
            for (int m = 0; m < 4; ++m) { bf16_t* rowp = O + (size_t)(row0 + ai * HALF + m * 16) * ldc + col0;
#pragma unroll
                for (int bj = 0; bj < 2; ++bj) { const f32x4 v0 = acc[ai][bj][m][0], v1 = acc[ai][bj][m][1];
                    u32x4 w; w.x = cvt_pk_bf16(v0[0], v0[1]); w.y = cvt_pk_bf16(v0[2], v0[3]); w.z = cvt_pk_bf16(v1[0], v1[1]); w.w = cvt_pk_bf16(v1[2], v1[3]);
                    *(u32x4*)(rowp + bj * HALF) = w; } }
    }
};
__device__ __forceinline__ float silu_f(float g) { return g * __builtin_amdgcn_rcpf(1.0f + __expf(-g)); }
struct EpiSwiGLU {
    static constexpr bool PERM = true, AFTER_DRAIN = false;
    bf16_t* H; int mrows;
    __device__ __forceinline__ void operator()(const f32x4 (&acc)[2][2][4][2], const Unit& u, int wr, int wc, int fr, int fq) const {
        const int row0 = u.pm * BM + wr * 64 + fr; const int col0 = u.pn * HALF + wc * 32 + 8 * fq;
#pragma unroll
        for (int ai = 0; ai < 2; ++ai)
#pragma unroll
            for (int m = 0; m < 4; ++m) { const int rr = row0 + ai * HALF + m * 16;
                bf16_t* rowp = (bf16_t*)((char*)H + ((size_t)(col0 >> 6) * (mrows >> 7) + (rr >> 7)) * HTB + lds_byte(rr & 127, col0 & 63));
                const f32x4 g0 = acc[ai][0][m][0], g1 = acc[ai][0][m][1], u0 = acc[ai][1][m][0], u1 = acc[ai][1][m][1];
                u32x4 w;
                w.x = cvt_pk_bf16(silu_f(g0[0]) * u0[0], silu_f(g0[1]) * u0[1]); w.y = cvt_pk_bf16(silu_f(g0[2]) * u0[2], silu_f(g0[3]) * u0[3]);
                w.z = cvt_pk_bf16(silu_f(g1[0]) * u1[0], silu_f(g1[1]) * u1[1]); w.w = cvt_pk_bf16(silu_f(g1[2]) * u1[2], silu_f(g1[3]) * u1[3]);
                *(u32x4*)rowp = w; }
    }
};
struct EpiResid {
    static constexpr bool PERM = true, AFTER_DRAIN = false;
    const float* resLatF; const float* resCtxF; bf16_t* X; const float* gate; int gstride; float gscale; float* slab;
    __device__ __forceinline__ void operator()(const f32x4 (&acc)[2][2][4][2], const Unit& u, int wr, int wc, int fr, int fq) const {
        const int v = u.pm < 32 ? 0 : (u.pm < 64 ? 1 : 2);
        const float* gv = gate + (size_t)v * gstride;
        const int col0 = u.pn * BM + wc * 32 + 8 * fq;
        f32x4 gvec[2][2];
#pragma unroll
        for (int bj = 0; bj < 2; ++bj)
#pragma unroll
            for (int n = 0; n < 2; ++n) gvec[bj][n] = *(const f32x4*)(gv + col0 + bj * HALF + n * 4) * gscale;
#pragma unroll
        for (int ai = 0; ai < 2; ++ai)
#pragma unroll
            for (int m = 0; m < 4; ++m) { const int row = u.pm * BM + ai * HALF + wr * 64 + m * 16 + fr;
                bf16_t* xp = X + (size_t)row * D_MODEL;
                if (u.ks >= 0) {
                    bf16_t* sp = (bf16_t*)slab + ((size_t)u.ks * 512 + (row - ROWS_LAT)) * D_MODEL;
#pragma unroll
                    for (int bj = 0; bj < 2; ++bj) { const int c = col0 + bj * HALF; const f32x4 o0 = gvec[bj][0] * acc[ai][bj][m][0], o1 = gvec[bj][1] * acc[ai][bj][m][1];
                        u32x4 w; w.x = cvt_pk_bf16(o0[0], o0[1]); w.y = cvt_pk_bf16(o0[2], o0[3]); w.z = cvt_pk_bf16(o1[0], o1[1]); w.w = cvt_pk_bf16(o1[2], o1[3]);
                        *(u32x4*)(sp + c) = w; }
                } else {
#pragma unroll
                    for (int bj = 0; bj < 2; ++bj) { const int c = col0 + bj * HALF; f32x4 r0, r1;
                        if (resLatF) { const float* rp = ((row < ROWS_LAT) ? resLatF + (size_t)row * D_MODEL : resCtxF + (size_t)(row - ROWS_LAT) * D_MODEL) + c;
                            r0 = *(const f32x4*)rp; r1 = *(const f32x4*)(rp + 4); }
                        else { const u32x4 rw = *(const u32x4*)(xp + c);
                            r0 = (f32x4){__builtin_bit_cast(float, rw.x << 16), __builtin_bit_cast(float, rw.x & 0xffff0000u), __builtin_bit_cast(float, rw.y << 16), __builtin_bit_cast(float, rw.y & 0xffff0000u)};
                            r1 = (f32x4){__builtin_bit_cast(float, rw.z << 16), __builtin_bit_cast(float, rw.z & 0xffff0000u), __builtin_bit_cast(float, rw.w << 16), __builtin_bit_cast(float, rw.w & 0xffff0000u)}; }
                        const f32x4 o0 = r0 + gvec[bj][0] * acc[ai][bj][m][0], o1 = r1 + gvec[bj][1] * acc[ai][bj][m][1];
                        u32x4 w; w.x = cvt_pk_bf16(o0[0], o0[1]); w.y = cvt_pk_bf16(o0[2], o0[3]); w.z = cvt_pk_bf16(o1[0], o1[1]); w.w = cvt_pk_bf16(o1[2], o1[3]);
                        *(u32x4*)(xp + c) = w; }
                }
                if (m & 1) asm volatile("" ::: "memory"); }
    }
};

struct EpiNull {
    static constexpr bool PERM = true, AFTER_DRAIN = false;
    __device__ __forceinline__ void operator()(const f32x4 (&acc)[2][2][4][2], const Unit& u, int wr, int wc, int fr, int fq) const {
#pragma unroll
        for (int ai = 0; ai < 2; ++ai)
#pragma unroll
            for (int bj = 0; bj < 2; ++bj)
#pragma unroll
                for (int m = 0; m < 4; ++m)
#pragma unroll
                    for (int n = 0; n < 2; ++n) asm volatile("" :: "v"(acc[ai][bj][m][n]));
    }
};
template <class Epi, class Sched, bool ALIGN_EPI = false, bool SP2 = false>
__device__ __forceinline__ void gemm_phase(PG8_LAS unsigned char* lds, const Gemm g, const Sched& S, const Epi& E) {
    const int tid = threadIdx.x, wid = __builtin_amdgcn_readfirstlane(tid >> 6), lane = tid & 63, wr = wid >> 2, wc = wid & 3, fr = lane & 15, fq = lane >> 4;
    unsigned voffA[2], voffB[2];
#pragma unroll
    for (int i = 0; i < 2; ++i) { int R, C; stage_rc(tid * 16 + i * 8192, R, C); const int Rb = Epi::PERM ? ((R & ~31) + perm32(R & 31)) : R;
        voffA[i] = g.ld ? (unsigned)(R * g.ld + C) * 2u : (unsigned)(tid * 16 + i * 8192); voffB[i] = g.ld ? (unsigned)(Rb * g.ld + C) * 2u : (unsigned)(tid * 16 + i * 8192); }
    const size_t kstepA = g.kstepA, kstepB = g.kstepB;
    const size_t hstep = g.ld ? (size_t)HALF * g.ld * 2 : (size_t)HTB;
    const size_t tstep = 2 * hstep;
    const unsigned ldsw = (unsigned)wid * 1024u;
    const int aoff = lds_byte(wr * 64 + fr, fq * 8), boff = lds_byte(wc * 32 + fr, fq * 8);
#define PG8_SA(b, h) (((b) * 2 + (h)) * HTB)
#define PG8_SB(b, h) ((4 + (b) * 2 + (h)) * HTB)
#define PG8_STAGE(bufoff, gbase, voff) do { _Pragma("unroll") for (int _i = 0; _i < 2; ++_i) \
        __builtin_amdgcn_global_load_lds((const unsigned*)((const char*)(gbase) + (voff)[_i]), (PG8_LAS unsigned*)(lds + (bufoff) + ldsw + _i * 8192), 16, 0, 0); } while (0)
#define PG8_LDA(dst, b, h) do { _Pragma("unroll") for (int m = 0; m < 4; ++m) _Pragma("unroll") for (int k = 0; k < 2; ++k) dst[m][k] = *(const PG8_LAS bf16x8*)(lds + PG8_SA(b, h) + aoff + m * 2048 + k * 1024); } while (0)
#define PG8_LDB(dst, b, h) do { _Pragma("unroll") for (int n = 0; n < 2; ++n) _Pragma("unroll") for (int k = 0; k < 2; ++k) dst[n][k] = *(const PG8_LAS bf16x8*)(lds + PG8_SB(b, h) + boff + n * 2048 + k * 1024); } while (0)
#define PG8_MMA(ai, bj, At, Bt) do { __builtin_amdgcn_s_setprio(1); _Pragma("unroll") for (int m = 0; m < 4; ++m) _Pragma("unroll") for (int n = 0; n < 2; ++n) _Pragma("unroll") for (int k = 0; k < 2; ++k) \
        acc[ai][bj][m][n] = __builtin_amdgcn_mfma_f32_16x16x32_bf16(Bt[n][k], At[m][k], acc[ai][bj][m][n], 0, 0, 0); __builtin_amdgcn_s_setprio(0); } while (0)
#define PG8_WAIT_V(n) asm volatile("s_waitcnt vmcnt(" #n ")" ::: "memory")
#define PG8_WAIT_L(n) asm volatile("s_waitcnt lgkmcnt(" #n ")" ::: "memory")
#define PG8_BAR __builtin_amdgcn_s_barrier()
#define PG8_SCHED __builtin_amdgcn_sched_barrier(0)
    Unit cur, nxt; int ui = 0;
    if (!S.next(0, cur)) return;
    f32x4 acc[2][2][4][2];
#pragma unroll
    for (int a = 0; a < 2; ++a)
#pragma unroll
        for (int b = 0; b < 2; ++b)
#pragma unroll
            for (int m = 0; m < 4; ++m)
#pragma unroll
                for (int n = 0; n < 2; ++n) acc[a][b][m][n] = (f32x4){0.f, 0.f, 0.f, 0.f};
    bf16x8 At[4][2], B0[2][2], B1[2][2];
    const char* cA = (const char*)g.A + (size_t)cur.pm * tstep + (size_t)cur.kt0 * kstepA; const char* cB = (const char*)g.Bt + (size_t)cur.pn * tstep + (size_t)cur.kt0 * kstepB;
    S.a_ready(cur);
    if constexpr (SP2) {
        PG8_STAGE(PG8_SB(0, 0), cB, voffB); PG8_STAGE(PG8_SB(0, 1), cB + hstep, voffB); PG8_STAGE(PG8_SA(0, 0), cA, voffA); PG8_STAGE(PG8_SA(0, 1), cA + hstep, voffA);
        if (wr == 1) PG8_BAR;
        PG8_WAIT_V(2); PG8_BAR;
        PG8_STAGE(PG8_SB(1, 0), cB + kstepB, voffB); PG8_STAGE(PG8_SA(1, 0), cA + kstepA, voffA); PG8_STAGE(PG8_SB(1, 1), cB + hstep + kstepB, voffB);
        PG8_WAIT_V(6); PG8_BAR;
    } else {
        PG8_STAGE(PG8_SB(0, 0), cB, voffB); PG8_STAGE(PG8_SA(0, 0), cA, voffA); PG8_STAGE(PG8_SB(0, 1), cB + hstep, voffB); PG8_STAGE(PG8_SA(0, 1), cA + hstep, voffA);
        if (wr == 1) PG8_BAR;
        PG8_WAIT_V(4); PG8_BAR;
        PG8_STAGE(PG8_SB(1, 0), cB + kstepB, voffB); PG8_STAGE(PG8_SA(1, 0), cA + kstepA, voffA); PG8_STAGE(PG8_SB(1, 1), cB + hstep + kstepB, voffB);
        PG8_WAIT_V(6); PG8_BAR;
    }
    for (;;) {
        const bool has_next = S.next(ui + 1, nxt);
        const char* nA = has_next ? (const char*)g.A + (size_t)nxt.pm * tstep + (size_t)nxt.kt0 * kstepA : cA; const char* nB = has_next ? (const char*)g.Bt + (size_t)nxt.pn * tstep + (size_t)nxt.kt0 * kstepB : cB;
        const int nt = cur.nt;
        for (int t = 0; t < nt; t += 2) {
            const bool last = (t == nt - 2);
#if defined(EXP_THR)
            if (g.thr > 0) __builtin_amdgcn_s_sleep(EXP_THR);
#endif
            const char* a1 = cA + (size_t)(t + 1) * kstepA;
            const char* a2 = last ? nA : cA + (size_t)(t + 2) * kstepA; const char* b2 = last ? nB : cB + (size_t)(t + 2) * kstepB;
            const char* a3 = a2 + kstepA; const char* b3 = b2 + kstepB;
            if (last && has_next) S.a_ready(nxt);
            if constexpr (SP2) {
            PG8_LDB(B0, 0, 0); PG8_LDB(B1, 0, 1); PG8_SCHED; PG8_LDA(At, 0, 0); PG8_STAGE(PG8_SA(1, 1), a1 + hstep, voffA);
            PG8_WAIT_V(8); PG8_WAIT_L(0); PG8_BAR; PG8_MMA(0, 0, At, B0); PG8_MMA(0, 1, At, B1); PG8_BAR; PG8_SCHED;
            PG8_LDA(At, 0, 1); PG8_STAGE(PG8_SB(0, 0), b2, voffB); PG8_STAGE(PG8_SB(0, 1), b2 + hstep, voffB); PG8_STAGE(PG8_SA(0, 0), a2, voffA);
            PG8_WAIT_V(8); PG8_WAIT_L(0); PG8_BAR; PG8_MMA(1, 0, At, B0); PG8_MMA(1, 1, At, B1); PG8_BAR; PG8_SCHED;
            PG8_LDB(B0, 1, 0); PG8_LDB(B1, 1, 1); PG8_SCHED; PG8_LDA(At, 1, 0); PG8_STAGE(PG8_SA(0, 1), a2 + hstep, voffA);
            PG8_WAIT_V(8); PG8_WAIT_L(0); PG8_BAR; PG8_MMA(0, 0, At, B0); PG8_MMA(0, 1, At, B1); PG8_BAR; PG8_SCHED;
            PG8_LDA(At, 1, 1); PG8_STAGE(PG8_SB(1, 0), b3, voffB); PG8_STAGE(PG8_SB(1, 1), b3 + hstep, voffB); PG8_STAGE(PG8_SA(1, 0), a3, voffA);
            PG8_WAIT_V(8); PG8_WAIT_L(0); PG8_BAR; PG8_MMA(1, 0, At, B0); PG8_MMA(1, 1, At, B1); PG8_BAR; PG8_SCHED;
            } else {
            PG8_LDB(B0, 0, 0); PG8_SCHED; PG8_LDA(At, 0, 0); PG8_STAGE(PG8_SA(1, 1), a1 + hstep, voffA);
            PG8_WAIT_L(8); PG8_BAR; PG8_WAIT_L(0); PG8_MMA(0, 0, At, B0); PG8_BAR; PG8_SCHED;
            PG8_LDB(B1, 0, 1); PG8_STAGE(PG8_SB(0, 0), b2, voffB);
            PG8_BAR; PG8_WAIT_L(0); PG8_MMA(0, 1, At, B1); PG8_BAR;
            PG8_LDA(At, 0, 1); PG8_STAGE(PG8_SA(0, 0), a2, voffA);
            PG8_BAR; PG8_WAIT_L(0); PG8_MMA(1, 0, At, B0); PG8_BAR; PG8_SCHED;
            PG8_STAGE(PG8_SB(0, 1), b2 + hstep, voffB);
            PG8_WAIT_V(6); PG8_BAR; PG8_MMA(1, 1, At, B1); PG8_BAR;
            PG8_LDB(B0, 1, 0); PG8_SCHED; PG8_LDA(At, 1, 0); PG8_STAGE(PG8_SA(0, 1), a2 + hstep, voffA);
            PG8_WAIT_L(8); PG8_BAR; PG8_WAIT_L(0); PG8_MMA(0, 0, At, B0); PG8_BAR; PG8_SCHED;
            PG8_LDB(B1, 1, 1); PG8_STAGE(PG8_SB(1, 0), b3, voffB);
            PG8_BAR; PG8_WAIT_L(0); PG8_MMA(0, 1, At, B1); PG8_BAR;
            PG8_LDA(At, 1, 1); PG8_STAGE(PG8_SA(1, 0), a3, voffA);
            PG8_BAR; PG8_WAIT_L(0); PG8_MMA(1, 0, At, B0); PG8_BAR; PG8_SCHED;
            PG8_STAGE(PG8_SB(1, 1), b3 + hstep, voffB);
            PG8_WAIT_V(6); PG8_BAR; PG8_MMA(1, 1, At, B1); PG8_BAR;
            }
        }
        if constexpr (ALIGN_EPI) { if (wr == 0) PG8_BAR; }
        if constexpr (!Epi::AFTER_DRAIN) { E(acc, cur, wr, wc, fr, fq);
#if defined(REP_EPI)
            if constexpr (Epi::PERM) { asm volatile("" ::: "memory"); E(acc, cur, wr, wc, fr, fq); }
#endif
            S.done(cur); }
        if (!has_next) break;
#pragma unroll
        for (int a = 0; a < 2; ++a)
#pragma unroll
            for (int b = 0; b < 2; ++b)
#pragma unroll
                for (int m = 0; m < 4; ++m)
#pragma unroll
                    for (int n = 0; n < 2; ++n) acc[a][b][m][n] = (f32x4){0.f, 0.f, 0.f, 0.f};
        cur = nxt; cA = nA; cB = nB; ++ui;
        if constexpr (ALIGN_EPI) { if (wr == 1) PG8_BAR; }
    }
    PG8_WAIT_V(0);
    if constexpr (!ALIGN_EPI) { if (wr == 0) PG8_BAR; }
    PG8_BAR;
    if constexpr (Epi::AFTER_DRAIN) { E.fused(acc, cur, wr, wc, fr, fq, lds, wid, lane); S.done(cur); }
#undef PG8_SA
#undef PG8_SB
#undef PG8_STAGE
#undef PG8_LDA
#undef PG8_LDB
#undef PG8_MMA
#undef PG8_WAIT_V
#undef PG8_WAIT_L
#undef PG8_BAR
#undef PG8_SCHED
}
}
#define GAS __attribute__((address_space(1)))
#define LAS __attribute__((address_space(3)))
typedef unsigned short bf16;
typedef unsigned v4u __attribute__((ext_vector_type(4)));
typedef float f32x4 __attribute__((ext_vector_type(4)));
typedef short bf16x8 __attribute__((ext_vector_type(8)));
typedef GAS unsigned gu32;
typedef GAS unsigned long long gu64;
#define RLX_AGENT __ATOMIC_RELAXED, __HIP_MEMORY_SCOPE_AGENT
#define LDS_WAIT() asm volatile("s_waitcnt lgkmcnt(0)" ::: "memory")
#define VM_WAIT() asm volatile("s_waitcnt vmcnt(0)" ::: "memory")
__device__ __forceinline__ unsigned long long rt() { return __builtin_amdgcn_s_memrealtime(); }
__device__ __forceinline__ unsigned f2bf(float f) { unsigned u = __builtin_bit_cast(unsigned, f); return (u + 0x7fffu + ((u >> 16) & 1u)) >> 16; }
__device__ __forceinline__ unsigned pk2(float lo, float hi) { return f2bf(lo) | (f2bf(hi) << 16); }

#define XB_TMO      128
#define XB_XCNT(j)  (256  + 64 * (j))
#define XB_XSUB(j)  (1280 + 64 * (j))
#define XB_XGEN(j)  (2304 + 64 * (j))
#define XB_TOP      3328
#define XB_TOPGEN   3392
#define XCD_BAR_WORDS 3456
#define XB_SPIN_CAP (1u << 18)

__device__ __forceinline__ unsigned xb_ld(unsigned* p)              { return __hip_atomic_load(p, __ATOMIC_RELAXED, __HIP_MEMORY_SCOPE_AGENT); }
__device__ __forceinline__ unsigned xb_add(unsigned* p, unsigned v) { return __hip_atomic_fetch_add(p, v, __ATOMIC_RELAXED, __HIP_MEMORY_SCOPE_AGENT); }
__device__ __forceinline__ unsigned xb_xcc_id() { return (unsigned)__builtin_amdgcn_s_getreg((3 << 11) | 20) & 0xFu; }
#define XB_SPIN(cond, bar) do { unsigned _sp = 0; while (cond) { __builtin_amdgcn_s_sleep(1); \
    if ((++_sp & 255u) == 0u) { if (xb_ld(&(bar)[XB_TMO])) break; if (_sp > XB_SPIN_CAP) { atomicAdd(&(bar)[XB_TMO], 1u); break; } } } } while (0)

struct XcdBarrier {
    unsigned* bar; unsigned x;
    volatile LAS unsigned* st;
};

__device__ __forceinline__ XcdBarrier xcd_barrier_post(unsigned* bar, volatile LAS unsigned* st) {
    XcdBarrier b; b.bar = bar; b.x = xb_xcc_id(); b.st = st;
    if (threadIdx.x == 0) (void)xb_add(&bar[XB_XCNT(b.x)], 1u);
    return b;
}
__device__ __forceinline__ void xcd_barrier_complete(unsigned* bar, unsigned x, unsigned& nloc, unsigned& nx) {
    const unsigned G = gridDim.x * gridDim.y * gridDim.z;
    unsigned sum, cnt, mine, sp = 0u;
    for (;;) {
        sum = 0u; cnt = 0u; mine = 0u;
#pragma unroll
        for (unsigned j = 0; j < 16; ++j) { const unsigned c = xb_ld(&bar[XB_XCNT(j)]); sum += c; cnt += (c > 0u) ? 1u : 0u; mine = (j == x) ? c : mine; }
        if (sum == G) break;
        __builtin_amdgcn_s_sleep(1);
        if ((++sp & 255u) == 0u) { if (xb_ld(&bar[XB_TMO])) break; if (sp > XB_SPIN_CAP) { atomicAdd(&bar[XB_TMO], 1u); break; } }
    }
    nloc = mine > 0u ? mine : 1u; nx = cnt > 0u ? cnt : 1u;
}

__device__ __forceinline__ void xcd_barrier(const XcdBarrier& b) {
    asm volatile("s_waitcnt vmcnt(0)" ::: "memory");
    __syncthreads();
    if (threadIdx.x == 0) {
        unsigned* bar = b.bar;
        __builtin_amdgcn_s_waitcnt(0);
        unsigned nloc = b.st[0], nx = b.st[1];
        if (nloc == 0u) { xcd_barrier_complete(bar, b.x, nloc, nx); b.st[0] = nloc; b.st[1] = nx; }
        const unsigned old = xb_add(&bar[XB_XSUB(b.x)], 1u);
        const unsigned gen = old / nloc;
        if (old + 1u == (gen + 1u) * nloc) {
            __builtin_amdgcn_fence(__ATOMIC_RELEASE, "agent");
            asm volatile("s_waitcnt vmcnt(0)" ::: "memory");
            const unsigned og = xb_add(&bar[XB_TOP], 1u);
            const unsigned tg = og / nx;
            if (og + 1u == (tg + 1u) * nx) xb_add(&bar[XB_TOPGEN], 1u);
            else XB_SPIN(xb_ld(&bar[XB_TOPGEN]) == tg, bar);
            __builtin_amdgcn_fence(__ATOMIC_ACQUIRE, "agent");
            xb_add(&bar[XB_XGEN(b.x)], 1u);
            asm volatile("s_waitcnt vmcnt(0)" ::: "memory");
        } else {
            XB_SPIN(xb_ld(&bar[XB_XGEN(b.x)]) == gen, bar);
            __builtin_amdgcn_fence(__ATOMIC_ACQUIRE, "agent");
            asm volatile("s_waitcnt vmcnt(0)" ::: "memory");
        }
    }
    __syncthreads();
}

constexpr int NWAVES = 8, NTHR = 512;
constexpr int DM = 2048, DFF = 5632, SEQ = 8192, CTXL = 256, NB = 2;
constexpr int NLAT = NB * SEQ, NCTXR = NB * CTXL, MROWS = NLAT + NCTXR;
constexpr int NMOD = 9, MODW = NMOD * DM;
constexpr int ABW = 4608, RGW = 4096, HD = 128;
constexpr float EPS = 1e-6f;
enum { I_X = 0, I_C, I_CTX, I_CCTX, I_WMOD, I_BMOD, I_NF1, I_NMIX, I_NF2, I_F1IN, I_F1OUT, I_F2IN, I_F2OUT, I_ABIN, I_ABOUT, I_SINK, I_ABCONV,
       I_RGIN, I_RGCONVW, I_RGCONVB, I_RGWA, I_RGBA, I_RGWX, I_RGBX, I_RGLAM, I_RGOUT, I_FNORM, N_IN };

constexpr size_t MiB = 1u << 20;
constexpr size_t WS_CTL = 0, CTL_ZERO_BYTES = 1 * MiB;
constexpr size_t WS_MOD = 1 * MiB;
constexpr size_t WS_ROPE = 1 * MiB + 512 * 1024;
constexpr size_t WS_WIN = 2 * MiB, WIN_BYTES = 44 * MiB;
constexpr size_t WS_WOUT = WS_WIN + 4 * WIN_BYTES, WOUT_BYTES = 22 * MiB;
constexpr size_t WS_WABIN = WS_WOUT + 4 * WOUT_BYTES;
constexpr size_t WS_WABOUT = WS_WABIN + 18 * MiB;
constexpr size_t WS_WRGIN = WS_WABOUT + 8 * MiB;
constexpr size_t WS_WRGOUT = WS_WRGIN + 16 * MiB;
constexpr size_t WS_WGATE = WS_WRGOUT + 8 * MiB;
constexpr size_t WS_X = WS_WGATE + 2 * MiB;
constexpr size_t WS_XN = WS_X + 132 * MiB;
constexpr size_t WS_H = WS_XN + 66 * MiB;
constexpr size_t WS_MIX = WS_H + 182 * MiB;
constexpr size_t WS_CS = WS_MIX + 66 * MiB;
constexpr size_t WS_PS = WS_CS + 17 * MiB;
constexpr size_t WS_SLAB = WS_PS + 3 * MiB;
constexpr size_t WS_ABH = WS_SLAB + 44 * MiB;
constexpr size_t WS_END = WS_ABH + 256 * MiB;
static_assert(WS_END <= 1140 * MiB, "d_ws map");
constexpr int CW_BAR = 4096;

constexpr int RING_OFF = 0, RING_BYTES = 131072;
constexpr int LDSCTL_OFF = RING_BYTES, MISC_OFF = LDSCTL_OFF + 320;
constexpr int LDS_BYTES = 147456;
struct Args { const float* in[27]; float* out; unsigned char* ws; int ph_lo, ph_hi; };

typedef float f32x2 __attribute__((ext_vector_type(2)));
typedef unsigned u32x2 __attribute__((ext_vector_type(2)));
typedef unsigned u32x4 __attribute__((ext_vector_type(4)));
__device__ __forceinline__ float wave_sum(float v) {
#pragma unroll
    for (int o = 1; o < 64; o <<= 1) v += __shfl_xor(v, o);
    return v;
}
__device__ __forceinline__ float bf_lo(unsigned w) { return __builtin_bit_cast(float, w << 16); }
__device__ __forceinline__ float bf_hi(unsigned w) { return __builtin_bit_cast(float, w & 0xffff0000u); }
__device__ __forceinline__ unsigned cvtpk(float lo, float hi) { unsigned r; asm volatile("v_cvt_pk_bf16_f32 %0, %1, %2" : "=v"(r) : "v"(lo), "v"(hi)); return r; }

#ifndef XN_IMG
#define XN_IMG 1
#endif
__device__ __forceinline__ int perm32_inv(int x) { return 16 * ((x >> 2) & 1) + 4 * (x >> 3) + (x & 3); }
__device__ __forceinline__ void conv_tile(const float* __restrict__ W, int N, bf16* __restrict__ Wt, int K, int k0, int n0, int drow0, LAS unsigned* scr, int lane, int tiled_rows = 0, bool perm = false) {
    const int kpl = lane >> 4, ng = lane & 15;
#pragma unroll 4
    for (int i = 0; i < 8; ++i) {
        const int kp = 4 * i + kpl;
        const float* src = W + (size_t)(k0 + 2 * kp) * N + n0 + 4 * ng;
        const f32x4 a = *(const f32x4*)src, b = *(const f32x4*)(src + N);
        LAS unsigned* d = scr + (4 * ng) * 33 + kp;
        d[0] = pk2(a.x, b.x); d[33] = pk2(a.y, b.y); d[66] = pk2(a.z, b.z); d[99] = pk2(a.w, b.w);
    }
    LDS_WAIT(); asm volatile("" ::: "memory");
    const int c = lane & 7;
#pragma unroll
    for (int j = 0; j < 8; ++j) { const int n = (lane >> 3) + 8 * j; const LAS unsigned* s = scr + n * 33 + 4 * c;
        v4u o; o.x = s[0]; o.y = s[1]; o.z = s[2]; o.w = s[3];
        const int jr = drow0 + n, jl = jr & 127, R = perm ? ((jl & ~31) + perm32_inv(jl & 31)) : jl;
        bf16* dp = tiled_rows ? (bf16*)((char*)Wt + ((size_t)(k0 >> 6) * (tiled_rows >> 7) + (jr >> 7)) * pg8::HTB + pg8::lds_byte(R, 8 * c)) : Wt + (size_t)(drow0 + n) * K + k0 + 8 * c;
        *(GAS v4u*)dp = o; }
    LDS_WAIT(); asm volatile("" ::: "memory");
}
__device__ __forceinline__ void conv_mat_tile(const float* W, int K, int N, bf16* Wt, int mode, int r, LAS unsigned* scr, int lane, int tiled_rows = 0, bool perm = false) {
    const int nblk = N / 64, kb = r / nblk, nb = r % nblk, n0 = 64 * nb;
    int drow0 = n0;
    if (mode == 1) { const int half = n0 >= DFF ? 1 : 0, nn = n0 - half * DFF; drow0 = (nn >> 7) * 256 + half * 128 + (nn & 127); }
    conv_tile(W, N, Wt, K, 64 * kb, n0, drow0, scr, lane, tiled_rows, perm);
}
constexpr int T_WIN = (DM / 64) * (2 * DFF / 64), T_WOUT = (DFF / 64) * (DM / 64), T_ABIN = (DM / 64) * (ABW / 64), T_SQ = (DM / 64) * (DM / 64), T_RGIN = (DM / 64) * (RGW / 64), T_GATE = 64 * 4;
constexpr int T_TOTAL = 4 * T_WIN + 4 * T_WOUT + T_ABIN + T_SQ + T_RGIN + T_SQ + T_GATE;

constexpr int TL_WIN = 0, TL_WOUT = 4 * T_WIN, TL_ABIN = TL_WOUT + 4 * T_WOUT, TL_ABOUT = TL_ABIN + T_ABIN, TL_RGIN = TL_ABOUT + T_SQ, TL_RGOUT = TL_RGIN + T_RGIN, TL_GATE = TL_RGOUT + T_SQ;
static_assert(TL_GATE + T_GATE == T_TOTAL, "tile list");
__device__ __forceinline__ void convert_ranges(const Args& a, unsigned char* ws, LAS unsigned char* lds, int a0, int a1, int b0, int b1, int widx, int nw, int wave, int lane) {
    LAS unsigned* scr = (LAS unsigned*)(lds + 49152 + wave * 8704);
    const int na = a1 - a0, ntot = na + (b1 - b0);
    for (int it = widx; it < ntot; it += nw) {
        int r = it < na ? a0 + it : b0 + (it - na);
        if (r < 4 * T_WIN) { const int s = r / T_WIN; r -= s * T_WIN; const int l = s >> 1;
            const float* W = ((s & 1) ? a.in[I_F2IN] : a.in[I_F1IN]) + (size_t)l * DM * 2 * DFF;
            conv_mat_tile(W, DM, 2 * DFF, (bf16*)(ws + WS_WIN + (size_t)s * WIN_BYTES), 1, r, scr, lane, XN_IMG ? 2 * DFF : 0, true); continue; }
        r -= 4 * T_WIN;
        if (r < 4 * T_WOUT) { const int s = r / T_WOUT; r -= s * T_WOUT; const int l = s >> 1;
            const float* W = ((s & 1) ? a.in[I_F2OUT] : a.in[I_F1OUT]) + (size_t)l * DFF * DM;
            conv_mat_tile(W, DFF, DM, (bf16*)(ws + WS_WOUT + (size_t)s * WOUT_BYTES), 0, r, scr, lane, DM, true); continue; }
        r -= 4 * T_WOUT;
        if (r < T_ABIN) { conv_mat_tile(a.in[I_ABIN], DM, ABW, (bf16*)(ws + WS_WABIN), 0, r, scr, lane, XN_IMG ? ABW : 0, true); continue; }
        r -= T_ABIN;
        if (r < T_SQ) { conv_mat_tile(a.in[I_ABOUT], DM, DM, (bf16*)(ws + WS_WABOUT), 0, r, scr, lane); continue; }
        r -= T_SQ;
        if (r < T_RGIN) { conv_mat_tile(a.in[I_RGIN], DM, RGW, (bf16*)(ws + WS_WRGIN), 0, r, scr, lane, XN_IMG ? RGW : 0, true); continue; }
        r -= T_RGIN;
        if (r < T_SQ) { conv_mat_tile(a.in[I_RGOUT], DM, DM, (bf16*)(ws + WS_WRGOUT), 0, r, scr, lane); continue; }
        r -= T_SQ;
        {
            const int mi = r >> 2, t = r & 3, d = mi >> 5, g = (mi >> 4) & 1, h = mi & 15;
            const float* W = (g ? a.in[I_RGWX] : a.in[I_RGWA]) + (size_t)(d * 16 + h) * 128 * 128;
            conv_mat_tile(W, 128, 128, (bf16*)(ws + WS_WGATE) + (size_t)mi * 128 * 128, 0, t, scr, lane);
        }
    }
}
__device__ __forceinline__ void mod_gemv_task(const Args& a, unsigned char* ws, LAS unsigned char* lds, int t, int tid, int wave, int lane) {
    LAS float* SC = (LAS float*)lds;
    LAS float* RED = (LAS float*)(lds + 24576);
    const int l = t / 144, cb = t % 144, n = 128 * cb + 2 * lane;
    const float* W = a.in[I_WMOD] + ((size_t)l * DM + 256 * wave) * MODW + n;
    f32x2 acc0 = {0.f, 0.f}, acc1 = acc0, acc2 = acc0;
#pragma unroll 32
    for (int k = 0; k < 256; ++k) {
        const f32x2 w = *(const f32x2*)(W + (size_t)k * MODW);
        const int kk = 256 * wave + k;
        acc0 += w * SC[kk]; acc1 += w * SC[2048 + kk]; acc2 += w * SC[4096 + kk];
    }
    LAS f32x2* R2 = (LAS f32x2*)RED;
    R2[(wave * 3 + 0) * 64 + lane] = acc0; R2[(wave * 3 + 1) * 64 + lane] = acc1; R2[(wave * 3 + 2) * 64 + lane] = acc2;
    __syncthreads();
    for (int o = tid; o < 384; o += NTHR) { const int v = o >> 7, j = o & 127; float s = a.in[I_BMOD][(size_t)l * MODW + 128 * cb + j];
#pragma unroll
        for (int w = 0; w < 8; ++w) s += RED[(w * 3 + v) * 128 + j];
        ((float*)(ws + WS_MOD))[((size_t)l * 3 + v) * MODW + 128 * cb + j] = s; }
    __syncthreads();
}
__device__ __forceinline__ void mod_gemv_tasks(const Args& a, unsigned char* ws, LAS unsigned char* lds, int t0, int t1, int worker, int nworkers, int tid, int wave, int lane) {
    if (t0 + worker >= t1) return;
    LAS float* SC = (LAS float*)lds;
    for (int i = tid; i < 3 * DM; i += NTHR) { const int v = i / DM, k = i % DM; const float c = (v < 2) ? a.in[I_C][v * DM + k] : a.in[I_CCTX][k];
        SC[i] = c / (1.0f + __expf(-c)); }
    __syncthreads();
    for (int t = t0 + worker; t < t1; t += nworkers) mod_gemv_task(a, ws, lds, t, tid, wave, lane);
}
__device__ __forceinline__ void p0_prologue(const Args& a, unsigned char* ws, LAS unsigned char* lds, int G, int bid, int tid, int wave, int lane) {
    constexpr int NG = 144;
    if (bid < NG) mod_gemv_tasks(a, ws, lds, 0, 144, bid, G < NG ? G : NG, tid, wave, lane);
    if (bid == G - 1) {
        float* ct = (float*)(ws + WS_ROPE); float* st = ct + 4096;
        for (int i = tid; i < 4096; i += NTHR) { const int pos = i >> 5, f = i & 31; const float inv = powf(10000.0f, -(float)f / 32.0f); const float ang = (float)pos * inv;
            const float c_ = cosf(ang), s_ = sinf(ang); ct[i] = c_; st[i] = s_;
            typedef _Float16 h2v_ __attribute__((ext_vector_type(2))); const h2v_ hv_ = {(_Float16)c_, (_Float16)s_};
            ((unsigned*)(ct + 8192))[i] = __builtin_bit_cast(unsigned, hv_); }
    }
    __syncthreads();
    { constexpr int SHARE_G = 2, SHARE_O = 4;
      const int wG = NG * NWAVES, wO = (G - NG) * NWAVES, tot = wG * SHARE_G + wO * SHARE_O;
      const int gwave = bid * NWAVES + wave;
      if (G > NG) { const int first = bid < NG ? gwave * SHARE_G : wG * SHARE_G + (gwave - wG) * SHARE_O, cnt = bid < NG ? SHARE_G : SHARE_O;
          for (int q = 0; q < cnt; ++q) convert_ranges(a, ws, lds, TL_WIN, TL_WIN + T_WIN, 0, 0, first + q, tot, wave, lane); }
      else convert_ranges(a, ws, lds, TL_WIN, TL_WIN + T_WIN, 0, 0, gwave, G * NWAVES, wave, lane); }
}

__device__ __forceinline__ int ncol(int lane, int jj) { return 8 * lane + 512 * (jj >> 1) + 4 * (jj & 1); }
__device__ __forceinline__ void norm_load_vec(const float* g, const float* shift, const float* scale, int v, int lane, f32x4 (&gs)[8], f32x4 (&sh)[8]) {
#pragma unroll
    for (int j = 0; j < 8; ++j) { const int c = ncol(lane, j); const f32x4 gg = *(const f32x4*)(g + c), sc = *(const f32x4*)(scale + (size_t)v * MODW + c);
        gs[j] = gg * (sc + 1.0f); sh[j] = *(const f32x4*)(shift + (size_t)v * MODW + c); }
}
__device__ __forceinline__ void norm_finish(f32x4 (&x)[8], const f32x4 (&gs)[8], const f32x4 (&sh)[8], bf16* XNb, int row, int lane) {
    float s = 0.f;
#pragma unroll
    for (int j = 0; j < 8; ++j) s += (x[j].x * x[j].x + x[j].y * x[j].y) + (x[j].z * x[j].z + x[j].w * x[j].w);
    const float rstd = 1.0f / sqrtf(wave_sum(s) * (1.0f / DM) + EPS);
#pragma unroll
    for (int j = 0; j < 4; ++j) { const f32x4 y0 = x[2 * j] * rstd * gs[2 * j] + sh[2 * j], y1 = x[2 * j + 1] * rstd * gs[2 * j + 1] + sh[2 * j + 1];
        v4u w; w.x = cvtpk(y0.x, y0.y); w.y = cvtpk(y0.z, y0.w); w.z = cvtpk(y1.x, y1.y); w.w = cvtpk(y1.z, y1.w);
        const int col = 8 * lane + 512 * j;
        if (XN_IMG) *(v4u*)((char*)XNb + ((size_t)(col >> 6) * (MROWS >> 7) + (row >> 7)) * pg8::HTB + pg8::lds_byte(row & 127, col & 63)) = w;
        else *(v4u*)(XNb + (size_t)row * DM + col) = w; }
}
template <bool F32> __device__ __forceinline__ void norm_load_row(const void* rowp, int lane, f32x4 (&x)[8]) {
    if (F32) { const float* xr = (const float*)rowp;
#pragma unroll
        for (int j = 0; j < 8; ++j) x[j] = *(const f32x4*)(xr + ncol(lane, j)); }
    else { const bf16* xr = (const bf16*)rowp; v4u w[4];
#pragma unroll
        for (int j = 0; j < 4; ++j) w[j] = *(const v4u*)(xr + 8 * lane + 512 * j);
#pragma unroll
        for (int j = 0; j < 4; ++j) { x[2 * j] = (f32x4){bf_lo(w[j].x), bf_hi(w[j].x), bf_lo(w[j].y), bf_hi(w[j].y)}; x[2 * j + 1] = (f32x4){bf_lo(w[j].z), bf_hi(w[j].z), bf_lo(w[j].w), bf_hi(w[j].w)}; } }
}
template <bool LAT_F32, bool CTX_F32>
__device__ __forceinline__ void norm_phase(const void* srcLat, const void* srcCtx, int nrows, const float* g, const float* shift, const float* scale  , bf16* XN, int gw, int ngw, int lane,
                                           int gwalt, const float* slab = nullptr, int nslab = 0, bf16* ctxOut = nullptr, LAS unsigned char* lds_norm = nullptr) {
    f32x4 gs[8], sh[8];
    constexpr size_t LSTR = LAT_F32 ? 4 : 2, CSTR = CTX_F32 ? 4 : 2;
    { const int per = (NLAT + ngw - 1) / ngw; const int r0 = gw * per, r1 = (r0 + per < NLAT) ? r0 + per : NLAT;
      int vcur = -1;
      int row = r0;
      for (; row + 3 < r1 && ((row < SEQ) == (row + 3 < SEQ)); row += 4) {
          const int v = row < SEQ ? 0 : 1;
          if (v != vcur) { vcur = v; norm_load_vec(g, shift, scale, v, lane, gs, sh); }
          f32x4 x0[8], x1[8], x2[8], x3[8];
          norm_load_row<LAT_F32>((const char*)srcLat + (size_t)row * DM * LSTR, lane, x0); norm_load_row<LAT_F32>((const char*)srcLat + (size_t)(row + 1) * DM * LSTR, lane, x1);
          norm_load_row<LAT_F32>((const char*)srcLat + (size_t)(row + 2) * DM * LSTR, lane, x2); norm_load_row<LAT_F32>((const char*)srcLat + (size_t)(row + 3) * DM * LSTR, lane, x3);
          norm_finish(x0, gs, sh, XN, row, lane); norm_finish(x1, gs, sh, XN, row + 1, lane); norm_finish(x2, gs, sh, XN, row + 2, lane); norm_finish(x3, gs, sh, XN, row + 3, lane);
      }
      for (; row + 1 < r1 && ((row < SEQ) == (row + 1 < SEQ)); row += 2) {
          const int v = row < SEQ ? 0 : 1;
          if (v != vcur) { vcur = v; norm_load_vec(g, shift, scale, v, lane, gs, sh); }
          f32x4 x[8], y[8];
          norm_load_row<LAT_F32>((const char*)srcLat + (size_t)row * DM * LSTR, lane, x); norm_load_row<LAT_F32>((const char*)srcLat + (size_t)(row + 1) * DM * LSTR, lane, y);
          norm_finish(x, gs, sh, XN, row, lane); norm_finish(y, gs, sh, XN, row + 1, lane);
      }
      for (; row < r1; ++row) {
          const int v = row < SEQ ? 0 : 1;
          if (v != vcur) { vcur = v; norm_load_vec(g, shift, scale, v, lane, gs, sh); }
          f32x4 x[8]; norm_load_row<LAT_F32>((const char*)srcLat + (size_t)row * DM * LSTR, lane, x);
          norm_finish(x, gs, sh, XN, row, lane);
      } }
    if (nrows > NLAT) {
        LAS float* red = (LAS float*)(lds_norm);
        const int G_ = ngw / NWAVES, bid_ = gw / NWAVES, wv = gw % NWAVES, half = wv >> 2, jq = wv & 3, col = 8 * lane + 512 * jq;
        for (int c0 = bid_; c0 < NCTXR; c0 += 2 * G_) {
            const int cr = c0 + half * G_; const bool live = cr < NCTXR;
            f32x4 xa = {0.f, 0.f, 0.f, 0.f}, xb = xa;
            const f32x4 ga = *(const f32x4*)(g + col), gb = *(const f32x4*)(g + col + 4), sa = *(const f32x4*)(scale + (size_t)2 * MODW + col), sb = *(const f32x4*)(scale + (size_t)2 * MODW + col + 4);
            const f32x4 ha = *(const f32x4*)(shift + (size_t)2 * MODW + col), hb = *(const f32x4*)(shift + (size_t)2 * MODW + col + 4);
            if (live) {
                if (CTX_F32) { const float* xr = (const float*)srcCtx + (size_t)cr * DM + col; xa = *(const f32x4*)xr; xb = *(const f32x4*)(xr + 4); }
                else { const v4u w = *(const v4u*)((const bf16*)srcCtx + (size_t)cr * DM + col); xa = (f32x4){bf_lo(w.x), bf_hi(w.x), bf_lo(w.y), bf_hi(w.y)}; xb = (f32x4){bf_lo(w.z), bf_hi(w.z), bf_lo(w.w), bf_hi(w.w)}; }
                if (nslab > 0) {
                    v4u tw[11];
#pragma unroll
                    for (int q = 0; q < 11; ++q) { const int qq = q < nslab ? q : 0; tw[q] = *(const v4u*)((const bf16*)slab + ((size_t)qq * NCTXR + cr) * DM + col); }
#pragma unroll
                    for (int q = 0; q < 11; ++q) if (q < nslab) { xa += (f32x4){bf_lo(tw[q].x), bf_hi(tw[q].x), bf_lo(tw[q].y), bf_hi(tw[q].y)}; xb += (f32x4){bf_lo(tw[q].z), bf_hi(tw[q].z), bf_lo(tw[q].w), bf_hi(tw[q].w)}; }
                    v4u w; w.x = cvtpk(xa.x, xa.y); w.y = cvtpk(xa.z, xa.w); w.z = cvtpk(xb.x, xb.y); w.w = cvtpk(xb.z, xb.w);
                    *(v4u*)(ctxOut + (size_t)cr * DM + col) = w;
                    xa = (f32x4){bf_lo(w.x), bf_hi(w.x), bf_lo(w.y), bf_hi(w.y)}; xb = (f32x4){bf_lo(w.z), bf_hi(w.z), bf_lo(w.w), bf_hi(w.w)};
                }
            }
            const float part = wave_sum((xa.x * xa.x + xa.y * xa.y) + (xa.z * xa.z + xa.w * xa.w) + (xb.x * xb.x + xb.y * xb.y) + (xb.z * xb.z + xb.w * xb.w));
            if (lane == 0) red[wv] = part;
            __syncthreads();
            if (live) {
                const float tot = (red[4 * half] + red[4 * half + 1]) + (red[4 * half + 2] + red[4 * half + 3]);
                const float rstd = 1.0f / sqrtf(tot * (1.0f / DM) + EPS);
                const f32x4 y0 = xa * rstd * (ga * (sa + 1.0f)) + ha, y1 = xb * rstd * (gb * (sb + 1.0f)) + hb;
                v4u w; w.x = cvtpk(y0.x, y0.y); w.y = cvtpk(y0.z, y0.w); w.z = cvtpk(y1.x, y1.y); w.w = cvtpk(y1.z, y1.w);
                const int row = NLAT + cr;
                if (XN_IMG) *(v4u*)((char*)XN + ((size_t)(col >> 6) * (MROWS >> 7) + (row >> 7)) * pg8::HTB + pg8::lds_byte(row & 127, col & 63)) = w;
                else *(v4u*)(XN + (size_t)row * DM + col) = w;
            }
            __syncthreads();
        }
    }
}
__device__ __forceinline__ void final_norm_phase(const bf16* X, const float* g, float* out, int gw, int ngw, int lane) {
    f32x4 gg[8];
#pragma unroll
    for (int j = 0; j < 8; ++j) gg[j] = *(const f32x4*)(g + ncol(lane, j));
    for (int row = gw; row < NLAT; row += ngw) {
        f32x4 x[8]; float s = 0.f; norm_load_row<false>(X + (size_t)row * DM, lane, x);
#pragma unroll
        for (int j = 0; j < 8; ++j) s += (x[j].x * x[j].x + x[j].y * x[j].y) + (x[j].z * x[j].z + x[j].w * x[j].w);
        const float rstd = 1.0f / sqrtf(wave_sum(s) * (1.0f / DM) + EPS);
#pragma unroll
        for (int j = 0; j < 8; ++j) *(f32x4*)(out + (size_t)row * DM + ncol(lane, j)) = x[j] * rstd * gg[j];
    }
}

typedef float f32x16 __attribute__((ext_vector_type(16)));
typedef short s16x4 __attribute__((ext_vector_type(4)));
constexpr int KSTR = 136, VSTR = 160;
constexpr int AT_K = 0, AT_V = 64 * KSTR * 2, AT_BUF = AT_V + 64 * VSTR * 2  , AT_WS = 2 * AT_BUF, AT_END = AT_WS + NWAVES * 256;
#define AT_LDS_BAR() do { asm volatile("s_waitcnt lgkmcnt(0)" ::: "memory"); __builtin_amdgcn_s_barrier(); asm volatile("" ::: "memory"); } while (0)
constexpr float ATT_C2 = 0.08838834764831845f * 1.4426950408889634f;
constexpr float LOG2E = 1.4426950408889634f;
__device__ __forceinline__ int crow(int r, int hi) { return (r & 3) + 8 * (r >> 2) + 4 * hi; }

__device__ __forceinline__ void rope_pair(v4u& p1, v4u& p2, const float* ropeC, const float* ropeS, int pos, int f0) {
    const f32x4 c0 = *(const f32x4*)(ropeC + pos * 32 + f0), c1 = *(const f32x4*)(ropeC + pos * 32 + f0 + 4);
    const f32x4 s0 = *(const f32x4*)(ropeS + pos * 32 + f0), s1 = *(const f32x4*)(ropeS + pos * 32 + f0 + 4);
    const float cc[8] = {c0.x, c0.y, c0.z, c0.w, c1.x, c1.y, c1.z, c1.w}, ss[8] = {s0.x, s0.y, s0.z, s0.w, s1.x, s1.y, s1.z, s1.w};
    unsigned a[4] = {p1.x, p1.y, p1.z, p1.w}, b[4] = {p2.x, p2.y, p2.z, p2.w};
#pragma unroll
    for (int i = 0; i < 4; ++i) {
        const float x1l = bf_lo(a[i]), x1h = bf_hi(a[i]), x2l = bf_lo(b[i]), x2h = bf_hi(b[i]);
        a[i] = cvtpk(x1l * cc[2 * i] - x2l * ss[2 * i], x1h * cc[2 * i + 1] - x2h * ss[2 * i + 1]);
        b[i] = cvtpk(x2l * cc[2 * i] + x1l * ss[2 * i], x2h * cc[2 * i + 1] + x1h * ss[2 * i + 1]);
    }
    p1 = (v4u){a[0], a[1], a[2], a[3]}; p2 = (v4u){b[0], b[1], b[2], b[3]};
}

__device__ __forceinline__ void rope_pair_pre(v4u& p1, v4u& p2, const f32x4& c0, const f32x4& c1, const f32x4& s0, const f32x4& s1) {
    const float cc[8] = {c0.x, c0.y, c0.z, c0.w, c1.x, c1.y, c1.z, c1.w}, ss[8] = {s0.x, s0.y, s0.z, s0.w, s1.x, s1.y, s1.z, s1.w};
    unsigned a[4] = {p1.x, p1.y, p1.z, p1.w}, b[4] = {p2.x, p2.y, p2.z, p2.w};
#pragma unroll
    for (int i = 0; i < 4; ++i) {
        const float x1l = bf_lo(a[i]), x1h = bf_hi(a[i]), x2l = bf_lo(b[i]), x2h = bf_hi(b[i]);
        a[i] = cvtpk(x1l * cc[2 * i] - x2l * ss[2 * i], x1h * cc[2 * i + 1] - x2h * ss[2 * i + 1]);
        b[i] = cvtpk(x2l * cc[2 * i] + x1l * ss[2 * i], x2h * cc[2 * i + 1] + x1h * ss[2 * i + 1]);
    }
    p1 = (v4u){a[0], a[1], a[2], a[3]}; p2 = (v4u){b[0], b[1], b[2], b[3]};
}

typedef _Float16 h2v __attribute__((ext_vector_type(2)));
__device__ __forceinline__ void rope_pair_h(v4u& p1, v4u& p2, const v4u& ra, const v4u& rb) {
    const unsigned t[8] = {ra.x, ra.y, ra.z, ra.w, rb.x, rb.y, rb.z, rb.w};
    unsigned a[4] = {p1.x, p1.y, p1.z, p1.w}, b[4] = {p2.x, p2.y, p2.z, p2.w};
#pragma unroll
    for (int i = 0; i < 4; ++i) {
        const h2v t0 = __builtin_bit_cast(h2v, t[2 * i]), t1 = __builtin_bit_cast(h2v, t[2 * i + 1]);
        const float c0 = (float)t0.x, s0 = (float)t0.y, c1 = (float)t1.x, s1 = (float)t1.y;
        const float x1l = bf_lo(a[i]), x1h = bf_hi(a[i]), x2l = bf_lo(b[i]), x2h = bf_hi(b[i]);
        a[i] = cvtpk(x1l * c0 - x2l * s0, x1h * c1 - x2h * s1);
        b[i] = cvtpk(x2l * c0 + x1l * s0, x2h * c1 + x1h * s1);
    }
    p1 = (v4u){a[0], a[1], a[2], a[3]}; p2 = (v4u){b[0], b[1], b[2], b[3]};
}

__device__ __forceinline__ void attn_unit(const bf16* __restrict__ PROJ, bf16* __restrict__ MIX, const float* sink, const float* ropeC, const float* ropeS,
                                          LAS unsigned char* lds, int u, int tid, int wave, int lane) {
    const bool isctx = u >= 512;
    int b, kvh, qb;
    if (!isctx) { b = u >> 8; kvh = (u >> 7) & 1; qb = u & 127; } else { const int uu = u - 512; b = uu >> 3; kvh = (uu >> 2) & 1; qb = uu & 3; }
    const int g = wave >> 1, rg = wave & 1, head = kvh * 4 + g;
    const int r32 = lane & 31, hi = lane >> 5;
    const size_t seqbase = isctx ? (size_t)NLAT + (size_t)b * CTXL : (size_t)b * SEQ;
    const size_t ctxbase = (size_t)NLAT + (size_t)b * CTXL;
    const int qpos = 64 * qb + 32 * rg + r32;
    const int srow = tid >> 3, sc = (tid & 3) + 8 * ((tid >> 2) & 1);
    const int t_lo = isctx ? 5 : 0;
    v4u kA, kB, vA, vB; bool kropeS = false; v4u rA, rB; const unsigned* ropeH = (const unsigned*)(ropeC + 8192);
    int tl_lo = 5, nloc = 0;
    if (!isctx) { tl_lo = 0; while (64 * qb - 128 + 64 * tl_lo < 0) ++tl_lo; int tl_hi = 4; while (64 * qb - 128 + 64 * tl_hi >= SEQ) --tl_hi; nloc = tl_hi - tl_lo + 1; }
    const int ntile = nloc + 4;
#define AT_FENCE() do { asm volatile("" ::: "memory"); __builtin_amdgcn_sched_barrier(0); } while (0)
#define AT_KF(j) (*(const LAS bf16x8*)(kb + 32 * ((j) >> 1) + ((j) & 1) * (32 * (KSTR * 2))))
#define AT_VLO(gq, d) __builtin_bit_cast(s16x4, __builtin_amdgcn_ds_read_tr16_b64_v4i16((LAS s16x4*)(vb + (16 * (gq)) * (VSTR * 2) + 64 * (d))))
#define AT_VHH(gq, d) __builtin_bit_cast(s16x4, __builtin_amdgcn_ds_read_tr16_b64_v4i16((LAS s16x4*)(vb + (16 * (gq) + 8) * (VSTR * 2) + 64 * (d))))
#define AT_TILE(i) ((i) < nloc ? tl_lo + (i) : 5 + ((i) - nloc))
#define AT_LOAD(t) do { const bool loc_ = (t) < 5; const int kp_ = loc_ ? (64 * qb - 128 + 64 * (t) + srow) : (64 * ((t) - 5) + srow); \
        const bf16* kr_ = PROJ + ((loc_ ? seqbase : ctxbase) + kp_) * ABW + 1024 + 128 * kvh + 8 * sc; \
        kA = *(const v4u*)kr_; kB = *(const v4u*)(kr_ + 32); vA = *(const v4u*)(kr_ + 256); vB = *(const v4u*)(kr_ + 288); kropeS = loc_; \
        if (loc_) { const int ro_ = ((sc >> 3) ? (kp_ & 63) : (kp_ >> 6)) * 32 + 8 * (sc & 3); rA = *(const v4u*)(ropeH + ro_); rB = *(const v4u*)(ropeH + ro_ + 4); } } while (0)
#define AT_STORE(buf) do { LAS unsigned char* tb_ = lds + (buf) * AT_BUF; \
        if (kropeS) rope_pair_h(kA, kB, rA, rB); \
        *(LAS v4u*)(tb_ + AT_K + srow * (KSTR * 2) + 16 * sc) = kA; *(LAS v4u*)(tb_ + AT_K + srow * (KSTR * 2) + 16 * (sc + 4)) = kB; \
        *(LAS v4u*)(tb_ + AT_V + srow * (VSTR * 2) + 16 * sc) = vA; *(LAS v4u*)(tb_ + AT_V + srow * (VSTR * 2) + 16 * (sc + 4)) = vB; } while (0)
    AT_LOAD(AT_TILE(0));
    v4u qraw[8];
    { const bf16* qrow = PROJ + (seqbase + qpos) * ABW + head * HD + 8 * hi;
#pragma unroll
      for (int kk = 0; kk < 8; ++kk) qraw[kk] = *(const v4u*)(qrow + 16 * kk); }
    if (!isctx) {
        rope_pair(qraw[0], qraw[2], ropeC, ropeS, qpos >> 6, 8 * hi);
        rope_pair(qraw[1], qraw[3], ropeC, ropeS, qpos >> 6, 16 + 8 * hi);
        rope_pair(qraw[4], qraw[6], ropeC, ropeS, qpos & 63, 8 * hi);
        rope_pair(qraw[5], qraw[7], ropeC, ropeS, qpos & 63, 16 + 8 * hi);
    }
    bf16x8 qf[8];
#pragma unroll
    for (int kk = 0; kk < 8; ++kk) qf[kk] = __builtin_bit_cast(bf16x8, qraw[kk]);
    AT_FENCE();
    float m_run = sink[head] * LOG2E, l_run = 1.0f;
    f32x16 O[4];
#pragma unroll
    for (int d = 0; d < 4; ++d)
#pragma unroll
        for (int r = 0; r < 16; ++r) O[d][r] = 0.f;
    LAS float* wsf = (LAS float*)(lds + AT_WS) + wave * 64;
    AT_LDS_BAR();
    AT_STORE(0);
    if (ntile > 1) AT_LOAD(AT_TILE(1));
    AT_LDS_BAR();
#pragma unroll 1
    for (int it = 0; it < ntile; ++it) {
        const int tcur = AT_TILE(it);
        const LAS unsigned char* tb = lds + (it & 1) * AT_BUF;
        const LAS unsigned char* kb = tb + AT_K + r32 * (KSTR * 2) + 16 * hi;
        bf16x8 kf[8];
#pragma unroll
        for (int j = 0; j < 8; ++j) kf[j] = AT_KF(j);
        AT_FENCE();
        if (it + 1 < ntile) AT_STORE((it + 1) & 1);
        if (it + 2 < ntile) AT_LOAD(AT_TILE(it + 2));
        f32x16 p0, p1;
#pragma unroll
        for (int r = 0; r < 16; ++r) { p0[r] = 0.f; p1[r] = 0.f; }
#pragma unroll
        for (int kk = 0; kk < 8; ++kk) {
            p0 = __builtin_amdgcn_mfma_f32_32x32x16_bf16(kf[2 * (kk & 3)], qf[kk], p0, 0, 0, 0);
            p1 = __builtin_amdgcn_mfma_f32_32x32x16_bf16(kf[2 * (kk & 3) + 1], qf[kk], p1, 0, 0, 0);
            if (kk < 4) { kf[2 * kk] = AT_KF(2 * (kk + 4)); kf[2 * kk + 1] = AT_KF(2 * (kk + 4) + 1); AT_FENCE(); }
        }
        AT_FENCE();
        const LAS unsigned char* vb = tb + AT_V + (4 * hi + ((lane & 15) >> 2)) * (VSTR * 2) + (16 * ((lane >> 4) & 1) + 4 * (lane & 3)) * 2;
        s16x4 vlo[2][4], vhh[2][4];
#pragma unroll
        for (int d = 0; d < 4; ++d) { vlo[0][d] = AT_VLO(0, d); vhh[0][d] = AT_VHH(0, d); }
        AT_FENCE();
        const int qrel = 32 * rg + r32;
        if (tcur == 0) {
#pragma unroll
            for (int r = 0; r < 16; ++r) { const int kv0 = crow(r, hi); if (kv0 < qrel) p0[r] = -INFINITY; if (kv0 + 32 < qrel) p1[r] = -INFINITY; } }
        if (tcur == 4) {
#pragma unroll
            for (int r = 0; r < 16; ++r) { const int kv0 = crow(r, hi); if (kv0 > qrel) p0[r] = -INFINITY; if (kv0 + 32 > qrel) p1[r] = -INFINITY; } }
        float mx = fmaxf(p0[0], p1[0]);
#pragma unroll
        for (int r = 1; r < 16; ++r) mx = fmaxf(mx, fmaxf(p0[r], p1[r]));
        { const auto rr = __builtin_amdgcn_permlane32_swap(__float_as_uint(mx), __float_as_uint(mx), false, false); mx = fmaxf(__uint_as_float(rr[0]), __uint_as_float(rr[1])); }
        const float cand = mx * ATT_C2; const bool grow = cand > m_run + 8.0f;
        const float m_new = grow ? cand : m_run;
        float rs = 0.f;
#pragma unroll
        for (int r = 0; r < 16; ++r) { p0[r] = __builtin_amdgcn_exp2f(p0[r] * ATT_C2 - m_new); p1[r] = __builtin_amdgcn_exp2f(p1[r] * ATT_C2 - m_new); rs += p0[r] + p1[r]; }
        { const auto rr = __builtin_amdgcn_permlane32_swap(__float_as_uint(rs), __float_as_uint(rs), false, false); rs = __uint_as_float(rr[0]) + __uint_as_float(rr[1]); }
        if (__any(grow)) {
            const float alpha = __builtin_amdgcn_exp2f(m_run - m_new);
            l_run = l_run * alpha + rs; m_run = m_new;
            if (hi == 0) wsf[r32] = alpha;
            LDS_WAIT(); asm volatile("" ::: "memory");
            float al[16];
#pragma unroll
            for (int r = 0; r < 16; ++r) al[r] = wsf[crow(r, hi)];
#pragma unroll
            for (int d = 0; d < 4; ++d)
#pragma unroll
                for (int r = 0; r < 16; ++r) O[d][r] *= al[r];
            LDS_WAIT(); asm volatile("" ::: "memory");
        } else l_run += rs;
#pragma unroll
        for (int d = 0; d < 4; ++d) { vlo[1][d] = AT_VLO(1, d); vhh[1][d] = AT_VHH(1, d); }
        AT_FENCE();
#pragma unroll
        for (int gq = 0; gq < 4; ++gq) {
            const int half = gq >> 1, s = gq & 1;
            u32x4 pw;
            if (half == 0) { pw.x = cvtpk(p0[8 * s + 0], p0[8 * s + 1]); pw.y = cvtpk(p0[8 * s + 2], p0[8 * s + 3]); pw.z = cvtpk(p0[8 * s + 4], p0[8 * s + 5]); pw.w = cvtpk(p0[8 * s + 6], p0[8 * s + 7]); }
            else           { pw.x = cvtpk(p1[8 * s + 0], p1[8 * s + 1]); pw.y = cvtpk(p1[8 * s + 2], p1[8 * s + 3]); pw.z = cvtpk(p1[8 * s + 4], p1[8 * s + 5]); pw.w = cvtpk(p1[8 * s + 6], p1[8 * s + 7]); }
            const bf16x8 pa = __builtin_bit_cast(bf16x8, pw);
#pragma unroll
            for (int d = 0; d < 4; ++d) {
                const s16x4 lo = vlo[gq & 1][d], hh = vhh[gq & 1][d];
                const bf16x8 vf = (bf16x8){lo[0], lo[1], lo[2], lo[3], hh[0], hh[1], hh[2], hh[3]};
                O[d] = __builtin_amdgcn_mfma_f32_32x32x16_bf16(pa, vf, O[d], 0, 0, 0);
                if (gq < 2) { vlo[gq & 1][d] = AT_VLO(gq + 2, d); vhh[gq & 1][d] = AT_VHH(gq + 2, d); AT_FENCE(); }
            }
        }
        AT_LDS_BAR();
    }
#undef AT_TILE
#undef AT_FENCE
#undef AT_KF
#undef AT_VLO
#undef AT_VHH
#undef AT_STORE
#undef AT_LOAD
    if (hi == 0) wsf[32 + r32] = 1.0f / l_run;
    LDS_WAIT(); asm volatile("" ::: "memory");
    { LAS bf16* stg = (LAS bf16*)(lds + wave * 8704);
#pragma unroll
      for (int r = 0; r < 16; ++r) { const int q = crow(r, hi); const float il = wsf[32 + q];
#pragma unroll
          for (int d = 0; d < 4; ++d) stg[q * 136 + 32 * d + r32] = (bf16)f2bf(O[d][r] * il); }
      LDS_WAIT(); asm volatile("" ::: "memory");
      bf16* obase = MIX + (seqbase + 64 * qb + 32 * rg) * DM + head * HD;
#pragma unroll
      for (int j = 0; j < 8; ++j) { const int i = lane + 64 * j, row = i >> 4, ch = i & 15;
          const v4u w = *(const LAS v4u*)(stg + row * 136 + 8 * ch);
          *(v4u*)(obase + (size_t)row * DM + 8 * ch) = w; }
      LDS_WAIT(); asm volatile("" ::: "memory"); }
}

__device__ __forceinline__ void sconv_item_load(const bf16* __restrict__ PROJ, int it, v4u& bgv, v4u (&cg)[3], v4u (&uu)[3], float (&msk)[3]) {
    const int row = it >> 7, c = (it & 127) * 8;
    int pos, len; if (row < NLAT) { pos = row & (SEQ - 1); len = SEQ; } else { pos = (row - NLAT) & (CTXL - 1); len = CTXL; }
    const bf16* pr = PROJ + (size_t)row * ABW;
    bgv = *(const v4u*)(pr + 1536 + c);
#pragma unroll
    for (int k = 0; k < 3; ++k) { const int p2 = pos + k - 1; const bool ok = (p2 >= 0 && p2 < len); const bf16* q = pr + (ok ? (ptrdiff_t)(k - 1) * ABW : 0);
        cg[k] = *(const v4u*)(q + 2560 + c); uu[k] = *(const v4u*)(q + 3584 + c); msk[k] = ok ? 1.0f : 0.0f; }
}
__device__ __forceinline__ void sconv_item_finish(bf16* __restrict__ MIX, const float* cw, int it, const v4u& bgv, const v4u (&cg)[3], const v4u (&uu)[3], const float (&msk)[3]) {
    const int row = it >> 7, c = (it & 127) * 8;
    float acc[8];
#pragma unroll
    for (int j = 0; j < 8; ++j) acc[j] = 0.f;
#pragma unroll
    for (int k = 0; k < 3; ++k) {
        const f32x4 w0 = *(const f32x4*)(cw + k * 1024 + c) * msk[k], w1 = *(const f32x4*)(cw + k * 1024 + c + 4) * msk[k];
        const unsigned cgw[4] = {cg[k].x, cg[k].y, cg[k].z, cg[k].w}, uw[4] = {uu[k].x, uu[k].y, uu[k].z, uu[k].w};
        const float ww[8] = {w0.x, w0.y, w0.z, w0.w, w1.x, w1.y, w1.z, w1.w};
#pragma unroll
        for (int i = 0; i < 4; ++i) { acc[2 * i] += ww[2 * i] * (bf_lo(cgw[i]) * bf_lo(uw[i])); acc[2 * i + 1] += ww[2 * i + 1] * (bf_hi(cgw[i]) * bf_hi(uw[i])); }
    }
    const unsigned bw[4] = {bgv.x, bgv.y, bgv.z, bgv.w};
    v4u o;
    o.x = cvtpk(acc[0] * bf_lo(bw[0]), acc[1] * bf_hi(bw[0])); o.y = cvtpk(acc[2] * bf_lo(bw[1]), acc[3] * bf_hi(bw[1]));
    o.z = cvtpk(acc[4] * bf_lo(bw[2]), acc[5] * bf_hi(bw[2])); o.w = cvtpk(acc[6] * bf_lo(bw[3]), acc[7] * bf_hi(bw[3]));
    *(v4u*)(MIX + (size_t)row * DM + 1024 + c) = o;
}
__device__ __forceinline__ void sconv_items(const bf16* __restrict__ PROJ, bf16* __restrict__ MIX, const float* cw  , int gtid, int ngt) {
    constexpr int NIT = MROWS * 128;
    int it = gtid;
    for (; it + ngt < NIT; it += 2 * ngt) {
        v4u bA, cA[3], uA[3], bB, cB[3], uB[3]; float mA[3], mB[3];
        sconv_item_load(PROJ, it, bA, cA, uA, mA); sconv_item_load(PROJ, it + ngt, bB, cB, uB, mB);
        sconv_item_finish(MIX, cw, it, bA, cA, uA, mA); sconv_item_finish(MIX, cw, it + ngt, bB, cB, uB, mB);
    }
    if (it < NIT) { v4u bA, cA[3], uA[3]; float mA[3]; sconv_item_load(PROJ, it, bA, cA, uA, mA); sconv_item_finish(MIX, cw, it, bA, cA, uA, mA); }
}

__device__ __forceinline__ void sconv_strips(const bf16* __restrict__ PROJ, bf16* __restrict__ MIX, const float* cw  , int gtid, int ngt) {
    constexpr int R = 18, NGRP = (MROWS + R - 1) / R, NTASK = NGRP * 128;
    for (int task = gtid; task < NTASK; task += ngt) {
        const int grp = __builtin_amdgcn_readfirstlane(task >> 7), c = (task & 127) * 8;
        const int r0 = grp * R;
        float w[3][8];
#pragma unroll
        for (int k = 0; k < 3; ++k) { const f32x4 a = *(const f32x4*)(cw + k * 1024 + c), b = *(const f32x4*)(cw + k * 1024 + c + 4);
            w[k][0] = a.x; w[k][1] = a.y; w[k][2] = a.z; w[k][3] = a.w; w[k][4] = b.x; w[k][5] = b.y; w[k][6] = b.z; w[k][7] = b.w; }
        v4u cgq[4], uq[4], bgq[4];
#define SC_LOAD(slot, j) do { int rr_ = r0 + (j); rr_ = rr_ < 0 ? 0 : (rr_ >= MROWS ? MROWS - 1 : rr_); const bf16* pr_ = PROJ + (size_t)rr_ * ABW + c; \
        bgq[slot] = *(const v4u*)(pr_ + 1536); cgq[slot] = *(const v4u*)(pr_ + 2560); uq[slot] = *(const v4u*)(pr_ + 3584); } while (0)
        SC_LOAD(0, -1); SC_LOAD(1, 0); SC_LOAD(2, 1); SC_LOAD(3, 2);
        float P0[8], P1[8], P2[8]; v4u B1 = (v4u){0u, 0u, 0u, 0u}, B2;
#pragma unroll
        for (int i = 0; i < 8; ++i) { P0[i] = 0.f; P1[i] = 0.f; }
#pragma unroll 1
        for (int jb = -1; jb < R + 1; jb += 4) {
#pragma unroll
            for (int q = 0; q < 4; ++q) {
                const int j = jb + q;
                { const unsigned cgw[4] = {cgq[q].x, cgq[q].y, cgq[q].z, cgq[q].w}, uw[4] = {uq[q].x, uq[q].y, uq[q].z, uq[q].w};
#pragma unroll
                  for (int i = 0; i < 4; ++i) { P2[2 * i] = bf_lo(cgw[i]) * bf_lo(uw[i]); P2[2 * i + 1] = bf_hi(cgw[i]) * bf_hi(uw[i]); }
                  B2 = bgq[q]; }
                if (j + 4 <= R) SC_LOAD(q, j + 4);
                const int orow = r0 + j - 1;
                if (j >= 1 && orow < MROWS) {
                    int pos, len; if (orow < NLAT) { pos = orow & (SEQ - 1); len = SEQ; } else { pos = (orow - NLAT) & (CTXL - 1); len = CTXL; }
                    float acc[8];
#pragma unroll
                    for (int i = 0; i < 8; ++i) acc[i] = 0.f;
                    if (pos > 0) {
#pragma unroll
                        for (int i = 0; i < 8; ++i) acc[i] += w[0][i] * P0[i]; }
#pragma unroll
                    for (int i = 0; i < 8; ++i) acc[i] += w[1][i] * P1[i];
                    if (pos < len - 1) {
#pragma unroll
                        for (int i = 0; i < 8; ++i) acc[i] += w[2][i] * P2[i]; }
                    const unsigned bw[4] = {B1.x, B1.y, B1.z, B1.w};
                    v4u o;
                    o.x = cvtpk(acc[0] * bf_lo(bw[0]), acc[1] * bf_hi(bw[0])); o.y = cvtpk(acc[2] * bf_lo(bw[1]), acc[3] * bf_hi(bw[1]));
                    o.z = cvtpk(acc[4] * bf_lo(bw[2]), acc[5] * bf_hi(bw[2])); o.w = cvtpk(acc[6] * bf_lo(bw[3]), acc[7] * bf_hi(bw[3]));
                    *(v4u*)(MIX + (size_t)orow * DM + 1024 + c) = o;
                }
#pragma unroll
                for (int i = 0; i < 8; ++i) { P0[i] = P1[i]; P1[i] = P2[i]; }
                B1 = B2;
            }
        }
#undef SC_LOAD
    }
}

constexpr int UCF_STR = 132;
constexpr int SC_UC_BYTES = 32 * UCF_STR * 4 + 32 * KSTR * 2;
constexpr int SC_UC0 = 0, SC_Y = 2 * SC_UC_BYTES, SC_END = SC_Y + 2 * 32 * 128 * 4;
static_assert(SC_END <= RING_BYTES && (SC_UC_BYTES % 16) == 0 && ((32 * UCF_STR * 4) % 16) == 0, "scan LDS map");
__device__ __forceinline__ float sigmoid_f(float x) { return __builtin_amdgcn_rcpf(1.0f + __builtin_amdgcn_exp2f(-1.4426950408889634f * x)); }
__device__ __forceinline__ float neg_expm1_small(float x) { float p = 1.0f + x * (1.0f / 6.0f); p = 1.0f + x * (1.0f / 5.0f) * p; p = 1.0f + x * 0.25f * p; p = 1.0f + x * (1.0f / 3.0f) * p; p = 1.0f + x * 0.5f * p; return -x * p; }
__device__ __forceinline__ float gelu_tanh_f(float x) { const float z = 0.7978845608028654f * (x + 0.044715f * x * x * x); const float t = 1.0f - 2.0f * __builtin_amdgcn_rcpf(__builtin_amdgcn_exp2f(2.8853900817779268f * z) + 1.0f); return 0.5f * x * (1.0f + t); }

typedef _Float16 h2_t __attribute__((ext_vector_type(2)));
__device__ __forceinline__ float lane_partner(float x, int hi) {
    const auto rr = __builtin_amdgcn_permlane32_swap(__float_as_uint(x), __float_as_uint(x), false, false);
    return __uint_as_float(hi ? rr[0] : rr[1]);
}
template <bool REV, bool WANT_H, bool WANT_P = false>
__device__ __forceinline__ void lane_scan(const float (&av)[16], const float (&bv)[16], int hi, float carry, float (&hv)[16], float& Atot, float& Htot, float* pv = nullptr) {
    float As[4], Hs[4], Ap[4], Hp[4];
#pragma unroll
    for (int k = 0; k < 4; ++k) {
        float A = 1.0f, H = 0.0f;
#pragma unroll
        for (int i = 0; i < 4; ++i) { const int r = 4 * k + (REV ? 3 - i : i); H = av[r] * H + bv[r]; A *= av[r]; }
        As[k] = A; Hs[k] = H;
    }
#pragma unroll
    for (int k = 0; k < 4; ++k) { Ap[k] = lane_partner(As[k], hi); Hp[k] = lane_partner(Hs[k], hi); }
    const bool ownFirst = REV ? (hi == 1) : (hi == 0);
    float c = carry, c0 = 0.0f, At = 1.0f; float cin[4], pin[4];
#pragma unroll
    for (int kk = 0; kk < 4; ++kk) { const int k = REV ? 3 - kk : kk;
        const float A1 = ownFirst ? As[k] : Ap[k], H1 = ownFirst ? Hs[k] : Hp[k], A2 = ownFirst ? Ap[k] : As[k], H2 = ownFirst ? Hp[k] : Hs[k];
        const float cf = c; c = A1 * c + H1; const float cs = c; c = A2 * c + H2;
        cin[k] = ownFirst ? cf : cs;
        pin[k] = ownFirst ? At : At * A1;
        c0 = A1 * c0 + H1; c0 = A2 * c0 + H2; At *= A1 * A2; }
    Atot = At; Htot = c0;
    if (WANT_H) {
#pragma unroll
        for (int k = 0; k < 4; ++k) { float hcur = cin[k], pcur = pin[k];
#pragma unroll
            for (int i = 0; i < 4; ++i) { const int r = 4 * k + (REV ? 3 - i : i); hcur = av[r] * hcur + bv[r]; hv[r] = hcur; if (WANT_P) { pcur *= av[r]; pv[r] = pcur; } } }
    }
}

#define LDS_BAR() do { asm volatile("s_waitcnt lgkmcnt(0)" ::: "memory"); __builtin_amdgcn_s_barrier(); asm volatile("" ::: "memory"); } while (0)
template <bool PASS3>
__device__ __forceinline__ void scan_unit(const Args& a, unsigned char* ws, LAS unsigned char* lds, int p, int h, int tid, int wave, int lane, int k0 = 0, int k1 = 8) {
    const bf16* PROJ2 = (const bf16*)(ws + WS_H);
    bf16* MIX = (bf16*)(ws + WS_MIX);
    float* CS = (float*)(ws + WS_CS); float* PS = (float*)(ws + WS_PS);
    const bf16* WG = (const bf16*)(ws + WS_WGATE);
    LAS float* Y = (LAS float*)(lds + SC_Y);
    const int r32 = lane & 31, hi = lane >> 5;
    const int d = wave >> 2, cq = wave & 3;
    const int cabs = h * 128 + 32 * cq + r32;
    const int pseq0 = p < 64 ? (p & ~31) : p;
    const int seqlen = p < 64 ? SEQ : CTXL;
    const int pos0 = (p - pseq0) * 256;
    bf16x8 wfa[8], wfx[8];
    { const bf16* wa = WG + ((size_t)((d * 2 + 0) * 16 + h) * 128 + 32 * cq + r32) * 128 + 8 * hi;
      const bf16* wx = WG + ((size_t)((d * 2 + 1) * 16 + h) * 128 + 32 * cq + r32) * 128 + 8 * hi;
#pragma unroll
      for (int kk = 0; kk < 8; ++kk) { wfa[kk] = *(const bf16x8*)(wa + 16 * kk); wfx[kk] = *(const bf16x8*)(wx + 16 * kk); } }
    const float ba = a.in[I_RGBA][d * DM + cabs], bx = a.in[I_RGBX][d * DM + cabs];
    const float sp8 = 8.0f * log1pf(expf(-a.in[I_RGLAM][d * DM + cabs]));
    const int ct = tid >> 4, cc = (tid & 15) * 8;
    float cwv[4][8], cbv[8];
    { const float* cwp = a.in[I_RGCONVW] + h * 128 + cc; const float* cbp = a.in[I_RGCONVB] + h * 128 + cc;
#pragma unroll
      for (int kk = 0; kk < 4; ++kk) { const f32x4 w0 = *(const f32x4*)(cwp + kk * DM), w1 = *(const f32x4*)(cwp + kk * DM + 4);
          cwv[kk][0] = w0.x; cwv[kk][1] = w0.y; cwv[kk][2] = w0.z; cwv[kk][3] = w0.w; cwv[kk][4] = w1.x; cwv[kk][5] = w1.y; cwv[kk][6] = w1.z; cwv[kk][7] = w1.w; }
      const f32x4 b0 = *(const f32x4*)cbp, b1 = *(const f32x4*)(cbp + 4);
      cbv[0] = b0.x; cbv[1] = b0.y; cbv[2] = b0.z; cbv[3] = b0.w; cbv[4] = b1.x; cbv[5] = b1.y; cbv[6] = b1.z; cbv[7] = b1.w; }
    float cin[8];
    float PA = 1.0f, PH = 0.0f;
    if (PASS3) {
        const int b = p >> 5;
        float carry = 0.0f;
        { float ca[8], chh[8];
#pragma unroll
          for (int k = 0; k < 8; ++k) { ca[k] = CS[((size_t)(((64 + b) * 8 + k) * 2 + d) * 2 + 0) * DM + cabs]; chh[k] = CS[((size_t)(((64 + b) * 8 + k) * 2 + d) * 2 + 1) * DM + cabs]; }
#pragma unroll
          for (int k = 0; k < 8; ++k) { const int kk = d ? 7 - k : k; carry = ca[kk] * carry + chh[kk]; } }
        { const int nprev = d ? (32 * b + 31 - p) : (p - 32 * b);
          for (int q0 = 0; q0 < nprev; q0 += 8) { float pa[8], ph[8];
#pragma unroll
              for (int q = 0; q < 8; ++q) { const int qq = (q0 + q < nprev) ? q0 + q : q0; const int pp = d ? (32 * b + 31 - qq) : (32 * b + qq);
                  pa[q] = PS[((size_t)(pp * 2 + d) * 2 + 0) * DM + cabs]; ph[q] = PS[((size_t)(pp * 2 + d) * 2 + 1) * DM + cabs]; }
#pragma unroll
              for (int q = 0; q < 8; ++q) if (q0 + q < nprev) carry = pa[q] * carry + ph[q]; } }
        if (d == 0) { cin[0] = carry;
#pragma unroll
            for (int k = 0; k < 7; ++k) cin[k + 1] = CS[((size_t)((p * 8 + k) * 2 + 0) * 2 + 0) * DM + cabs] * cin[k] + CS[((size_t)((p * 8 + k) * 2 + 0) * 2 + 1) * DM + cabs]; }
        else { cin[7] = carry;
#pragma unroll
            for (int k = 7; k > 0; --k) cin[k - 1] = CS[((size_t)((p * 8 + k) * 2 + 1) * 2 + 0) * DM + cabs] * cin[k] + CS[((size_t)((p * 8 + k) * 2 + 1) * 2 + 1) * DM + cabs]; }
    }
    v4u un[4], gn = {0u, 0u, 0u, 0u};
#define SC_PREFETCH(k) do { const int pos_ = pos0 + 32 * (k) + ct; const size_t row_ = (size_t)p * 256 + 32 * (k) + ct; \
        _Pragma("unroll") for (int kk = 0; kk < 4; ++kk) { const int p2 = pos_ + kk - 2; \
            un[kk] = (p2 >= 0 && p2 < seqlen) ? *(const v4u*)(PROJ2 + (size_t)((ptrdiff_t)row_ + kk - 2) * RGW + 2048 + h * 128 + cc) : (v4u){0u, 0u, 0u, 0u}; } \
        if (PASS3) gn = *(const v4u*)(PROJ2 + row_ * RGW + h * 128 + cc); } while (0)
    SC_PREFETCH(k0);
    LDS_BAR();
#pragma unroll 1
    for (int k = k0; k < k1; ++k) {
        LAS unsigned char* ucb = lds + SC_UC0 + (k & 1) * SC_UC_BYTES;
        LAS float* UCF = (LAS float*)ucb;
        const v4u gcur = gn;
        { float acc[8];
#pragma unroll
          for (int j = 0; j < 8; ++j) acc[j] = cbv[j];
#pragma unroll
          for (int kk = 0; kk < 4; ++kk) {
              const unsigned uw[4] = {un[kk].x, un[kk].y, un[kk].z, un[kk].w};
#pragma unroll
              for (int i = 0; i < 4; ++i) { acc[2 * i] += cwv[kk][2 * i] * bf_lo(uw[i]); acc[2 * i + 1] += cwv[kk][2 * i + 1] * bf_hi(uw[i]); } }
          *(LAS f32x4*)(UCF + ct * UCF_STR + cc) = (f32x4){acc[0], acc[1], acc[2], acc[3]}; *(LAS f32x4*)(UCF + ct * UCF_STR + cc + 4) = (f32x4){acc[4], acc[5], acc[6], acc[7]};
          v4u o; o.x = cvtpk(acc[0], acc[1]); o.y = cvtpk(acc[2], acc[3]); o.z = cvtpk(acc[4], acc[5]); o.w = cvtpk(acc[6], acc[7]);
          *(LAS v4u*)(ucb + 32 * UCF_STR * 4 + ct * (KSTR * 2) + cc * 2) = o; }
        LDS_BAR();
        if (k + 1 < k1) SC_PREFETCH(k + 1);
        float ucv[16];
#pragma unroll
        for (int r = 0; r < 16; ++r) ucv[r] = UCF[crow(r, hi) * UCF_STR + 32 * cq + r32];
        asm volatile("" ::: "memory");
        f32x16 gr, gi;
#pragma unroll
        for (int r = 0; r < 16; ++r) { gr[r] = 0.f; gi[r] = 0.f; }
        { const LAS unsigned char* ub = ucb + 32 * UCF_STR * 4 + r32 * (KSTR * 2) + 16 * hi;
          bf16x8 af[8];
#pragma unroll
          for (int kk = 0; kk < 8; ++kk) af[kk] = *(const LAS bf16x8*)(ub + 32 * kk);
          asm volatile("" ::: "memory"); __builtin_amdgcn_sched_barrier(0);
#pragma unroll
          for (int kk = 0; kk < 8; ++kk) {
              gr = __builtin_amdgcn_mfma_f32_32x32x16_bf16(af[kk], wfa[kk], gr, 0, 0, 0);
              gi = __builtin_amdgcn_mfma_f32_32x32x16_bf16(af[kk], wfx[kk], gi, 0, 0, 0); } }
        float av[16], bv[16]; unsigned abw[16];
#pragma unroll
        for (int r = 0; r < 16; r += 2) {
            const f32x2 xr = (f32x2){gr[r], gr[r + 1]} + ba, xi = (f32x2){gi[r], gi[r + 1]} + bx;
            const f32x2 tr = xr * -1.4426950408889634f, ti = xi * -1.4426950408889634f;
            f32x2 er, ei; er.x = __builtin_amdgcn_exp2f(tr.x); er.y = __builtin_amdgcn_exp2f(tr.y); ei.x = __builtin_amdgcn_exp2f(ti.x); ei.y = __builtin_amdgcn_exp2f(ti.y);
            const f32x2 pr = er + 1.0f, pi = ei + 1.0f, P = pr * pi;
            f32x2 inv; inv.x = __builtin_amdgcn_rcpf(P.x); inv.y = __builtin_amdgcn_rcpf(P.y);
            const f32x2 rr = pi * inv, ii = pr * inv;
            const f32x2 la = rr * -sp8, l2u = la * 1.4426950408889634f;
            f32x2 a2; a2.x = __builtin_amdgcn_exp2f(l2u.x); a2.y = __builtin_amdgcn_exp2f(l2u.y);
            const f32x2 x = la * 2.0f;
            f32x2 pp = x * 0.2f + 1.0f; pp = (x * 0.25f) * pp + 1.0f; pp = (x * (1.0f / 3.0f)) * pp + 1.0f; pp = (x * 0.5f) * pp + 1.0f;
            const f32x2 ser = -x * pp, dir = 1.0f - a2 * a2;
            f32x2 m2; m2.x = la.x > -0.25f ? ser.x : dir.x; m2.y = la.y > -0.25f ? ser.y : dir.y;
            f32x2 mult; mult.x = __builtin_amdgcn_sqrtf(m2.x); mult.y = __builtin_amdgcn_sqrtf(m2.y);
            const f32x2 uc = (f32x2){ucv[r], ucv[r + 1]};
            const f32x2 bbu = mult * ii * uc;
            av[r] = a2.x; av[r + 1] = a2.y; bv[r] = bbu.x; bv[r + 1] = bbu.y;
        }
        float hv[16], At, Ht;
        if (!PASS3) {
            float pv[16];
            if (d == 0) lane_scan<false, true, true>(av, bv, hi, 0.0f, hv, At, Ht, pv); else lane_scan<true, true, true>(av, bv, hi, 0.0f, hv, At, Ht, pv);
            if (p < 64) {
#pragma unroll
                for (int r = 0; r < 16; ++r) { h2_t w; w.x = (_Float16)hv[r]; w.y = (_Float16)pv[r]; abw[r] = __builtin_bit_cast(unsigned, w); }
                unsigned* dst = (unsigned*)(ws + WS_ABH) + ((size_t)((p * 16 + h) * 8 + k) * 8 + wave) * (64 * 16) + lane * 4;
#pragma unroll
                for (int q = 0; q < 4; ++q) *(v4u*)(dst + 256 * q) = (v4u){abw[4 * q], abw[4 * q + 1], abw[4 * q + 2], abw[4 * q + 3]};
            }
            if (hi == 0) { CS[((size_t)((p * 8 + k) * 2 + d) * 2 + 0) * DM + cabs] = At; CS[((size_t)((p * 8 + k) * 2 + d) * 2 + 1) * DM + cabs] = Ht; }
            if (d == 0) { PH = At * PH + Ht; PA *= At; } else { PH = PA * Ht + PH; PA *= At; }
        } else {
            float c0 = cin[0];
#pragma unroll
            for (int j = 1; j < 8; ++j) c0 = (k == j) ? cin[j] : c0;
            if (d == 0) lane_scan<false, true>(av, bv, hi, c0, hv, At, Ht); else lane_scan<true, true>(av, bv, hi, c0, hv, At, Ht);
#pragma unroll
            for (int r = 0; r < 16; ++r) Y[(d * 32 + crow(r, hi)) * 128 + 32 * cq + r32] = hv[r];
            LDS_BAR();
            const size_t row = (size_t)p * 256 + 32 * k + ct;
            const f32x4 y0 = *(const LAS f32x4*)(Y + ct * 128 + cc) + *(const LAS f32x4*)(Y + (32 + ct) * 128 + cc);
            const f32x4 y1 = *(const LAS f32x4*)(Y + ct * 128 + cc + 4) + *(const LAS f32x4*)(Y + (32 + ct) * 128 + cc + 4);
            v4u o;
            o.x = cvtpk(y0.x * gelu_tanh_f(bf_lo(gcur.x)), y0.y * gelu_tanh_f(bf_hi(gcur.x))); o.y = cvtpk(y0.z * gelu_tanh_f(bf_lo(gcur.y)), y0.w * gelu_tanh_f(bf_hi(gcur.y)));
            o.z = cvtpk(y1.x * gelu_tanh_f(bf_lo(gcur.z)), y1.y * gelu_tanh_f(bf_hi(gcur.z))); o.w = cvtpk(y1.z * gelu_tanh_f(bf_lo(gcur.w)), y1.w * gelu_tanh_f(bf_hi(gcur.w)));
            *(v4u*)(MIX + row * DM + h * 128 + cc) = o;
        }
    }
#undef SC_PREFETCH
    if (!PASS3 && hi == 0 && k1 - k0 == 8) { PS[((size_t)(p * 2 + d) * 2 + 0) * DM + cabs] = PA; PS[((size_t)(p * 2 + d) * 2 + 1) * DM + cabs] = PH; }
}

template <int NU>
__device__ __forceinline__ void scan_carry(const float* __restrict__ CS, const float* __restrict__ PS, const int (&pp)[NU], int d, int cabs, float (&cin)[NU][8]) {
    float carry[NU]; int nprev[NU], nmax = 0;
#pragma unroll
    for (int u = 0; u < NU; ++u) { const int b = pp[u] >> 5; float ca[8], chh[8];
#pragma unroll
        for (int k = 0; k < 8; ++k) { ca[k] = CS[((size_t)(((64 + b) * 8 + k) * 2 + d) * 2 + 0) * DM + cabs]; chh[k] = CS[((size_t)(((64 + b) * 8 + k) * 2 + d) * 2 + 1) * DM + cabs]; }
        float c = 0.0f;
#pragma unroll
        for (int k = 0; k < 8; ++k) { const int kk = d ? 7 - k : k; c = ca[kk] * c + chh[kk]; }
        carry[u] = c; nprev[u] = d ? (32 * b + 31 - pp[u]) : (pp[u] - 32 * b); nmax = nprev[u] > nmax ? nprev[u] : nmax; }
    for (int q0 = 0; q0 < nmax; q0 += 8) {
        float pa[NU][8], ph[NU][8];
#pragma unroll
        for (int u = 0; u < NU; ++u) { const int b = pp[u] >> 5;
#pragma unroll
            for (int q = 0; q < 8; ++q) { const int qq = (q0 + q < nprev[u]) ? q0 + q : 0; const int pq = d ? (32 * b + 31 - qq) : (32 * b + qq);
                pa[u][q] = PS[((size_t)(pq * 2 + d) * 2 + 0) * DM + cabs]; ph[u][q] = PS[((size_t)(pq * 2 + d) * 2 + 1) * DM + cabs]; } }
#pragma unroll
        for (int u = 0; u < NU; ++u)
#pragma unroll
            for (int q = 0; q < 8; ++q) if (q0 + q < nprev[u]) carry[u] = pa[u][q] * carry[u] + ph[u][q];
    }
#pragma unroll
    for (int u = 0; u < NU; ++u) { const int p = pp[u]; float cj[8];
        float c = carry[u];
#pragma unroll
        for (int j = 0; j < 8; ++j) { const int k = d ? 7 - j : j; cj[j] = c;
            if (j < 7) c = CS[((size_t)((p * 8 + k) * 2 + d) * 2 + 0) * DM + cabs] * c + CS[((size_t)((p * 8 + k) * 2 + d) * 2 + 1) * DM + cabs]; }
#pragma unroll
        for (int k = 0; k < 8; ++k) cin[u][k] = d ? cj[7 - k] : cj[k]; }
}

__device__ __forceinline__ void scan_carry4(const float* __restrict__ CS, const float* __restrict__ PS, const int (&pp)[4], int d, int cabs, float (&cin)[4][8]) {
    float carry[4] = {0.f, 0.f, 0.f, 0.f};
    float cg[2]; int n0[2], n1[2]; const float* pb[2];
    { float ca[2][8], chh[2][8];
#pragma unroll
      for (int g = 0; g < 2; ++g) { const int b = pp[2 * g] >> 5;
#pragma unroll
          for (int k = 0; k < 8; ++k) { ca[g][k] = CS[((size_t)(((64 + b) * 8 + k) * 2 + d) * 2 + 0) * DM + cabs]; chh[g][k] = CS[((size_t)(((64 + b) * 8 + k) * 2 + d) * 2 + 1) * DM + cabs]; } }
#pragma unroll
      for (int g = 0; g < 2; ++g) { const int b = pp[2 * g] >> 5; float c = 0.0f;
#pragma unroll
          for (int k = 0; k < 8; ++k) { const int kk = d ? 7 - k : k; c = ca[g][kk] * c + chh[g][kk]; }
          cg[g] = c;
          n0[g] = d ? (32 * b + 31 - pp[2 * g]) : (pp[2 * g] - 32 * b); n1[g] = d ? (32 * b + 31 - pp[2 * g + 1]) : (pp[2 * g + 1] - 32 * b);
          pb[g] = PS + ((size_t)((d ? 32 * b + 31 : 32 * b) * 2 + d) * 2) * DM + cabs; } }
    const ptrdiff_t st = d ? -(ptrdiff_t)(4 * DM) : (ptrdiff_t)(4 * DM);
#pragma unroll 1
    for (int q0 = 0; q0 < 32; q0 += 16) {
        float pa[2][16], ph[2][16];
#pragma unroll
        for (int g = 0; g < 2; ++g)
#pragma unroll
            for (int q = 0; q < 16; ++q) { const float* pq = pb[g] + (ptrdiff_t)(q0 + q) * st; pa[g][q] = pq[0]; ph[g][q] = pq[DM]; }
#pragma unroll
        for (int g = 0; g < 2; ++g)
#pragma unroll
            for (int q = 0; q < 16; ++q) { carry[2 * g] = (q0 + q == n0[g]) ? cg[g] : carry[2 * g]; carry[2 * g + 1] = (q0 + q == n1[g]) ? cg[g] : carry[2 * g + 1]; cg[g] = pa[g][q] * cg[g] + ph[g][q]; }
    }
#pragma unroll
    for (int u = 0; u < 4; ++u) { const int p = pp[u]; float cj[8];
        float c = carry[u];
#pragma unroll
        for (int j = 0; j < 8; ++j) { const int k = d ? 7 - j : j; cj[j] = c;
            if (j < 7) c = CS[((size_t)((p * 8 + k) * 2 + d) * 2 + 0) * DM + cabs] * c + CS[((size_t)((p * 8 + k) * 2 + d) * 2 + 1) * DM + cabs]; }
#pragma unroll
        for (int k = 0; k < 8; ++k) cin[u][k] = d ? cj[7 - k] : cj[k]; }
}

__device__ __forceinline__ void sa_prefetch_pair(unsigned char* ws, int p, int h, int k, int tid, int wave, int lane, v4u (&ab0)[4], v4u (&ab1)[4], v4u& g0, v4u& g1) {
    const bf16* PROJ2 = (const bf16*)(ws + WS_H);
    const int ct = tid >> 4, cc = (tid & 15) * 8;
    const unsigned* s0 = (const unsigned*)(ws + WS_ABH) + ((size_t)((p * 16 + h) * 8 + k) * 8 + wave) * (64 * 16) + lane * 4;
#pragma unroll
    for (int q = 0; q < 4; ++q) { ab0[q] = *(const v4u*)(s0 + 256 * q); ab1[q] = *(const v4u*)(s0 + 8 * 64 * 16 + 256 * q); }
    g0 = *(const v4u*)(PROJ2 + ((size_t)p * 256 + 32 * k + ct) * RGW + h * 128 + cc);
    g1 = *(const v4u*)(PROJ2 + ((size_t)p * 256 + 32 * (k + 1) + ct) * RGW + h * 128 + cc);
}

constexpr int SA_Y = 0;
static_assert(SA_Y + 2 * 4 * 32 * 128 * 4 <= RING_BYTES, "scan pass 3 LDS map");
__device__ __forceinline__ void scan_apply_unit(const Args& a, unsigned char* ws, LAS unsigned char* lds, int p, int h, int tid, int wave, int lane,
                                                float ci0, float ci1, float ci2, float ci3, float ci4, float ci5, float ci6, float ci7,
                                                v4u (&ab0)[4], v4u (&ab1)[4], v4u& g0, v4u& g1, int pnext, int hnext) {
    const float cin[8] = {ci0, ci1, ci2, ci3, ci4, ci5, ci6, ci7};
    const bf16* PROJ2 = (const bf16*)(ws + WS_H);
    bf16* MIX = (bf16*)(ws + WS_MIX);
    const int r32 = lane & 31, hi = lane >> 5;
    const int d = wave >> 2, cq = wave & 3;
    const int ct = tid >> 4, cc = (tid & 15) * 8;
    const unsigned* abase = (const unsigned*)(ws + WS_ABH) + ((size_t)((p * 16 + h) * 8) * 8 + wave) * (64 * 16) + lane * 4;
#define SA_PREFETCH(AB, GG, k) do { const unsigned* s_ = abase + (size_t)(k) * (8 * 64 * 16); \
        _Pragma("unroll") for (int q = 0; q < 4; ++q) AB[q] = *(const v4u*)(s_ + 256 * q); \
        GG = *(const v4u*)(PROJ2 + ((size_t)p * 256 + 32 * (k) + ct) * RGW + h * 128 + cc); } while (0)
#define SA_UNPACK(AB, HV, CI) do { _Pragma("unroll") for (int q = 0; q < 4; ++q) { const unsigned w[4] = {AB[q].x, AB[q].y, AB[q].z, AB[q].w}; \
        _Pragma("unroll") for (int e = 0; e < 4; ++e) { const h2_t hv2 = __builtin_bit_cast(h2_t, w[e]); HV[4 * q + e] = (float)hv2.x + (float)hv2.y * (CI); } } } while (0)
#define SA_EMIT(YB, GC, k) do { const size_t row = (size_t)p * 256 + 32 * (k) + ct; \
        const f32x4 y0 = *(const LAS f32x4*)(YB + ct * 128 + cc) + *(const LAS f32x4*)(YB + (32 + ct) * 128 + cc); \
        const f32x4 y1 = *(const LAS f32x4*)(YB + ct * 128 + cc + 4) + *(const LAS f32x4*)(YB + (32 + ct) * 128 + cc + 4); \
        v4u o; \
        o.x = cvtpk(y0.x * gelu_tanh_f(bf_lo(GC.x)), y0.y * gelu_tanh_f(bf_hi(GC.x))); o.y = cvtpk(y0.z * gelu_tanh_f(bf_lo(GC.y)), y0.w * gelu_tanh_f(bf_hi(GC.y))); \
        o.z = cvtpk(y1.x * gelu_tanh_f(bf_lo(GC.z)), y1.y * gelu_tanh_f(bf_hi(GC.z))); o.w = cvtpk(y1.z * gelu_tanh_f(bf_lo(GC.w)), y1.w * gelu_tanh_f(bf_hi(GC.w))); \
        *(v4u*)(MIX + row * DM + h * 128 + cc) = o; } while (0)
    LDS_BAR();
#pragma unroll 1
    for (int k = 0; k < 8; k += 2) {
        LAS float* Y0 = (LAS float*)(lds + SA_Y + ((k >> 1) & 1) * (4 * 32 * 128 * 4));
        LAS float* Y1 = Y0 + 2 * 32 * 128;
        const v4u gc0 = g0, gc1 = g1;
        float c0 = cin[0], c1 = cin[1];
#pragma unroll
        for (int j = 2; j < 8; j += 2) { c0 = (k == j) ? cin[j] : c0; c1 = (k == j) ? cin[j + 1] : c1; }
        float hv0[16], hv1[16];
        SA_UNPACK(ab0, hv0, c0); SA_UNPACK(ab1, hv1, c1);
        if (k + 2 < 8) { SA_PREFETCH(ab0, g0, k + 2); SA_PREFETCH(ab1, g1, k + 3); }
        else if (pnext >= 0) sa_prefetch_pair(ws, pnext, hnext, 0, tid, wave, lane, ab0, ab1, g0, g1);
#pragma unroll
        for (int r = 0; r < 16; ++r) { Y0[(d * 32 + crow(r, hi)) * 128 + 32 * cq + r32] = hv0[r]; Y1[(d * 32 + crow(r, hi)) * 128 + 32 * cq + r32] = hv1[r]; }
        LDS_BAR();
        SA_EMIT(Y0, gc0, k); SA_EMIT(Y1, gc1, k + 1);
    }
#undef SA_UNPACK
#undef SA_EMIT
#undef SA_PREFETCH
}

#ifndef MK_ONE_LAUNCH
#define MK_ONE_LAUNCH 1
#endif
constexpr int N_PHASES = 23;
#define C8(x) x[0], x[1], x[2], x[3], x[4], x[5], x[6], x[7]
#ifndef PG8_SP2
#define PG8_SP2 true
#endif
#ifndef REP_THIN
#define REP_THIN 1
#endif
#ifndef REP_UP
#define REP_UP 1
#endif
#ifndef REP_DOWN
#define REP_DOWN 1
#endif
#ifndef REP_P0
#define REP_P0 REP_THIN
#endif
#ifndef REP_NORM
#define REP_NORM REP_THIN
#endif
#ifndef REP_AT
#define REP_AT 1
#endif
#ifndef REP_CONV
#define REP_CONV 1
#endif
#ifndef REP_ATTN
#define REP_ATTN REP_THIN
#endif
#ifndef REP_SCAN
#define REP_SCAN REP_THIN
#endif
#ifndef REP_SCAN1
#define REP_SCAN1 REP_SCAN
#endif
#define RT_(n) _Pragma("unroll 1") for (int rt_ = 0; rt_ < (n); ++rt_)
#define RU_
#ifndef EXP_THR_PHASE
#define EXP_THR_PHASE -1
#endif
#ifndef EXP_CLK_PHASE
#define EXP_CLK_PHASE -1
#endif
#ifndef TLB_TOUCH_PHASE
#define TLB_TOUCH_PHASE -1
#endif
#ifndef REP_UP_PHASE
#define REP_UP_PHASE -1
#endif
#ifdef DIS_NORM
#define final_norm_phase(...) do {} while (0)
#endif
__device__ __forceinline__ void tlb_touch(const void* p, size_t bytes, int G, int bid, int tid) {
    const size_t id = (size_t)(bid >> 3) * NTHR + tid, n = (size_t)(G >> 3) * NTHR, np = bytes >> 12;
    unsigned acc = 0;
    for (size_t i = id; i < np; i += n) acc += __builtin_nontemporal_load((const unsigned*)((const char*)p + (i << 12)));
    asm volatile("" :: "v"(acc));
}
template <class Epi, class Sched> __device__ __forceinline__ void run_gemm(LAS unsigned char* lds, const bf16* A, const bf16* Bt, int M, int N, int K, int G, int bid, const Epi& E, int slow = -1) {
    pg8::Gemm g{A, Bt, K, 128, 128}; Sched S; S.init(G, bid, slow); pg8::gemm_phase<Epi, Sched, true, PG8_SP2>(lds, g, S, E);
}
template <class Epi, class Sched> __device__ __forceinline__ void run_gemm_kt(LAS unsigned char* lds, const bf16* A, const bf16* Bt, int M, int N, int G, int bid, const Epi& E, int slow = -1, int thr = 0) {
    pg8::Gemm g{A, Bt, 0, (size_t)M * 128, (size_t)N * 128, thr}; Sched S; S.init(G, bid, slow); pg8::gemm_phase<Epi, Sched, true, PG8_SP2>(lds, g, S, E);
}
__global__ void __launch_bounds__(NTHR, 2) fwd_kernel(Args args) {
    extern __shared__ __attribute__((aligned(16))) unsigned char lds_raw[];
    LAS unsigned char* lds = (LAS unsigned char*)lds_raw;
    volatile LAS unsigned* MISC = (volatile LAS unsigned*)(lds + MISC_OFF);
    const int tid = threadIdx.x, lane = tid & 63, wave = __builtin_amdgcn_readfirstlane(tid >> 6);
    const int G = gridDim.x, bid = blockIdx.x;
    unsigned char* ws = args.ws;
    for (int u = tid; u < (LDS_BYTES - LDSCTL_OFF) / 4; u += NTHR) ((LAS unsigned*)(lds + LDSCTL_OFF))[u] = 0u;
    __syncthreads();
    const int lo = args.ph_lo, hi = args.ph_hi;
    XcdBarrier bar; bar.bar = (unsigned*)(ws + WS_CTL) + CW_BAR; bar.x = 0; bar.st = nullptr;
    if (hi - lo > 1) bar = xcd_barrier_post((unsigned*)(ws + WS_CTL) + CW_BAR, MISC + 8);
#define IN(k) (lo <= (k) && (k) < hi)
#ifndef REP_BAR
#define REP_BAR 1
#endif
#if defined(PROBE_WAIT)
#ifndef PROBE_GRP
#define PROBE_GRP 0
#endif
#ifndef PROBE_PHASE
#define PROBE_PHASE 1000
#endif
#ifndef PROBE_CUM
#define PROBE_CUM 0
#endif
#ifndef PROBE_BASE
#define PROBE_BASE 0
#endif
#ifndef PROBE_SCALE
#define PROBE_SCALE 0.1f
#endif
#define SEAM(k) do { if (IN(k) && IN((k) + 1)) { if ((k) == 2) CALIBRATE_ARRIVE(); const unsigned long long t0_ = __builtin_amdgcn_s_memrealtime(); xcd_barrier(bar); \
        if (tid == 0 && ((PROBE_WAIT >> (k)) & 1)) { const unsigned long long dt_ = __builtin_amdgcn_s_memrealtime() - t0_; atomicAdd((unsigned long long*)(ws + WS_CTL) + 4000, dt_); \
            atomicAdd((unsigned long long*)(ws + WS_CTL) + 4010 + 2 * (PROBE_GRP ? (bid & 7) : xb_xcc_id()), dt_); atomicAdd((unsigned long long*)(ws + WS_CTL) + 4011 + 2 * (PROBE_GRP ? (bid & 7) : xb_xcc_id()), 1ull); } if ((k) == 2) CALIBRATE_DECIDE(); \
        if (bid == 0 && tid == 0) { if ((k) == PROBE_PHASE - 1 && !PROBE_CUM) *((unsigned long long*)(ws + WS_CTL) + 4100) = __builtin_amdgcn_s_memrealtime(); if ((k) == PROBE_PHASE) *((unsigned long long*)(ws + WS_CTL) + 4101) = __builtin_amdgcn_s_memrealtime(); } } } while (0)
#else
#define SEAM(k) do { if (IN(k) && IN((k) + 1)) { if ((k) == 2) CALIBRATE_ARRIVE(); _Pragma("unroll 1") for (int rb_ = 0; rb_ < REP_BAR; ++rb_) xcd_barrier(bar); if ((k) == 2) CALIBRATE_DECIDE(); } } while (0)
#endif
#if !defined(USE_ADAPT)
#define NO_ADAPT_HOOK slow = -1;
#else
#define NO_ADAPT_HOOK
#endif
#if defined(USE_ADAPT)
#define CALIBRATE_ARRIVE() do { if (G == 256 && tid == 0) __hip_atomic_store((unsigned long long*)(ws + WS_CTL) + 8192 + bid, (unsigned long long)__builtin_amdgcn_s_memrealtime(), __ATOMIC_RELAXED, __HIP_MEMORY_SCOPE_AGENT); } while (0)
#define CALIBRATE_DECIDE() do { if (G == 256) { if (wave == 0) { const unsigned long long* T_ = (const unsigned long long*)(ws + WS_CTL) + 8192; const unsigned long long b_ = T_[0]; \
            long long v_ = (long long)(T_[lane] - b_) + (long long)(T_[lane + 64] - b_) + (long long)(T_[lane + 128] - b_) + (long long)(T_[lane + 192] - b_); \
            v_ += __shfl_xor(v_, 8); v_ += __shfl_xor(v_, 16); v_ += __shfl_xor(v_, 32); int i_ = lane & 7; \
            _Pragma("unroll") for (int o_ = 1; o_ < 8; o_ <<= 1) { const long long ov_ = __shfl_xor(v_, o_); const int oi_ = __shfl_xor(i_, o_); if (ov_ > v_ || (ov_ == v_ && oi_ < i_)) { v_ = ov_; i_ = oi_; } } \
            const long long tot_ = v_  ; long long all_ = (long long)(T_[lane] - b_) + (long long)(T_[lane + 64] - b_) + (long long)(T_[lane + 128] - b_) + (long long)(T_[lane + 192] - b_); \
            all_ += __shfl_xor(all_, 1); all_ += __shfl_xor(all_, 2); all_ += __shfl_xor(all_, 4); all_ += __shfl_xor(all_, 8); all_ += __shfl_xor(all_, 16); all_ += __shfl_xor(all_, 32); \
              \
            const bool sig_ = (tot_ * 7 - (all_ - tot_)) > 800LL * 224; \
            if (lane == 0) MISC[16] = sig_ ? (unsigned)(i_ + 1) : 0u; } \
        __syncthreads(); slow = __builtin_amdgcn_readfirstlane((int)MISC[16]) - 1; __syncthreads(); NO_ADAPT_HOOK } } while (0)
#else
#define CALIBRATE_ARRIVE() do {} while (0)
#define CALIBRATE_DECIDE() do {} while (0)
#endif
    const int gw = bid * NWAVES + wave, ngw = G * NWAVES, gwalt = wave * G + bid;
    float* MOD = (float*)(ws + WS_MOD);
    bf16* X = (bf16*)(ws + WS_X);
    bf16* XN = (bf16*)(ws + WS_XN);
    bf16* HB = (bf16*)(ws + WS_H);
    bf16* MIX = (bf16*)(ws + WS_MIX);
    float* SLAB = (float*)(ws + WS_SLAB);

#if defined(PROBE_WAIT)
    if ((PROBE_PHASE == 0 || PROBE_PHASE == 23 || PROBE_CUM) && bid == 0 && tid == 0) *((unsigned long long*)(ws + WS_CTL) + 4100) = __builtin_amdgcn_s_memrealtime();
#if defined(EXP_SLEEP_US)
    { const unsigned long long t0_ = __builtin_amdgcn_s_memrealtime(); while (__builtin_amdgcn_s_memrealtime() - t0_ < (unsigned long long)(EXP_SLEEP_US) * 100ull) __builtin_amdgcn_s_sleep(100); }
#endif
#if defined(EXP_STREAM_US)
    { const unsigned long long t0_ = __builtin_amdgcn_s_memrealtime(); unsigned sacc_ = 0; size_t so_ = ((size_t)bid * NTHR + tid) * 16;
      while (__builtin_amdgcn_s_memrealtime() - t0_ < (unsigned long long)(EXP_STREAM_US) * 100ull) {
#pragma unroll
          for (int i = 0; i < 8; ++i) { const v4u v_ = __builtin_nontemporal_load((const v4u*)(ws + WS_H + so_)); sacc_ += v_.x ^ v_.w; so_ += (size_t)G * NTHR * 16; if (so_ >= (size_t)512 * MiB) so_ -= (size_t)512 * MiB; } }
      asm volatile("" :: "v"(sacc_)); }
#endif
#if defined(EXP_HEAT_US)
    { const unsigned long long t0_ = __builtin_amdgcn_s_memrealtime(); f32x16 hacc_; for (int r = 0; r < 16; ++r) hacc_[r] = 0.f;
      v4u ha_ = {0x3f803f80u + tid * 0x10001u, 0xbf80bf80u ^ (tid * 77u), 0x3e803e80u + lane, 0xbe80be80u}, hb_ = {0x3f003f00u + lane * 3u, 0xbf00bf00u, 0x3f803f80u ^ tid, 0x3e003e00u};
      while (__builtin_amdgcn_s_memrealtime() - t0_ < (unsigned long long)(EXP_HEAT_US) * 100ull) {
#pragma unroll
          for (int i = 0; i < 32; ++i) hacc_ = __builtin_amdgcn_mfma_f32_32x32x16_bf16(__builtin_bit_cast(bf16x8, ha_), __builtin_bit_cast(bf16x8, hb_), hacc_, 0, 0, 0); }
      if (hacc_[0] == 12345.678f && hacc_[5] == 3.0f) args.out[1] = hacc_[0]; }
#endif
#if defined(PROBE_WARM)
    unsigned warm_ = 0; if (bid == 0 && tid == 0) warm_ = __hip_atomic_load((unsigned*)(ws + WS_ROPE + 262144), __ATOMIC_RELAXED, __HIP_MEMORY_SCOPE_AGENT);
#endif
#endif
    int slow = -1;
#ifndef DIS_P0
    if (IN(0)) RT_(REP_P0) { p0_prologue(args, ws, lds, G, bid, tid, wave, lane); }
#endif
    SEAM(0);

#define FILL_TAIL(nbusy, a0, a1, b0, b1) do { const int rk_ = pg8::xrank(bid, slow);     \
        if (rk_ >= (nbusy) && rk_ < 0x3fffffff) convert_ranges(args, ws, lds, a0, a1, b0, b1, (rk_ - (nbusy)) * NWAVES + wave, ((slow < 0 ? G : G - G / 8) - (nbusy)) * NWAVES, wave, lane); } while (0)
#define FFN_BLOCK(MP, s, base, nslab_in, FILL) do { \
        const int l_ = (s) >> 1, which_ = (s) & 1; \
        const float* modl_ = MOD + (size_t)l_ * 3 * MODW; \
        if (IN(base)) RT_(REP_NORM) { const float* g_ = (which_ ? args.in[I_NF2] : args.in[I_NF1]) + (size_t)l_ * DM; \
            if ((s) == 0) norm_phase<true, true>(args.in[I_X], args.in[I_CTX], (MP) * 256, g_, modl_ + (which_ ? 6 : 0) * DM, modl_ + (which_ ? 7 : 1) * DM, XN, gw, ngw, lane, gwalt, SLAB, nslab_in, X + (size_t)NLAT * DM, lds); \
            else norm_phase<false, false>(X, X + (size_t)NLAT * DM, (MP) * 256, g_, modl_ + (which_ ? 6 : 0) * DM, modl_ + (which_ ? 7 : 1) * DM, XN, gw, ngw, lane, gwalt, SLAB, nslab_in, X + (size_t)NLAT * DM, lds); } \
        SEAM(base); \
        if (IN((base) + 1)) RU_ { pg8::EpiSwiGLU E_{HB, MROWS}; \
            if (EXP_CLK_PHASE == (base) + 1) { const unsigned long long t0_ = __builtin_amdgcn_s_memrealtime(); f32x16 hacc_; for (int r = 0; r < 16; ++r) hacc_[r] = 0.f; \
                v4u ha_ = {0x3f803f80u + tid * 0x10001u, 0xbf80bf80u ^ (tid * 77u), 0x3e803e80u + lane, 0xbe80be80u}, hb_ = {0x3f003f00u + lane * 3u, 0xbf00bf00u, 0x3f803f80u ^ tid, 0x3e003e00u}; \
                _Pragma("unroll 1") for (int i_ = 0; i_ < 100; ++i_) { _Pragma("unroll") for (int j_ = 0; j_ < 32; ++j_) hacc_ = __builtin_amdgcn_mfma_f32_32x32x16_bf16(__builtin_bit_cast(bf16x8, ha_), __builtin_bit_cast(bf16x8, hb_), hacc_, 0, 0, 0); } \
                if (hacc_[0] == 12345.678f && hacc_[5] == 3.0f) args.out[1] = hacc_[0]; \
                if (bid == 0 && tid == 0) *((unsigned long long*)(ws + WS_CTL) + 4102) = __builtin_amdgcn_s_memrealtime() - t0_; } \
            if (TLB_TOUCH_PHASE == (base) + 1 || TLB_TOUCH_PHASE == -2) { tlb_touch(ws + WS_WIN + (size_t)(s) * WIN_BYTES, WIN_BYTES, G, bid, tid); tlb_touch(XN, (size_t)MROWS * DM * 2, G, bid, tid); tlb_touch(HB, (size_t)MROWS * DFF * 2, G, bid, tid); } \
            run_gemm_kt<pg8::EpiSwiGLU, pg8::StaticOrderC<MP, 44, 32>>(lds + RING_OFF, XN, (const bf16*)(ws + WS_WIN + (size_t)(s) * WIN_BYTES), MROWS, 2 * DFF, G, bid, E_, slow, ((base) + 1 == EXP_THR_PHASE) ? 1 : 0); \
            if (REP_UP > 1 && (REP_UP_PHASE < 0 || (base) + 1 == REP_UP_PHASE)) run_gemm_kt<pg8::EpiSwiGLU, pg8::StaticOrderC<MP, 44, 32>>(lds + RING_OFF, XN, (const bf16*)(ws + WS_WIN + (size_t)(s) * WIN_BYTES), MROWS, 2 * DFF, G, bid, E_, slow); \
            FILL; } \
        SEAM((base) + 1); \
        if (IN((base) + 2)) { pg8::EpiResid E_{((s) == 0) ? args.in[I_X] : nullptr, ((s) == 0) ? args.in[I_CTX] : nullptr, X, modl_ + (which_ ? 8 : 2) * DM, MODW, 0.5f, SLAB}; \
            if ((MP) == 66) run_gemm_kt<pg8::EpiResid, pg8::SplitCtxOrder<8, 88>>(lds + RING_OFF, HB, (const bf16*)(ws + WS_WOUT + (size_t)(s) * WOUT_BYTES), MROWS, DM, G, bid, E_, slow); \
            else run_gemm_kt<pg8::EpiResid, pg8::StaticOrderC<64, 8, 88, 4>>(lds + RING_OFF, HB, (const bf16*)(ws + WS_WOUT + (size_t)(s) * WOUT_BYTES), MROWS, DM, G, bid, E_, slow); \
            if (REP_DOWN == 2) { pg8::EpiResid E2_{nullptr, nullptr, X, modl_ + (which_ ? 8 : 2) * DM, MODW, 0.0f, SLAB}; \
                run_gemm_kt<pg8::EpiResid, pg8::StaticOrderC<64, 8, 88, 4>>(lds + RING_OFF, HB, (const bf16*)(ws + WS_WOUT + (size_t)(s) * WOUT_BYTES), MROWS, DM, G, bid, E2_, slow); } \
            if (REP_DOWN == 3) { pg8::EpiNull E3_{}; \
                run_gemm_kt<pg8::EpiNull, pg8::StaticOrderC<64, 8, 88, 4>>(lds + RING_OFF, HB, (const bf16*)(ws + WS_WOUT + (size_t)(s) * WOUT_BYTES), MROWS, DM, G, bid, E3_, slow); } } \
        SEAM((base) + 2); \
    } while (0)

    FFN_BLOCK(66, 0, 1, 0, do { FILL_TAIL(88, TL_WOUT, TL_WOUT + T_WOUT, TL_ABIN, TL_ABOUT + T_SQ); __syncthreads(); if (bid >= 88) mod_gemv_tasks(args, ws, lds, 144, 288, bid - 88, G - 88, tid, wave, lane); } while (0));
    { const float* modl = MOD;
            if (IN(4)) RT_(REP_NORM) norm_phase<false, true>(X, args.in[I_CTX], MROWS, args.in[I_NMIX], modl + 3 * DM, modl + 4 * DM, XN, gw, ngw, lane, gwalt, SLAB, 11, X + (size_t)NLAT * DM, lds);
            SEAM(4);
            if (IN(5)) RU_ { pg8::EpiBf16 E{HB, ABW};
                run_gemm_kt<pg8::EpiBf16, pg8::StaticOrderC<66, 18, 32>>(lds + RING_OFF, XN, (const bf16*)(ws + WS_WABIN), MROWS, ABW, G, bid, E, slow);
                if (REP_UP > 1) run_gemm_kt<pg8::EpiBf16, pg8::StaticOrderC<66, 18, 32>>(lds + RING_OFF, XN, (const bf16*)(ws + WS_WABIN), MROWS, ABW, G, bid, E, slow);
                FILL_TAIL(164, TL_WIN + T_WIN, TL_WIN + 2 * T_WIN, 0, 0); }
            SEAM(5);
            if (IN(6)) RT_(REP_ATTN) {
                const float* ropeC = (const float*)(ws + WS_ROPE); const float* ropeS = ropeC + 4096;
#ifndef DIS_ATTN
                RT_(REP_AT) for (int u = bid; u < 528; u += G) attn_unit(HB, MIX, args.in[I_SINK], ropeC, ropeS, lds, u, tid, wave, lane);
#endif
                RT_(REP_CONV) { if (G > 32) { if (bid >= 16) sconv_strips(HB, MIX, args.in[I_ABCONV], (bid - 16) * NTHR + tid, (G - 16) * NTHR); }
                else sconv_strips(HB, MIX, args.in[I_ABCONV], bid * NTHR + tid, G * NTHR); }
            }
            SEAM(6);
            if (IN(7)) { pg8::EpiResid E{nullptr, nullptr, X, modl + 5 * DM, MODW, 1.0f, SLAB};
                run_gemm<pg8::EpiResid, pg8::SplitCtxOrder<8, 32>>(lds + RING_OFF, MIX, (const bf16*)(ws + WS_WABOUT), MROWS, DM, DM, G, bid, E, slow); }
            SEAM(7);
    }
    FFN_BLOCK(66, 1, 8, 8, FILL_TAIL(88, TL_WOUT + T_WOUT, TL_WOUT + 2 * T_WOUT, TL_WIN + 2 * T_WIN, TL_WIN + 3 * T_WIN));
    FFN_BLOCK(66, 2, 11, 11, FILL_TAIL(88, TL_WOUT + 2 * T_WOUT, TL_WOUT + 3 * T_WOUT, TL_RGIN, T_TOTAL));
    { const float* modl = MOD + (size_t)3 * MODW;
            if (IN(14)) RT_(REP_NORM) norm_phase<false, false>(X, X + (size_t)NLAT * DM, MROWS, args.in[I_NMIX] + DM, modl + 3 * DM, modl + 4 * DM, XN, gw, ngw, lane, gwalt, SLAB, 11, X + (size_t)NLAT * DM, lds);
            SEAM(14);
            if (IN(15)) RU_ { pg8::EpiBf16 E{HB, RGW};
                run_gemm_kt<pg8::EpiBf16, pg8::StaticOrderC<66, 16, 32>>(lds + RING_OFF, XN, (const bf16*)(ws + WS_WRGIN), MROWS, RGW, G, bid, E, slow);
                if (REP_UP > 1) run_gemm_kt<pg8::EpiBf16, pg8::StaticOrderC<66, 16, 32>>(lds + RING_OFF, XN, (const bf16*)(ws + WS_WRGIN), MROWS, RGW, G, bid, E, slow);
                FILL_TAIL(32, TL_WIN + 3 * T_WIN, TL_WIN + 4 * T_WIN, TL_WOUT + 3 * T_WOUT, TL_WOUT + 4 * T_WOUT); }
            SEAM(15);
#ifndef DIS_SCAN
            if (IN(16)) RT_(REP_SCAN1) { for (int u = bid; u < 64 * 16 + 128; u += G) { if (u < 1024) scan_unit<false>(args, ws, lds, u >> 4, u & 15, tid, wave, lane);
                    else { const int v = u - 1024; scan_unit<false>(args, ws, lds, 64 + (v >> 6), (v >> 2) & 15, tid, wave, lane, 2 * (v & 3), 2 * (v & 3) + 2); } } }
            SEAM(16);
            if (IN(17)) RT_(REP_SCAN) { { const float* CSp = (const float*)(ws + WS_CS); const float* PSp = (const float*)(ws + WS_PS);
                    const int sd_ = wave >> 2, scabs_ = 32 * (wave & 3) + (lane & 31);
                    if (G == 256) {
                        const int hh = bid & 15; const int pp[4] = {bid >> 4, (bid >> 4) + 16, (bid >> 4) + 32, (bid >> 4) + 48}; float cin4[4][8];
                        v4u ab0_[4], ab1_[4], g0_, g1_; sa_prefetch_pair(ws, pp[0], hh, 0, tid, wave, lane, ab0_, ab1_, g0_, g1_);
                        scan_carry4(CSp, PSp, pp, sd_, hh * 128 + scabs_, cin4);
                        scan_apply_unit(args, ws, lds, pp[0], hh, tid, wave, lane, C8(cin4[0]), ab0_, ab1_, g0_, g1_, pp[1], hh); scan_apply_unit(args, ws, lds, pp[1], hh, tid, wave, lane, C8(cin4[1]), ab0_, ab1_, g0_, g1_, pp[2], hh);
                        scan_apply_unit(args, ws, lds, pp[2], hh, tid, wave, lane, C8(cin4[2]), ab0_, ab1_, g0_, g1_, pp[3], hh); scan_apply_unit(args, ws, lds, pp[3], hh, tid, wave, lane, C8(cin4[3]), ab0_, ab1_, g0_, g1_, -1, 0);
                    } else for (int u = bid; u < 64 * 16; u += G) { const int pp[1] = {u >> 4}; float cin1[1][8]; scan_carry<1>(CSp, PSp, pp, sd_, (u & 15) * 128 + scabs_, cin1);
                        v4u ab0_[4], ab1_[4], g0_, g1_; sa_prefetch_pair(ws, u >> 4, u & 15, 0, tid, wave, lane, ab0_, ab1_, g0_, g1_);
                        scan_apply_unit(args, ws, lds, u >> 4, u & 15, tid, wave, lane, C8(cin1[0]), ab0_, ab1_, g0_, g1_, -1, 0); } } }
#endif
            SEAM(17);
            if (IN(18)) { pg8::EpiResid E{nullptr, nullptr, X, modl + 5 * DM, MODW, 1.0f, SLAB};
                run_gemm<pg8::EpiResid, pg8::StaticOrderC<64, 8, 32>>(lds + RING_OFF, MIX, (const bf16*)(ws + WS_WRGOUT), NLAT, DM, DM, G, bid, E, slow); }
            SEAM(18);
    }
    FFN_BLOCK(64, 3, 19, 0, (void)0);
    if (IN(22)) RT_(REP_NORM) final_norm_phase(X, args.in[I_FNORM], args.out, gw, ngw, lane);
#if defined(PROBE_WAIT)
    if (bid == 0 && tid == 0) { __threadfence(); const unsigned long long tw = __hip_atomic_load((unsigned long long*)(ws + WS_CTL) + 4000, __ATOMIC_RELAXED, __HIP_MEMORY_SCOPE_AGENT);
        asm volatile("s_waitcnt vmcnt(0)" ::: "memory");
#if defined(PROBE_RATE)
        args.out[0] += (float)*((int*)(ws + WS_CTL + 8 * 4200)) * 1e-5f;
#elif defined(PROBE_WARM)
        { const bool w_ = warm_ == 0x600DF00Du; __hip_atomic_store((unsigned*)(ws + WS_ROPE + 262144), 0x600DF00Du, __ATOMIC_RELAXED, __HIP_MEMORY_SCOPE_AGENT);
          const unsigned long long p0_ = *((unsigned long long*)(ws + WS_CTL) + 4100), p1_ = (PROBE_PHASE >= 22) ? __builtin_amdgcn_s_memrealtime() : *((unsigned long long*)(ws + WS_CTL) + 4101); const float us_ = (float)(p1_ - p0_) * 0.01f;
          if (PROBE_WARM == 5 || PROBE_WARM == 6) { float* cs_ = (float*)(ws + WS_ROPE + 262144 + 64); const float c_ = (float)*((unsigned long long*)(ws + WS_CTL) + 4102) * 0.01f;
              if (!w_) *cs_ = c_; args.out[0] += ((PROBE_WARM == 5 ? *cs_ : c_) - (float)PROBE_BASE) * PROBE_SCALE; } else
          if (PROBE_WARM == 4) { float* cs_ = (float*)(ws + WS_ROPE + 262144 + 64); if (!w_) *cs_ = us_; args.out[0] += (*cs_ - (float)PROBE_BASE) * PROBE_SCALE; } else
          args.out[0] += PROBE_WARM == 1 ? (w_ ? 3.0f : 0.0f) : PROBE_WARM == 2 ? (w_ ? (us_ - (float)PROBE_BASE) * PROBE_SCALE : 0.0f) : (w_ ? 0.0f : (us_ - (float)PROBE_BASE) * PROBE_SCALE); }
#elif PROBE_PHASE < 1000
        { const unsigned long long p0_ = *((unsigned long long*)(ws + WS_CTL) + 4100), p1_ = (PROBE_PHASE >= 22) ? __builtin_amdgcn_s_memrealtime() : *((unsigned long long*)(ws + WS_CTL) + 4101); args.out[0] += ((float)(p1_ - p0_) * 0.01f - (float)PROBE_BASE) * PROBE_SCALE; }
#elif !defined(PROBE_XCD)
        args.out[0] += (float)tw * (0.01f / 256.0f) * 0.01f;
#else
        float mx = 0.f, mn = 1e30f;
        for (int x = 0; x < 8; ++x) { const unsigned long long s = __hip_atomic_load((unsigned long long*)(ws + WS_CTL) + 4010 + 2 * x, __ATOMIC_RELAXED, __HIP_MEMORY_SCOPE_AGENT), n = __hip_atomic_load((unsigned long long*)(ws + WS_CTL) + 4011 + 2 * x, __ATOMIC_RELAXED, __HIP_MEMORY_SCOPE_AGENT);
            if (n) { const float av = (float)s / (float)n * 0.01f; mx = fmaxf(mx, av); mn = fminf(mn, av); } }
        int imn = 0; { float best = 1e30f; for (int x = 0; x < 8; ++x) { const unsigned long long s = __hip_atomic_load((unsigned long long*)(ws + WS_CTL) + 4010 + 2 * x, __ATOMIC_RELAXED, __HIP_MEMORY_SCOPE_AGENT), n = __hip_atomic_load((unsigned long long*)(ws + WS_CTL) + 4011 + 2 * x, __ATOMIC_RELAXED, __HIP_MEMORY_SCOPE_AGENT); if (n && (float)s / (float)n < best) { best = (float)s / (float)n; imn = x; } } }
        args.out[0] += (PROBE_XCD == 1 ? mx * 0.01f : (PROBE_XCD == 2 ? mn * 0.01f : (float)(imn + 1)));
#endif
        }
#endif
#undef IN
#undef SEAM
}

extern "C" void kernel_launch(void* const* d_in, const int* in_sizes, int n_in, void* d_out, int out_size, void* d_ws, size_t ws_size, hipStream_t stream) {
    static int grid = 0;
    if (grid == 0) {
        if (n_in != N_IN || in_sizes[0] != NLAT * DM || out_size != NLAT * DM || ws_size < WS_END) { fprintf(stderr, "kernel_launch: unexpected shapes (n_in %d, ws %zu)\n", n_in, ws_size); grid = -1; return; }
        int dev = 0, cus = 0, per_cu = 0;
        if (hipGetDevice(&dev) != hipSuccess || hipDeviceGetAttribute(&cus, hipDeviceAttributeMultiprocessorCount, dev) != hipSuccess) { grid = -1; return; }
        if (hipFuncSetAttribute((const void*)fwd_kernel, hipFuncAttributeMaxDynamicSharedMemorySize, LDS_BYTES) != hipSuccess) { fprintf(stderr, "kernel_launch: hipFuncSetAttribute failed\n"); grid = -1; return; }
        if (hipOccupancyMaxActiveBlocksPerMultiprocessor(&per_cu, (const void*)fwd_kernel, NTHR, LDS_BYTES) != hipSuccess || per_cu < 1) fprintf(stderr, "kernel_launch: occupancy query reports %d\n", per_cu);
        (void)hipGetLastError();
        grid = cus;
    }
    if (grid < 0) return;
    if (hipMemsetAsync((char*)d_ws + WS_CTL, 0, CTL_ZERO_BYTES, stream) != hipSuccess) return;
#if defined(PROBE_RATE)
    { int dev_ = 0, khz_ = 0; (void)hipGetDevice(&dev_); (void)hipDeviceGetAttribute(&khz_, hipDeviceAttributeWallClockRate, dev_);
      (void)hipMemsetD32Async((hipDeviceptr_t)((char*)d_ws + WS_CTL + 8 * 4200), khz_, 1, stream); }
#endif
    Args a{};
    for (int i = 0; i < N_IN; ++i) a.in[i] = (const float*)d_in[i];
    a.out = (float*)d_out; a.ws = (unsigned char*)d_ws;
#if MK_ONE_LAUNCH
    a.ph_lo = 0; a.ph_hi = N_PHASES;
    hipLaunchKernelGGL(fwd_kernel, dim3(grid), dim3(NTHR), LDS_BYTES, stream, a);
#else
    for (int p = 0; p < N_PHASES; ++p) { a.ph_lo = p; a.ph_hi = p + 1; hipLaunchKernelGGL(fwd_kernel, dim3(grid), dim3(NTHR), LDS_BYTES, stream, a); }
#endif
}
```

```cpp
#include <hip/hip_runtime.h>
#include <cstdio>
#include <cstdint>
#ifndef PG8_WGM
#define PG8_WGM 8
#endif
namespace pg8 {
#define PG8_LAS __attribute__((address_space(3)))
typedef unsigned short bf16_t;
typedef short bf16x8 __attribute__((ext_vector_type(8)));
typedef float f32x4 __attribute__((ext_vector_type(4)));
typedef unsigned u32x4 __attribute__((ext_vector_type(4)));
constexpr int BM = 256, BK = 64, HALF = 128, HTB = HALF * BK * 2  , STAGE_BYTES = 8 * HTB, NXCD = 8, WGM = PG8_WGM;

__host__ __device__ __forceinline__ int lds_byte(int r, int c) { const int st = (r >> 4) * 2 + (c >> 5), rr = r & 15, cc = c & 31, ob = rr * 64 + cc * 2; return st * 1024 + (ob ^ (((ob >> 9) & 1) << 5)); }
__host__ __device__ __forceinline__ void stage_rc(int b, int& R, int& C) { const int st = b / 1024, sb = b % 1024, swz = sb ^ (((sb >> 9) & 1) << 5); R = (st >> 1) * 16 + swz / 64; C = (st & 1) * 32 + (swz % 64) / 2; }
__host__ __device__ __forceinline__ int perm32(int rho) { const int n = rho >> 4, i = rho & 15; return 8 * (i >> 2) + 4 * n + (i & 3); }

struct Unit { int pm, pn, kt0, nt, ks; };
struct Gemm { const bf16_t* A; const bf16_t* Bt; int ld; size_t kstepA, kstepB; int thr; };

__host__ __device__ __forceinline__ int xrank(int c, int slow) { return slow < 0 ? c : (((c & 7) == slow) ? 0x3fffffff : c - ((c + 7 - slow) >> 3)); }
template <int NM_, int NN_, int KT, int WGM_ = WGM> struct StaticOrderC {
    static constexpr int nM = NM_, nN = NN_, nwg = NM_ * NN_;
    int G, c, slow;
    __host__ __device__ __forceinline__ void init(int G_, int c_, int slow_ = -1) { G = G_; c = c_; slow = (G_ == 256) ? slow_ : -1; }
    static __host__ __device__ __forceinline__ void map(int L, int& pm, int& pn) {
        int wgid = L; { constexpr int q = nwg / NXCD, r = nwg % NXCD; const int xcd = wgid % NXCD, off = wgid / NXCD; wgid = (xcd < r ? xcd * (q + 1) : r * (q + 1) + (xcd - r) * q) + off; }
        constexpr int WGMv = WGM_; constexpr int nig = WGMv * nN; const int gid = wgid / nig, fm = gid * WGMv, gsz = (nM - fm) < WGMv ? (nM - fm) : WGMv;
        const int w = wgid - gid * nig;
        if (gsz == WGMv) { pm = fm + (w % WGMv); pn = w / WGMv; } else { pm = fm + (w % gsz); pn = w / gsz; }
    }
    __host__ __device__ __forceinline__ bool next(int i, Unit& u) const {
        const int full = nwg / G;
        int L = i * G + c;
        if (i >= full) { if (i > full) return false; const int rk = xrank(c, slow); if (rk >= nwg - full * G) return false; L = full * G + rk; }
        int pm, pn; map(L, pm, pn);
        u.pm = pm; u.pn = pn; u.kt0 = 0; u.nt = KT; u.ks = -1;
        return true;
    }
    __device__ __forceinline__ void a_ready(const Unit&) const {}
    __device__ __forceinline__ void done(const Unit&) const {}
};

template <int NN_, int KT> struct SplitCtxOrder {
    static constexpr int NPIECE = (KT == 88) ? 11 : 8, NLATU = 64 * NN_, NSUB = 2 * NN_ * NPIECE;
    int G, c, slow;
    __host__ __device__ __forceinline__ void init(int G_, int c_, int slow_ = -1) { G = G_; c = c_; slow = (G_ == 256) ? slow_ : -1; }
    static __host__ __device__ __forceinline__ void piece(int p, int& kt0, int& nt) {
        if (KT == 88) { nt = 8; kt0 = 8 * p; } else { nt = 4; kt0 = 4 * p; }
    }
    __host__ __device__ __forceinline__ bool next(int i, Unit& u) const {
        int pm, pn, kt0 = 0, nt = KT, ks = -1;
        const int rk = xrank(c, slow); const bool has_piece = rk < NSUB;
        if (has_piece && i == 0) { const int un = rk % (2 * NN_); ks = rk / (2 * NN_); pm = 64 + (un & 1); pn = un >> 1; piece(ks, kt0, nt); }
        else { const int L = (has_piece ? i - 1 : i) * G + c; if (L >= NLATU) return false; StaticOrderC<64, NN_, KT, (KT == 88 ? 4 : WGM)>::map(L, pm, pn); }
        u.pm = pm; u.pn = pn; u.kt0 = kt0; u.nt = nt; u.ks = ks;
        return true;
    }
    __device__ __forceinline__ void a_ready(const Unit&) const {}
    __device__ __forceinline__ void done(const Unit&) const {}
};

__device__ __forceinline__ unsigned cvt_pk_bf16(float lo, float hi) { unsigned r; asm volatile("v_cvt_pk_bf16_f32 %0, %1, %2" : "=v"(r) : "v"(lo), "v"(hi)); return r; }
constexpr int ROWS_LAT = 16384, D_MODEL = 2048;

struct EpiBf16 {
    static constexpr bool PERM = true, AFTER_DRAIN = false;
    bf16_t* O; int ldc;
    __device__ __forceinline__ void operator()(const f32x4 (&acc)[2][2][4][2], const Unit& u, int wr, int wc, int fr, int fq) const {
        const int row0 = u.pm * BM + wr * 64 + fr; const int col0 = u.pn * BM + wc * 32 + 8 * fq;
#pragma unroll
        for (int ai = 0; ai < 2; ++ai)
#pragma unroll
            for (int m = 0; m < 4; ++m) { bf16_t* rowp = O + (size_t)(row0 + ai * HALF + m * 16) * ldc + col0;
#pragma unroll
                for (int bj = 0; bj < 2; ++bj) { const f32x4 v0 = acc[ai][bj][m][0], v1 = acc[ai][bj][m][1];
                    u32x4 w; w.x = cvt_pk_bf16(v0[0], v0[1]); w.y = cvt_pk_bf16(v0[2], v0[3]); w.z = cvt_pk_bf16(v1[0], v1[1]); w.w = cvt_pk_bf16(v1[2], v1[3]);
                    *(u32x4*)(rowp + bj * HALF) = w; } }
    }
};
__device__ __forceinline__ float silu_f(float g) { return g * __builtin_amdgcn_rcpf(1.0f + __expf(-g)); }
struct EpiSwiGLU {
    static constexpr bool PERM = true, AFTER_DRAIN = false;
    bf16_t* H; int mrows;
    __device__ __forceinline__ void operator()(const f32x4 (&acc)[2][2][4][2], const Unit& u, int wr, int wc, int fr, int fq) const {
        const int row0 = u.pm * BM + wr * 64 + fr; const int col0 = u.pn * HALF + wc * 32 + 8 * fq;
#pragma unroll
        for (int ai = 0; ai < 2; ++ai)
#pragma unroll
            for (int m = 0; m < 4; ++m) { const int rr = row0 + ai * HALF + m * 16;
                bf16_t* rowp = (bf16_t*)((char*)H + ((size_t)(col0 >> 6) * (mrows >> 7) + (rr >> 7)) * HTB + lds_byte(rr & 127, col0 & 63));
                const f32x4 g0 = acc[ai][0][m][0], g1 = acc[ai][0][m][1], u0 = acc[ai][1][m][0], u1 = acc[ai][1][m][1];
                u32x4 w;
                w.x = cvt_pk_bf16(silu_f(g0[0]) * u0[0], silu_f(g0[1]) * u0[1]); w.y = cvt_pk_bf16(silu_f(g0[2]) * u0[2], silu_f(g0[3]) * u0[3]);
                w.z = cvt_pk_bf16(silu_f(g1[0]) * u1[0], silu_f(g1[1]) * u1[1]); w.w = cvt_pk_bf16(silu_f(g1[2]) * u1[2], silu_f(g1[3]) * u1[3]);
                *(u32x4*)rowp = w; }
    }
};
struct EpiResid {
    static constexpr bool PERM = true, AFTER_DRAIN = false;
    const float* resLatF; const float* resCtxF; bf16_t* X; const float* gate; int gstride; float gscale; float* slab;
    __device__ __forceinline__ void operator()(const f32x4 (&acc)[2][2][4][2], const Unit& u, int wr, int wc, int fr, int fq) const {
        const int v = u.pm < 32 ? 0 : (u.pm < 64 ? 1 : 2);
        const float* gv = gate + (size_t)v * gstride;
        const int col0 = u.pn * BM + wc * 32 + 8 * fq;
        f32x4 gvec[2][2];
#pragma unroll
        for (int bj = 0; bj < 2; ++bj)
#pragma unroll
            for (int n = 0; n < 2; ++n) gvec[bj][n] = *(const f32x4*)(gv + col0 + bj * HALF + n * 4) * gscale;
#pragma unroll
        for (int ai = 0; ai < 2; ++ai)
#pragma unroll
            for (int m = 0; m < 4; ++m) { const int row = u.pm * BM + ai * HALF + wr * 64 + m * 16 + fr;
                bf16_t* xp = X + (size_t)row * D_MODEL;
                if (u.ks >= 0) {
                    bf16_t* sp = (bf16_t*)slab + ((size_t)u.ks * 512 + (row - ROWS_LAT)) * D_MODEL;
#pragma unroll
                    for (int bj = 0; bj < 2; ++bj) { const int c = col0 + bj * HALF; const f32x4 o0 = gvec[bj][0] * acc[ai][bj][m][0], o1 = gvec[bj][1] * acc[ai][bj][m][1];
                        u32x4 w; w.x = cvt_pk_bf16(o0[0], o0[1]); w.y = cvt_pk_bf16(o0[2], o0[3]); w.z = cvt_pk_bf16(o1[0], o1[1]); w.w = cvt_pk_bf16(o1[2], o1[3]);
                        *(u32x4*)(sp + c) = w; }
                } else {
#pragma unroll
                    for (int bj = 0; bj < 2; ++bj) { const int c = col0 + bj * HALF; f32x4 r0, r1;
                        if (resLatF) { const float* rp = ((row < ROWS_LAT) ? resLatF + (size_t)row * D_MODEL : resCtxF + (size_t)(row - ROWS_LAT) * D_MODEL) + c;
                            r0 = *(const f32x4*)rp; r1 = *(const f32x4*)(rp + 4); }
                        else { const u32x4 rw = *(const u32x4*)(xp + c);
                            r0 = (f32x4){__builtin_bit_cast(float, rw.x << 16), __builtin_bit_cast(float, rw.x & 0xffff0000u), __builtin_bit_cast(float, rw.y << 16), __builtin_bit_cast(float, rw.y & 0xffff0000u)};
                            r1 = (f32x4){__builtin_bit_cast(float, rw.z << 16), __builtin_bit_cast(float, rw.z & 0xffff0000u), __builtin_bit_cast(float, rw.w << 16), __builtin_bit_cast(float, rw.w & 0xffff0000u)}; }
                        const f32x4 o0 = r0 + gvec[bj][0] * acc[ai][bj][m][0], o1 = r1 + gvec[bj][1] * acc[ai][bj][m][1];
                        u32x4 w; w.x = cvt_pk_bf16(o0[0], o0[1]); w.y = cvt_pk_bf16(o0[2], o0[3]); w.z = cvt_pk_bf16(o1[0], o1[1]); w.w = cvt_pk_bf16(o1[2], o1[3]);
                        *(u32x4*)(xp + c) = w; }
                }
                if (m & 1) asm volatile("" ::: "memory"); }
    }
};

struct EpiNull {
    static constexpr bool PERM = true, AFTER_DRAIN = false;
    __device__ __forceinline__ void operator()(const f32x4 (&acc)[2][2][4][2], const Unit& u, int wr, int wc, int fr, int fq) const {
#pragma unroll
        for (int ai = 0; ai < 2; ++ai)
#pragma unroll
            for (int bj = 0; bj < 2; ++bj)
#pragma unroll
                for (int m = 0; m < 4; ++m)
#pragma unroll
                    for (int n = 0; n < 2; ++n) asm volatile("" :: "v"(acc[ai][bj][m][n]));
    }
};
template <class Epi, class Sched, bool ALIGN_EPI = false, bool SP2 = false>
__device__ __forceinline__ void gemm_phase(PG8_LAS unsigned char* lds, const Gemm g, const Sched& S, const Epi& E) {
    const int tid = threadIdx.x, wid = __builtin_amdgcn_readfirstlane(tid >> 6), lane = tid & 63, wr = wid >> 2, wc = wid & 3, fr = lane & 15, fq = lane >> 4;
    unsigned voffA[2], voffB[2];
#pragma unroll
    for (int i = 0; i < 2; ++i) { int R, C; stage_rc(tid * 16 + i * 8192, R, C); const int Rb = Epi::PERM ? ((R & ~31) + perm32(R & 31)) : R;
        voffA[i] = g.ld ? (unsigned)(R * g.ld + C) * 2u : (unsigned)(tid * 16 + i * 8192); voffB[i] = g.ld ? (unsigned)(Rb * g.ld + C) * 2u : (unsigned)(tid * 16 + i * 8192); }
    const size_t kstepA = g.kstepA, kstepB = g.kstepB;
    const size_t hstep = g.ld ? (size_t)HALF * g.ld * 2 : (size_t)HTB;
    const size_t tstep = 2 * hstep;
    const unsigned ldsw = (unsigned)wid * 1024u;
    const int aoff = lds_byte(wr * 64 + fr, fq * 8), boff = lds_byte(wc * 32 + fr, fq * 8);
#define PG8_SA(b, h) (((b) * 2 + (h)) * HTB)
#define PG8_SB(b, h) ((4 + (b) * 2 + (h)) * HTB)
#define PG8_STAGE(bufoff, gbase, voff) do { _Pragma("unroll") for (int _i = 0; _i < 2; ++_i) \
        __builtin_amdgcn_global_load_lds((const unsigned*)((const char*)(gbase) + (voff)[_i]), (PG8_LAS unsigned*)(lds + (bufoff) + ldsw + _i * 8192), 16, 0, 0); } while (0)
#define PG8_LDA(dst, b, h) do { _Pragma("unroll") for (int m = 0; m < 4; ++m) _Pragma("unroll") for (int k = 0; k < 2; ++k) dst[m][k] = *(const PG8_LAS bf16x8*)(lds + PG8_SA(b, h) + aoff + m * 2048 + k * 1024); } while (0)
#define PG8_LDB(dst, b, h) do { _Pragma("unroll") for (int n = 0; n < 2; ++n) _Pragma("unroll") for (int k = 0; k < 2; ++k) dst[n][k] = *(const PG8_LAS bf16x8*)(lds + PG8_SB(b, h) + boff + n * 2048 + k * 1024); } while (0)
#define PG8_MMA(ai, bj, At, Bt) do { __builtin_amdgcn_s_setprio(1); _Pragma("unroll") for (int m = 0; m < 4; ++m) _Pragma("unroll") for (int n = 0; n < 2; ++n) _Pragma("unroll") for (int k = 0; k < 2; ++k) \
        acc[ai][bj][m][n] = __builtin_amdgcn_mfma_f32_16x16x32_bf16(Bt[n][k], At[m][k], acc[ai][bj][m][n], 0, 0, 0); __builtin_amdgcn_s_setprio(0); } while (0)
#define PG8_WAIT_V(n) asm volatile("s_waitcnt vmcnt(" #n ")" ::: "memory")
#define PG8_WAIT_L(n) asm volatile("s_waitcnt lgkmcnt(" #n ")" ::: "memory")
#define PG8_BAR __builtin_amdgcn_s_barrier()
#define PG8_SCHED __builtin_amdgcn_sched_barrier(0)
    Unit cur, nxt; int ui = 0;
    if (!S.next(0, cur)) return;
    f32x4 acc[2][2][4][2];
#pragma unroll
    for (int a = 0; a < 2; ++a)
#pragma unroll
        for (int b = 0; b < 2; ++b)
#pragma unroll
            for (int m = 0; m < 4; ++m)
#pragma unroll
                for (int n = 0; n < 2; ++n) acc[a][b][m][n] = (f32x4){0.f, 0.f, 0.f, 0.f};
    bf16x8 At[4][2], B0[2][2], B1[2][2];
    const char* cA = (const char*)g.A + (size_t)cur.pm * tstep + (size_t)cur.kt0 * kstepA; const char* cB = (const char*)g.Bt + (size_t)cur.pn * tstep + (size_t)cur.kt0 * kstepB;
    S.a_ready(cur);
    if constexpr (SP2) {
        PG8_STAGE(PG8_SB(0, 0), cB, voffB); PG8_STAGE(PG8_SB(0, 1), cB + hstep, voffB); PG8_STAGE(PG8_SA(0, 0), cA, voffA); PG8_STAGE(PG8_SA(0, 1), cA + hstep, voffA);
        if (wr == 1) PG8_BAR;
        PG8_WAIT_V(2); PG8_BAR;
        PG8_STAGE(PG8_SB(1, 0), cB + kstepB, voffB); PG8_STAGE(PG8_SA(1, 0), cA + kstepA, voffA); PG8_STAGE(PG8_SB(1, 1), cB + hstep + kstepB, voffB);
        PG8_WAIT_V(6); PG8_BAR;
    } else {
        PG8_STAGE(PG8_SB(0, 0), cB, voffB); PG8_STAGE(PG8_SA(0, 0), cA, voffA); PG8_STAGE(PG8_SB(0, 1), cB + hstep, voffB); PG8_STAGE(PG8_SA(0, 1), cA + hstep, voffA);
        if (wr == 1) PG8_BAR;
        PG8_WAIT_V(4); PG8_BAR;
        PG8_STAGE(PG8_SB(1, 0), cB + kstepB, voffB); PG8_STAGE(PG8_SA(1, 0), cA + kstepA, voffA); PG8_STAGE(PG8_SB(1, 1), cB + hstep + kstepB, voffB);
        PG8_WAIT_V(6); PG8_BAR;
    }
    for (;;) {
        const bool has_next = S.next(ui + 1, nxt);
        const char* nA = has_next ? (const char*)g.A + (size_t)nxt.pm * tstep + (size_t)nxt.kt0 * kstepA : cA; const char* nB = has_next ? (const char*)g.Bt + (size_t)nxt.pn * tstep + (size_t)nxt.kt0 * kstepB : cB;
        const int nt = cur.nt;
        for (int t = 0; t < nt; t += 2) {
            const bool last = (t == nt - 2);
#if defined(EXP_THR)
            if (g.thr > 0) __builtin_amdgcn_s_sleep(EXP_THR);
#endif
            const char* a1 = cA + (size_t)(t + 1) * kstepA;
            const char* a2 = last ? nA : cA + (size_t)(t + 2) * kstepA; const char* b2 = last ? nB : cB + (size_t)(t + 2) * kstepB;
            const char* a3 = a2 + kstepA; const char* b3 = b2 + kstepB;
            if (last && has_next) S.a_ready(nxt);
            if constexpr (SP2) {
            PG8_LDB(B0, 0, 0); PG8_LDB(B1, 0, 1); PG8_SCHED; PG8_LDA(At, 0, 0); PG8_STAGE(PG8_SA(1, 1), a1 + hstep, voffA);
            PG8_WAIT_V(8); PG8_WAIT_L(0); PG8_BAR; PG8_MMA(0, 0, At, B0); PG8_MMA(0, 1, At, B1); PG8_BAR; PG8_SCHED;
            PG8_LDA(At, 0, 1); PG8_STAGE(PG8_SB(0, 0), b2, voffB); PG8_STAGE(PG8_SB(0, 1), b2 + hstep, voffB); PG8_STAGE(PG8_SA(0, 0), a2, voffA);
            PG8_WAIT_V(8); PG8_WAIT_L(0); PG8_BAR; PG8_MMA(1, 0, At, B0); PG8_MMA(1, 1, At, B1); PG8_BAR; PG8_SCHED;
            PG8_LDB(B0, 1, 0); PG8_LDB(B1, 1, 1); PG8_SCHED; PG8_LDA(At, 1, 0); PG8_STAGE(PG8_SA(0, 1), a2 + hstep, voffA);
            PG8_WAIT_V(8); PG8_WAIT_L(0); PG8_BAR; PG8_MMA(0, 0, At, B0); PG8_MMA(0, 1, At, B1); PG8_BAR; PG8_SCHED;
            PG8_LDA(At, 1, 1); PG8_STAGE(PG8_SB(1, 0), b3, voffB); PG8_STAGE(PG8_SB(1, 1), b3 + hstep, voffB); PG8_STAGE(PG8_SA(1, 0), a3, voffA);
            PG8_WAIT_V(8); PG8_WAIT_L(0); PG8_BAR; PG8_MMA(1, 0, At, B0); PG8_MMA(1, 1, At, B1); PG8_BAR; PG8_SCHED;
            } else {
            PG8_LDB(B0, 0, 0); PG8_SCHED; PG8_LDA(At, 0, 0); PG8_STAGE(PG8_SA(1, 1), a1 + hstep, voffA);
            PG8_WAIT_L(8); PG8_BAR; PG8_WAIT_L(0); PG8_MMA(0, 0, At, B0); PG8_BAR; PG8_SCHED;
            PG8_LDB(B1, 0, 1); PG8_STAGE(PG8_SB(0, 0), b2, voffB);
            PG8_BAR; PG8_WAIT_L(0); PG8_MMA(0, 1, At, B1); PG8_BAR;
            PG8_LDA(At, 0, 1); PG8_STAGE(PG8_SA(0, 0), a2, voffA);
            PG8_BAR; PG8_WAIT_L(0); PG8_MMA(1, 0, At, B0); PG8_BAR; PG8_SCHED;
            PG8_STAGE(PG8_SB(0, 1), b2 + hstep, voffB);
            PG8_WAIT_V(6); PG8_BAR; PG8_MMA(1, 1, At, B1); PG8_BAR;
            PG8_LDB(B0, 1, 0); PG8_SCHED; PG8_LDA(At, 1, 0); PG8_STAGE(PG8_SA(0, 1), a2 + hstep, voffA);
            PG8_WAIT_L(8); PG8_BAR; PG8_WAIT_L(0); PG8_MMA(0, 0, At, B0); PG8_BAR; PG8_SCHED;
            PG8_LDB(B1, 1, 1); PG8_STAGE(PG8_SB(1, 0), b3, voffB);
            PG8_BAR; PG8_WAIT_L(0); PG8_MMA(0, 1, At, B1); PG8_BAR;
            PG8_LDA(At, 1, 1); PG8_STAGE(PG8_SA(1, 0), a3, voffA);
            PG8_BAR; PG8_WAIT_L(0); PG8_MMA(1, 0, At, B0); PG8_BAR; PG8_SCHED;
            PG8_STAGE(PG8_SB(1, 1), b3 + hstep, voffB);
            PG8_WAIT_V(6); PG8_BAR; PG8_MMA(1, 1, At, B1); PG8_BAR;
            }
        }
        if constexpr (ALIGN_EPI) { if (wr == 0) PG8_BAR; }
        if constexpr (!Epi::AFTER_DRAIN) { E(acc, cur, wr, wc, fr, fq);
#if defined(REP_EPI)
            if constexpr (Epi::PERM) { asm volatile("" ::: "memory"); E(acc, cur, wr, wc, fr, fq); }
#endif
            S.done(cur); }
        if (!has_next) break;
#pragma unroll
        for (int a = 0; a < 2; ++a)
#pragma unroll
            for (int b = 0; b < 2; ++b)
#pragma unroll
                for (int m = 0; m < 4; ++m)
#pragma unroll
                    for (int n = 0; n < 2; ++n) acc[a][b][m][n] = (f32x4){0.f, 0.f, 0.f, 0.f};
        cur = nxt; cA = nA; cB = nB; ++ui;
        if constexpr (ALIGN_EPI) { if (wr == 1) PG8_BAR; }
    }
    PG8_WAIT_V(0);
    if constexpr (!ALIGN_EPI) { if (wr == 0) PG8_BAR; }
    PG8_BAR;
    if constexpr (Epi::AFTER_DRAIN) { E.fused(acc, cur, wr, wc, fr, fq, lds, wid, lane); S.done(cur); }
#undef PG8_SA
#undef PG8_SB
#undef PG8_STAGE
#undef PG8_LDA
#undef PG8_LDB
#undef PG8_MMA
#undef PG8_WAIT_V
#undef PG8_WAIT_L
#undef PG8_BAR
#undef PG8_SCHED
}
}
#define GAS __attribute__((address_space(1)))
#define LAS __attribute__((address_space(3)))
typedef unsigned short bf16;
typedef unsigned v4u __attribute__((ext_vector_type(4)));
typedef float f32x4 __attribute__((ext_vector_type(4)));
typedef short bf16x8 __attribute__((ext_vector_type(8)));
typedef GAS unsigned gu32;
typedef GAS unsigned long long gu64;
#define RLX_AGENT __ATOMIC_RELAXED, __HIP_MEMORY_SCOPE_AGENT
#define LDS_WAIT() asm volatile("s_waitcnt lgkmcnt(0)" ::: "memory")
#define VM_WAIT() asm volatile("s_waitcnt vmcnt(0)" ::: "memory")
__device__ __forceinline__ unsigned long long rt() { return __builtin_amdgcn_s_memrealtime(); }
__device__ __forceinline__ unsigned f2bf(float f) { unsigned u = __builtin_bit_cast(unsigned, f); return (u + 0x7fffu + ((u >> 16) & 1u)) >> 16; }
__device__ __forceinline__ unsigned pk2(float lo, float hi) { return f2bf(lo) | (f2bf(hi) << 16); }

#define XB_TMO      128
#define XB_XCNT(j)  (256  + 64 * (j))
#define XB_XSUB(j)  (1280 + 64 * (j))
#define XB_XGEN(j)  (2304 + 64 * (j))
#define XB_TOP      3328
#define XB_TOPGEN   3392
#define XCD_BAR_WORDS 3456
#define XB_SPIN_CAP (1u << 18)

__device__ __forceinline__ unsigned xb_ld(unsigned* p)              { return __hip_atomic_load(p, __ATOMIC_RELAXED, __HIP_MEMORY_SCOPE_AGENT); }
__device__ __forceinline__ unsigned xb_add(unsigned* p, unsigned v) { return __hip_atomic_fetch_add(p, v, __ATOMIC_RELAXED, __HIP_MEMORY_SCOPE_AGENT); }
__device__ __forceinline__ unsigned xb_xcc_id() { return (unsigned)__builtin_amdgcn_s_getreg((3 << 11) | 20) & 0xFu; }
#define XB_SPIN(cond, bar) do { unsigned _sp = 0; while (cond) { __builtin_amdgcn_s_sleep(1); \
    if ((++_sp & 255u) == 0u) { if (xb_ld(&(bar)[XB_TMO])) break; if (_sp > XB_SPIN_CAP) { atomicAdd(&(bar)[XB_TMO], 1u); break; } } } } while (0)

struct XcdBarrier {
    unsigned* bar; unsigned x;
    volatile LAS unsigned* st;
};

__device__ __forceinline__ XcdBarrier xcd_barrier_post(unsigned* bar, volatile LAS unsigned* st) {
    XcdBarrier b; b.bar = bar; b.x = xb_xcc_id(); b.st = st;
    if (threadIdx.x == 0) (void)xb_add(&bar[XB_XCNT(b.x)], 1u);
    return b;
}
__device__ __forceinline__ void xcd_barrier_complete(unsigned* bar, unsigned x, unsigned& nloc, unsigned& nx) {
    const unsigned G = gridDim.x * gridDim.y * gridDim.z;
    unsigned sum, cnt, mine, sp = 0u;
    for (;;) {
        sum = 0u; cnt = 0u; mine = 0u;
#pragma unroll
        for (unsigned j = 0; j < 16; ++j) { const unsigned c = xb_ld(&bar[XB_XCNT(j)]); sum += c; cnt += (c > 0u) ? 1u : 0u; mine = (j == x) ? c : mine; }
        if (sum == G) break;
        __builtin_amdgcn_s_sleep(1);
        if ((++sp & 255u) == 0u) { if (xb_ld(&bar[XB_TMO])) break; if (sp > XB_SPIN_CAP) { atomicAdd(&bar[XB_TMO], 1u); break; } }
    }
    nloc = mine > 0u ? mine : 1u; nx = cnt > 0u ? cnt : 1u;
}

__device__ __forceinline__ void xcd_barrier(const XcdBarrier& b) {
    asm volatile("s_waitcnt vmcnt(0)" ::: "memory");
    __syncthreads();
    if (threadIdx.x == 0) {
        unsigned* bar = b.bar;
        __builtin_amdgcn_s_waitcnt(0);
        unsigned nloc = b.st[0], nx = b.st[1];
        if (nloc == 0u) { xcd_barrier_complete(bar, b.x, nloc, nx); b.st[0] = nloc; b.st[1] = nx; }
        const unsigned old = xb_add(&bar[XB_XSUB(b.x)], 1u);
        const unsigned gen = old / nloc;
        if (old + 1u == (gen + 1u) * nloc) {
            __builtin_amdgcn_fence(__ATOMIC_RELEASE, "agent");
            asm volatile("s_waitcnt vmcnt(0)" ::: "memory");
            const unsigned og = xb_add(&bar[XB_TOP], 1u);
            const unsigned tg = og / nx;
            if (og + 1u == (tg + 1u) * nx) xb_add(&bar[XB_TOPGEN], 1u);
            else XB_SPIN(xb_ld(&bar[XB_TOPGEN]) == tg, bar);
            __builtin_amdgcn_fence(__ATOMIC_ACQUIRE, "agent");
            xb_add(&bar[XB_XGEN(b.x)], 1u);
            asm volatile("s_waitcnt vmcnt(0)" ::: "memory");
        } else {
            XB_SPIN(xb_ld(&bar[XB_XGEN(b.x)]) == gen, bar);
            __builtin_amdgcn_fence(__ATOMIC_ACQUIRE, "agent");
            asm volatile("s_waitcnt vmcnt(0)" ::: "memory");
        }
    }
    __syncthreads();
}

constexpr int NWAVES = 8, NTHR = 512;
constexpr int DM = 2048, DFF = 5632, SEQ = 8192, CTXL = 256, NB = 2;
constexpr int NLAT = NB * SEQ, NCTXR = NB * CTXL, MROWS = NLAT + NCTXR;
constexpr int NMOD = 9, MODW = NMOD * DM;
constexpr int ABW = 4608, RGW = 4096, HD = 128;
constexpr float EPS = 1e-6f;
enum { I_X = 0, I_C, I_CTX, I_CCTX, I_WMOD, I_BMOD, I_NF1, I_NMIX, I_NF2, I_F1IN, I_F1OUT, I_F2IN, I_F2OUT, I_ABIN, I_ABOUT, I_SINK, I_ABCONV,
       I_RGIN, I_RGCONVW, I_RGCONVB, I_RGWA, I_RGBA, I_RGWX, I_RGBX, I_RGLAM, I_RGOUT, I_FNORM, N_IN };

constexpr size_t MiB = 1u << 20;
constexpr size_t WS_CTL = 0, CTL_ZERO_BYTES = 1 * MiB;
constexpr size_t WS_MOD = 1 * MiB;
constexpr size_t WS_ROPE = 1 * MiB + 512 * 1024;
constexpr size_t WS_WIN = 2 * MiB, WIN_BYTES = 44 * MiB;
constexpr size_t WS_WOUT = WS_WIN + 4 * WIN_BYTES, WOUT_BYTES = 22 * MiB;
constexpr size_t WS_WABIN = WS_WOUT + 4 * WOUT_BYTES;
constexpr size_t WS_WABOUT = WS_WABIN + 18 * MiB;
constexpr size_t WS_WRGIN = WS_WABOUT + 8 * MiB;
constexpr size_t WS_WRGOUT = WS_WRGIN + 16 * MiB;
constexpr size_t WS_WGATE = WS_WRGOUT + 8 * MiB;
constexpr size_t WS_X = WS_WGATE + 2 * MiB;
constexpr size_t WS_XN = WS_X + 132 * MiB;
constexpr size_t WS_H = WS_XN + 66 * MiB;
constexpr size_t WS_MIX = WS_H + 182 * MiB;
constexpr size_t WS_CS = WS_MIX + 66 * MiB;
constexpr size_t WS_PS = WS_CS + 17 * MiB;
constexpr size_t WS_SLAB = WS_PS + 3 * MiB;
constexpr size_t WS_ABH = WS_SLAB + 44 * MiB;
constexpr size_t WS_END = WS_ABH + 256 * MiB;
static_assert(WS_END <= 1140 * MiB, "d_ws map");
constexpr int CW_BAR = 4096;

constexpr int RING_OFF = 0, RING_BYTES = 131072;
constexpr int LDSCTL_OFF = RING_BYTES, MISC_OFF = LDSCTL_OFF + 320;
constexpr int LDS_BYTES = 147456;
struct Args { const float* in[27]; float* out; unsigned char* ws; int ph_lo, ph_hi; };

typedef float f32x2 __attribute__((ext_vector_type(2)));
typedef unsigned u32x2 __attribute__((ext_vector_type(2)));
typedef unsigned u32x4 __attribute__((ext_vector_type(4)));
__device__ __forceinline__ float wave_sum(float v) {
#pragma unroll
    for (int o = 1; o < 64; o <<= 1) v += __shfl_xor(v, o);
    return v;
}
__device__ __forceinline__ float bf_lo(unsigned w) { return __builtin_bit_cast(float, w << 16); }
__device__ __forceinline__ float bf_hi(unsigned w) { return __builtin_bit_cast(float, w & 0xffff0000u); }
__device__ __forceinline__ unsigned cvtpk(float lo, float hi) { unsigned r; asm volatile("v_cvt_pk_bf16_f32 %0, %1, %2" : "=v"(r) : "v"(lo), "v"(hi)); return r; }

#ifndef XN_IMG
#define XN_IMG 1
#endif
__device__ __forceinline__ int perm32_inv(int x) { return 16 * ((x >> 2) & 1) + 4 * (x >> 3) + (x & 3); }
__device__ __forceinline__ void conv_tile(const float* __restrict__ W, int N, bf16* __restrict__ Wt, int K, int k0, int n0, int drow0, LAS unsigned* scr, int lane, int tiled_rows = 0, bool perm = false) {
    const int kpl = lane >> 4, ng = lane & 15;
#pragma unroll 4
    for (int i = 0; i < 8; ++i) {
        const int kp = 4 * i + kpl;
        const float* src = W + (size_t)(k0 + 2 * kp) * N + n0 + 4 * ng;
        const f32x4 a = *(const f32x4*)src, b = *(const f32x4*)(src + N);
        LAS unsigned* d = scr + (4 * ng) * 33 + kp;
        d[0] = pk2(a.x, b.x); d[33] = pk2(a.y, b.y); d[66] = pk2(a.z, b.z); d[99] = pk2(a.w, b.w);
    }
    LDS_WAIT(); asm volatile("" ::: "memory");
    const int c = lane & 7;
#pragma unroll
    for (int j = 0; j < 8; ++j) { const int n = (lane >> 3) + 8 * j; const LAS unsigned* s = scr + n * 33 + 4 * c;
        v4u o; o.x = s[0]; o.y = s[1]; o.z = s[2]; o.w = s[3];
        const int jr = drow0 + n, jl = jr & 127, R = perm ? ((jl & ~31) + perm32_inv(jl & 31)) : jl;
        bf16* dp = tiled_rows ? (bf16*)((char*)Wt + ((size_t)(k0 >> 6) * (tiled_rows >> 7) + (jr >> 7)) * pg8::HTB + pg8::lds_byte(R, 8 * c)) : Wt + (size_t)(drow0 + n) * K + k0 + 8 * c;
        *(GAS v4u*)dp = o; }
    LDS_WAIT(); asm volatile("" ::: "memory");
}
__device__ __forceinline__ void conv_mat_tile(const float* W, int K, int N, bf16* Wt, int mode, int r, LAS unsigned* scr, int lane, int tiled_rows = 0, bool perm = false) {
    const int nblk = N / 64, kb = r / nblk, nb = r % nblk, n0 = 64 * nb;
    int drow0 = n0;
    if (mode == 1) { const int half = n0 >= DFF ? 1 : 0, nn = n0 - half * DFF; drow0 = (nn >> 7) * 256 + half * 128 + (nn & 127); }
    conv_tile(W, N, Wt, K, 64 * kb, n0, drow0, scr, lane, tiled_rows, perm);
}
constexpr int T_WIN = (DM / 64) * (2 * DFF / 64), T_WOUT = (DFF / 64) * (DM / 64), T_ABIN = (DM / 64) * (ABW / 64), T_SQ = (DM / 64) * (DM / 64), T_RGIN = (DM / 64) * (RGW / 64), T_GATE = 64 * 4;
constexpr int T_TOTAL = 4 * T_WIN + 4 * T_WOUT + T_ABIN + T_SQ + T_RGIN + T_SQ + T_GATE;

constexpr int TL_WIN = 0, TL_WOUT = 4 * T_WIN, TL_ABIN = TL_WOUT + 4 * T_WOUT, TL_ABOUT = TL_ABIN + T_ABIN, TL_RGIN = TL_ABOUT + T_SQ, TL_RGOUT = TL_RGIN + T_RGIN, TL_GATE = TL_RGOUT + T_SQ;
static_assert(TL_GATE + T_GATE == T_TOTAL, "tile list");
__device__ __forceinline__ void convert_ranges(const Args& a, unsigned char* ws, LAS unsigned char* lds, int a0, int a1, int b0, int b1, int widx, int nw, int wave, int lane) {
    LAS unsigned* scr = (LAS unsigned*)(lds + 49152 + wave * 8704);
    const int na = a1 - a0, ntot = na + (b1 - b0);
    for (int it = widx; it < ntot; it += nw) {
        int r = it < na ? a0 + it : b0 + (it - na);
        if (r < 4 * T_WIN) { const int s = r / T_WIN; r -= s * T_WIN; const int l = s >> 1;
            const float* W = ((s & 1) ? a.in[I_F2IN] : a.in[I_F1IN]) + (size_t)l * DM * 2 * DFF;
            conv_mat_tile(W, DM, 2 * DFF, (bf16*)(ws + WS_WIN + (size_t)s * WIN_BYTES), 1, r, scr, lane, XN_IMG ? 2 * DFF : 0, true); continue; }
        r -= 4 * T_WIN;
        if (r < 4 * T_WOUT) { const int s = r / T_WOUT; r -= s * T_WOUT; const int l = s >> 1;
            const float* W = ((s & 1) ? a.in[I_F2OUT] : a.in[I_F1OUT]) + (size_t)l * DFF * DM;
            conv_mat_tile(W, DFF, DM, (bf16*)(ws + WS_WOUT + (size_t)s * WOUT_BYTES), 0, r, scr, lane, DM, true); continue; }
        r -= 4 * T_WOUT;
        if (r < T_ABIN) { conv_mat_tile(a.in[I_ABIN], DM, ABW, (bf16*)(ws + WS_WABIN), 0, r, scr, lane, XN_IMG ? ABW : 0, true); continue; }
        r -= T_ABIN;
        if (r < T_SQ) { conv_mat_tile(a.in[I_ABOUT], DM, DM, (bf16*)(ws + WS_WABOUT), 0, r, scr, lane); continue; }
        r -= T_SQ;
        if (r < T_RGIN) { conv_mat_tile(a.in[I_RGIN], DM, RGW, (bf16*)(ws + WS_WRGIN), 0, r, scr, lane, XN_IMG ? RGW : 0, true); continue; }
        r -= T_RGIN;
        if (r < T_SQ) { conv_mat_tile(a.in[I_RGOUT], DM, DM, (bf16*)(ws + WS_WRGOUT), 0, r, scr, lane); continue; }
        r -= T_SQ;
        {
            const int mi = r >> 2, t = r & 3, d = mi >> 5, g = (mi >> 4) & 1, h = mi & 15;
            const float* W = (g ? a.in[I_RGWX] : a.in[I_RGWA]) + (size_t)(d * 16 + h) * 128 * 128;
            conv_mat_tile(W, 128, 128, (bf16*)(ws + WS_WGATE) + (size_t)mi * 128 * 128, 0, t, scr, lane);
        }
    }
}
template <int UNR = 16> __device__ __forceinline__ void mod_gemv_task(const Args& a, unsigned char* ws, LAS unsigned char* lds, int t, int tid, int wave, int lane) {
    LAS float* SC = (LAS float*)lds;
    LAS float* RED = (LAS float*)(lds + 24576);
    const int l = t / 144, cb = t % 144, n = 128 * cb + 2 * lane;
    const float* W = a.in[I_WMOD] + ((size_t)l * DM + 256 * wave) * MODW + n;
    f32x2 acc0 = {0.f, 0.f}, acc1 = acc0, acc2 = acc0;
#pragma unroll UNR
    for (int k = 0; k < 256; ++k) {
        const f32x2 w = *(const f32x2*)(W + (size_t)k * MODW);
        const int kk = 256 * wave + k;
        acc0 += w * SC[kk]; acc1 += w * SC[2048 + kk]; acc2 += w * SC[4096 + kk];
    }
    LAS f32x2* R2 = (LAS f32x2*)RED;
    R2[(wave * 3 + 0) * 64 + lane] = acc0; R2[(wave * 3 + 1) * 64 + lane] = acc1; R2[(wave * 3 + 2) * 64 + lane] = acc2;
    __syncthreads();
    for (int o = tid; o < 384; o += NTHR) { const int v = o >> 7, j = o & 127; float s = a.in[I_BMOD][(size_t)l * MODW + 128 * cb + j];
#pragma unroll
        for (int w = 0; w < 8; ++w) s += RED[(w * 3 + v) * 128 + j];
        ((float*)(ws + WS_MOD))[((size_t)l * 3 + v) * MODW + 128 * cb + j] = s; }
    __syncthreads();
}
template <int UNR = 16> __device__ __forceinline__ void mod_gemv_tasks(const Args& a, unsigned char* ws, LAS unsigned char* lds, int t0, int t1, int worker, int nworkers, int tid, int wave, int lane) {
    if (t0 + worker >= t1) return;
    LAS float* SC = (LAS float*)lds;
    for (int i = tid; i < 3 * DM; i += NTHR) { const int v = i / DM, k = i % DM; const float c = (v < 2) ? a.in[I_C][v * DM + k] : a.in[I_CCTX][k];
        SC[i] = c / (1.0f + __expf(-c)); }
    __syncthreads();
    for (int t = t0 + worker; t < t1; t += nworkers) mod_gemv_task<UNR>(a, ws, lds, t, tid, wave, lane);
}
__device__ __forceinline__ void p0_prologue(const Args& a, unsigned char* ws, LAS unsigned char* lds, int G, int bid, int tid, int wave, int lane) {
    constexpr int NG = 144;
    if (bid < NG) mod_gemv_tasks<32>(a, ws, lds, 0, 144, bid, G < NG ? G : NG, tid, wave, lane);
    if (bid == G - 1) {
        float* ct = (float*)(ws + WS_ROPE); float* st = ct + 4096;
        for (int i = tid; i < 4096; i += NTHR) { const int pos = i >> 5, f = i & 31; const float inv = powf(10000.0f, -(float)f / 32.0f); const float ang = (float)pos * inv;
            const float c_ = cosf(ang), s_ = sinf(ang); ct[i] = c_; st[i] = s_;
            typedef _Float16 h2v_ __attribute__((ext_vector_type(2))); const h2v_ hv_ = {(_Float16)c_, (_Float16)s_};
            ((unsigned*)(ct + 8192))[i] = __builtin_bit_cast(unsigned, hv_); }
    }
    __syncthreads();
    { constexpr int SHARE_G = 2, SHARE_O = 4;
      const int wG = NG * NWAVES, wO = (G - NG) * NWAVES, tot = wG * SHARE_G + wO * SHARE_O;
      const int gwave = bid * NWAVES + wave;
      if (G > NG) { const int first = bid < NG ? gwave * SHARE_G : wG * SHARE_G + (gwave - wG) * SHARE_O, cnt = bid < NG ? SHARE_G : SHARE_O;
          for (int q = 0; q < cnt; ++q) convert_ranges(a, ws, lds, TL_WIN, TL_WIN + T_WIN, 0, 0, first + q, tot, wave, lane); }
      else convert_ranges(a, ws, lds, TL_WIN, TL_WIN + T_WIN, 0, 0, gwave, G * NWAVES, wave, lane); }
}

__device__ __forceinline__ int ncol(int lane, int jj) { return 8 * lane + 512 * (jj >> 1) + 4 * (jj & 1); }
__device__ __forceinline__ void norm_load_vec(const float* g, const float* shift, const float* scale, int v, int lane, f32x4 (&gs)[8], f32x4 (&sh)[8]) {
#pragma unroll
    for (int j = 0; j < 8; ++j) { const int c = ncol(lane, j); const f32x4 gg = *(const f32x4*)(g + c), sc = *(const f32x4*)(scale + (size_t)v * MODW + c);
        gs[j] = gg * (sc + 1.0f); sh[j] = *(const f32x4*)(shift + (size_t)v * MODW + c); }
}
__device__ __forceinline__ void norm_finish(f32x4 (&x)[8], const f32x4 (&gs)[8], const f32x4 (&sh)[8], bf16* XNb, int row, int lane) {
    float s = 0.f;
#pragma unroll
    for (int j = 0; j < 8; ++j) s += (x[j].x * x[j].x + x[j].y * x[j].y) + (x[j].z * x[j].z + x[j].w * x[j].w);
    const float rstd = 1.0f / sqrtf(wave_sum(s) * (1.0f / DM) + EPS);
#pragma unroll
    for (int j = 0; j < 4; ++j) { const f32x4 y0 = x[2 * j] * rstd * gs[2 * j] + sh[2 * j], y1 = x[2 * j + 1] * rstd * gs[2 * j + 1] + sh[2 * j + 1];
        v4u w; w.x = cvtpk(y0.x, y0.y); w.y = cvtpk(y0.z, y0.w); w.z = cvtpk(y1.x, y1.y); w.w = cvtpk(y1.z, y1.w);
        const int col = 8 * lane + 512 * j;
        if (XN_IMG) *(v4u*)((char*)XNb + ((size_t)(col >> 6) * (MROWS >> 7) + (row >> 7)) * pg8::HTB + pg8::lds_byte(row & 127, col & 63)) = w;
        else *(v4u*)(XNb + (size_t)row * DM + col) = w; }
}
template <bool F32> __device__ __forceinline__ void norm_load_row(const void* rowp, int lane, f32x4 (&x)[8]) {
    if (F32) { const float* xr = (const float*)rowp;
#pragma unroll
        for (int j = 0; j < 8; ++j) x[j] = *(const f32x4*)(xr + ncol(lane, j)); }
    else { const bf16* xr = (const bf16*)rowp; v4u w[4];
#pragma unroll
        for (int j = 0; j < 4; ++j) w[j] = *(const v4u*)(xr + 8 * lane + 512 * j);
#pragma unroll
        for (int j = 0; j < 4; ++j) { x[2 * j] = (f32x4){bf_lo(w[j].x), bf_hi(w[j].x), bf_lo(w[j].y), bf_hi(w[j].y)}; x[2 * j + 1] = (f32x4){bf_lo(w[j].z), bf_hi(w[j].z), bf_lo(w[j].w), bf_hi(w[j].w)}; } }
}
template <bool LAT_F32, bool CTX_F32>
__device__ __forceinline__ void norm_phase(const void* srcLat, const void* srcCtx, int nrows, const float* g, const float* shift, const float* scale  , bf16* XN, int gw, int ngw, int lane,
                                           int gwalt, const float* slab = nullptr, int nslab = 0, bf16* ctxOut = nullptr, LAS unsigned char* lds_norm = nullptr) {
    f32x4 gs[8], sh[8];
    constexpr size_t LSTR = LAT_F32 ? 4 : 2, CSTR = CTX_F32 ? 4 : 2;
    { const int per = (NLAT + ngw - 1) / ngw; const int r0 = gw * per, r1 = (r0 + per < NLAT) ? r0 + per : NLAT;
      int vcur = -1;
      int row = r0;
      for (; row + 3 < r1 && ((row < SEQ) == (row + 3 < SEQ)); row += 4) {
          const int v = row < SEQ ? 0 : 1;
          if (v != vcur) { vcur = v; norm_load_vec(g, shift, scale, v, lane, gs, sh); }
          f32x4 x0[8], x1[8], x2[8], x3[8];
          norm_load_row<LAT_F32>((const char*)srcLat + (size_t)row * DM * LSTR, lane, x0); norm_load_row<LAT_F32>((const char*)srcLat + (size_t)(row + 1) * DM * LSTR, lane, x1);
          norm_load_row<LAT_F32>((const char*)srcLat + (size_t)(row + 2) * DM * LSTR, lane, x2); norm_load_row<LAT_F32>((const char*)srcLat + (size_t)(row + 3) * DM * LSTR, lane, x3);
          norm_finish(x0, gs, sh, XN, row, lane); norm_finish(x1, gs, sh, XN, row + 1, lane); norm_finish(x2, gs, sh, XN, row + 2, lane); norm_finish(x3, gs, sh, XN, row + 3, lane);
      }
      for (; row + 1 < r1 && ((row < SEQ) == (row + 1 < SEQ)); row += 2) {
          const int v = row < SEQ ? 0 : 1;
          if (v != vcur) { vcur = v; norm_load_vec(g, shift, scale, v, lane, gs, sh); }
          f32x4 x[8], y[8];
          norm_load_row<LAT_F32>((const char*)srcLat + (size_t)row * DM * LSTR, lane, x); norm_load_row<LAT_F32>((const char*)srcLat + (size_t)(row + 1) * DM * LSTR, lane, y);
          norm_finish(x, gs, sh, XN, row, lane); norm_finish(y, gs, sh, XN, row + 1, lane);
      }
      for (; row < r1; ++row) {
          const int v = row < SEQ ? 0 : 1;
          if (v != vcur) { vcur = v; norm_load_vec(g, shift, scale, v, lane, gs, sh); }
          f32x4 x[8]; norm_load_row<LAT_F32>((const char*)srcLat + (size_t)row * DM * LSTR, lane, x);
          norm_finish(x, gs, sh, XN, row, lane);
      } }
    if (nrows > NLAT) {
        LAS float* red = (LAS float*)(lds_norm);
        const int G_ = ngw / NWAVES, bid_ = gw / NWAVES, wv = gw % NWAVES, half = wv >> 2, jq = wv & 3, col = 8 * lane + 512 * jq;
        for (int c0 = bid_; c0 < NCTXR; c0 += 2 * G_) {
            const int cr = c0 + half * G_; const bool live = cr < NCTXR;
            f32x4 xa = {0.f, 0.f, 0.f, 0.f}, xb = xa;
            const f32x4 ga = *(const f32x4*)(g + col), gb = *(const f32x4*)(g + col + 4), sa = *(const f32x4*)(scale + (size_t)2 * MODW + col), sb = *(const f32x4*)(scale + (size_t)2 * MODW + col + 4);
            const f32x4 ha = *(const f32x4*)(shift + (size_t)2 * MODW + col), hb = *(const f32x4*)(shift + (size_t)2 * MODW + col + 4);
            if (live) {
                if (CTX_F32) { const float* xr = (const float*)srcCtx + (size_t)cr * DM + col; xa = *(const f32x4*)xr; xb = *(const f32x4*)(xr + 4); }
                else { const v4u w = *(const v4u*)((const bf16*)srcCtx + (size_t)cr * DM + col); xa = (f32x4){bf_lo(w.x), bf_hi(w.x), bf_lo(w.y), bf_hi(w.y)}; xb = (f32x4){bf_lo(w.z), bf_hi(w.z), bf_lo(w.w), bf_hi(w.w)}; }
                if (nslab > 0) {
                    v4u tw[11];
#pragma unroll
                    for (int q = 0; q < 11; ++q) { const int qq = q < nslab ? q : 0; tw[q] = *(const v4u*)((const bf16*)slab + ((size_t)qq * NCTXR + cr) * DM + col); }
#pragma unroll
                    for (int q = 0; q < 11; ++q) if (q < nslab) { xa += (f32x4){bf_lo(tw[q].x), bf_hi(tw[q].x), bf_lo(tw[q].y), bf_hi(tw[q].y)}; xb += (f32x4){bf_lo(tw[q].z), bf_hi(tw[q].z), bf_lo(tw[q].w), bf_hi(tw[q].w)}; }
                    v4u w; w.x = cvtpk(xa.x, xa.y); w.y = cvtpk(xa.z, xa.w); w.z = cvtpk(xb.x, xb.y); w.w = cvtpk(xb.z, xb.w);
                    *(v4u*)(ctxOut + (size_t)cr * DM + col) = w;
                    xa = (f32x4){bf_lo(w.x), bf_hi(w.x), bf_lo(w.y), bf_hi(w.y)}; xb = (f32x4){bf_lo(w.z), bf_hi(w.z), bf_lo(w.w), bf_hi(w.w)};
                }
            }
            const float part = wave_sum((xa.x * xa.x + xa.y * xa.y) + (xa.z * xa.z + xa.w * xa.w) + (xb.x * xb.x + xb.y * xb.y) + (xb.z * xb.z + xb.w * xb.w));
            if (lane == 0) red[wv] = part;
            __syncthreads();
            if (live) {
                const float tot = (red[4 * half] + red[4 * half + 1]) + (red[4 * half + 2] + red[4 * half + 3]);
                const float rstd = 1.0f / sqrtf(tot * (1.0f / DM) + EPS);
                const f32x4 y0 = xa * rstd * (ga * (sa + 1.0f)) + ha, y1 = xb * rstd * (gb * (sb + 1.0f)) + hb;
                v4u w; w.x = cvtpk(y0.x, y0.y); w.y = cvtpk(y0.z, y0.w); w.z = cvtpk(y1.x, y1.y); w.w = cvtpk(y1.z, y1.w);
                const int row = NLAT + cr;
                if (XN_IMG) *(v4u*)((char*)XN + ((size_t)(col >> 6) * (MROWS >> 7) + (row >> 7)) * pg8::HTB + pg8::lds_byte(row & 127, col & 63)) = w;
                else *(v4u*)(XN + (size_t)row * DM + col) = w;
            }
            __syncthreads();
        }
    }
}
__device__ __forceinline__ void final_norm_phase(const bf16* X, const float* g, float* out, int gw, int ngw, int lane) {
    f32x4 gg[8];
#pragma unroll
    for (int j = 0; j < 8; ++j) gg[j] = *(const f32x4*)(g + ncol(lane, j));
    for (int row = gw; row < NLAT; row += ngw) {
        f32x4 x[8]; float s = 0.f; norm_load_row<false>(X + (size_t)row * DM, lane, x);
#pragma unroll
        for (int j = 0; j < 8; ++j) s += (x[j].x * x[j].x + x[j].y * x[j].y) + (x[j].z * x[j].z + x[j].w * x[j].w);
        const float rstd = 1.0f / sqrtf(wave_sum(s) * (1.0f / DM) + EPS);
#pragma unroll
        for (int j = 0; j < 8; ++j) *(f32x4*)(out + (size_t)row * DM + ncol(lane, j)) = x[j] * rstd * gg[j];
    }
}

typedef float f32x16 __attribute__((ext_vector_type(16)));
typedef short s16x4 __attribute__((ext_vector_type(4)));
constexpr int KSTR = 136, VSTR = 160;
constexpr int AT_K = 0, AT_V = 64 * KSTR * 2, AT_BUF = AT_V + 64 * VSTR * 2  , AT_WS = 2 * AT_BUF, AT_END = AT_WS + NWAVES * 256;
#define AT_LDS_BAR() do { asm volatile("s_waitcnt lgkmcnt(0)" ::: "memory"); __builtin_amdgcn_s_barrier(); asm volatile("" ::: "memory"); } while (0)
constexpr float ATT_C2 = 0.08838834764831845f * 1.4426950408889634f;
constexpr float LOG2E = 1.4426950408889634f;
__device__ __forceinline__ int crow(int r, int hi) { return (r & 3) + 8 * (r >> 2) + 4 * hi; }

__device__ __forceinline__ void rope_pair(v4u& p1, v4u& p2, const float* ropeC, const float* ropeS, int pos, int f0) {
    const f32x4 c0 = *(const f32x4*)(ropeC + pos * 32 + f0), c1 = *(const f32x4*)(ropeC + pos * 32 + f0 + 4);
    const f32x4 s0 = *(const f32x4*)(ropeS + pos * 32 + f0), s1 = *(const f32x4*)(ropeS + pos * 32 + f0 + 4);
    const float cc[8] = {c0.x, c0.y, c0.z, c0.w, c1.x, c1.y, c1.z, c1.w}, ss[8] = {s0.x, s0.y, s0.z, s0.w, s1.x, s1.y, s1.z, s1.w};
    unsigned a[4] = {p1.x, p1.y, p1.z, p1.w}, b[4] = {p2.x, p2.y, p2.z, p2.w};
#pragma unroll
    for (int i = 0; i < 4; ++i) {
        const float x1l = bf_lo(a[i]), x1h = bf_hi(a[i]), x2l = bf_lo(b[i]), x2h = bf_hi(b[i]);
        a[i] = cvtpk(x1l * cc[2 * i] - x2l * ss[2 * i], x1h * cc[2 * i + 1] - x2h * ss[2 * i + 1]);
        b[i] = cvtpk(x2l * cc[2 * i] + x1l * ss[2 * i], x2h * cc[2 * i + 1] + x1h * ss[2 * i + 1]);
    }
    p1 = (v4u){a[0], a[1], a[2], a[3]}; p2 = (v4u){b[0], b[1], b[2], b[3]};
}

__device__ __forceinline__ void rope_pair_pre(v4u& p1, v4u& p2, const f32x4& c0, const f32x4& c1, const f32x4& s0, const f32x4& s1) {
    const float cc[8] = {c0.x, c0.y, c0.z, c0.w, c1.x, c1.y, c1.z, c1.w}, ss[8] = {s0.x, s0.y, s0.z, s0.w, s1.x, s1.y, s1.z, s1.w};
    unsigned a[4] = {p1.x, p1.y, p1.z, p1.w}, b[4] = {p2.x, p2.y, p2.z, p2.w};
#pragma unroll
    for (int i = 0; i < 4; ++i) {
        const float x1l = bf_lo(a[i]), x1h = bf_hi(a[i]), x2l = bf_lo(b[i]), x2h = bf_hi(b[i]);
        a[i] = cvtpk(x1l * cc[2 * i] - x2l * ss[2 * i], x1h * cc[2 * i + 1] - x2h * ss[2 * i + 1]);
        b[i] = cvtpk(x2l * cc[2 * i] + x1l * ss[2 * i], x2h * cc[2 * i + 1] + x1h * ss[2 * i + 1]);
    }
    p1 = (v4u){a[0], a[1], a[2], a[3]}; p2 = (v4u){b[0], b[1], b[2], b[3]};
}

typedef _Float16 h2v __attribute__((ext_vector_type(2)));
__device__ __forceinline__ void rope_pair_h(v4u& p1, v4u& p2, const v4u& ra, const v4u& rb) {
    const unsigned t[8] = {ra.x, ra.y, ra.z, ra.w, rb.x, rb.y, rb.z, rb.w};
    unsigned a[4] = {p1.x, p1.y, p1.z, p1.w}, b[4] = {p2.x, p2.y, p2.z, p2.w};
#pragma unroll
    for (int i = 0; i < 4; ++i) {
        const h2v t0 = __builtin_bit_cast(h2v, t[2 * i]), t1 = __builtin_bit_cast(h2v, t[2 * i + 1]);
        const float c0 = (float)t0.x, s0 = (float)t0.y, c1 = (float)t1.x, s1 = (float)t1.y;
        const float x1l = bf_lo(a[i]), x1h = bf_hi(a[i]), x2l = bf_lo(b[i]), x2h = bf_hi(b[i]);
        a[i] = cvtpk(x1l * c0 - x2l * s0, x1h * c1 - x2h * s1);
        b[i] = cvtpk(x2l * c0 + x1l * s0, x2h * c1 + x1h * s1);
    }
    p1 = (v4u){a[0], a[1], a[2], a[3]}; p2 = (v4u){b[0], b[1], b[2], b[3]};
}

__device__ __forceinline__ void attn_unit(const bf16* __restrict__ PROJ, bf16* __restrict__ MIX, const float* sink, const float* ropeC, const float* ropeS,
                                          LAS unsigned char* lds, int u, int tid, int wave, int lane) {
    const bool isctx = u >= 512;
    int b, kvh, qb;
    if (!isctx) { b = u >> 8; kvh = (u >> 7) & 1; qb = u & 127; } else { const int uu = u - 512; b = uu >> 3; kvh = (uu >> 2) & 1; qb = uu & 3; }
    const int g = wave >> 1, rg = wave & 1, head = kvh * 4 + g;
    const int r32 = lane & 31, hi = lane >> 5;
    const size_t seqbase = isctx ? (size_t)NLAT + (size_t)b * CTXL : (size_t)b * SEQ;
    const size_t ctxbase = (size_t)NLAT + (size_t)b * CTXL;
    const int qpos = 64 * qb + 32 * rg + r32;
    const int srow = tid >> 3, sc = (tid & 3) + 8 * ((tid >> 2) & 1);
    const int t_lo = isctx ? 5 : 0;
    v4u kA, kB, vA, vB; bool kropeS = false; v4u rA, rB; const unsigned* ropeH = (const unsigned*)(ropeC + 8192);
    int tl_lo = 5, nloc = 0;
    if (!isctx) { tl_lo = 0; while (64 * qb - 128 + 64 * tl_lo < 0) ++tl_lo; int tl_hi = 4; while (64 * qb - 128 + 64 * tl_hi >= SEQ) --tl_hi; nloc = tl_hi - tl_lo + 1; }
    const int ntile = nloc + 4;
#define AT_FENCE() do { asm volatile("" ::: "memory"); __builtin_amdgcn_sched_barrier(0); } while (0)
#define AT_KF(j) (*(const LAS bf16x8*)(kb + 32 * ((j) >> 1) + ((j) & 1) * (32 * (KSTR * 2))))
#define AT_VLO(gq, d) __builtin_bit_cast(s16x4, __builtin_amdgcn_ds_read_tr16_b64_v4i16((LAS s16x4*)(vb + (16 * (gq)) * (VSTR * 2) + 64 * (d))))
#define AT_VHH(gq, d) __builtin_bit_cast(s16x4, __builtin_amdgcn_ds_read_tr16_b64_v4i16((LAS s16x4*)(vb + (16 * (gq) + 8) * (VSTR * 2) + 64 * (d))))
#define AT_TILE(i) ((i) < nloc ? tl_lo + (i) : 5 + ((i) - nloc))
#define AT_LOAD(t) do { const bool loc_ = (t) < 5; const int kp_ = loc_ ? (64 * qb - 128 + 64 * (t) + srow) : (64 * ((t) - 5) + srow); \
        const bf16* kr_ = PROJ + ((loc_ ? seqbase : ctxbase) + kp_) * ABW + 1024 + 128 * kvh + 8 * sc; \
        kA = *(const v4u*)kr_; kB = *(const v4u*)(kr_ + 32); vA = *(const v4u*)(kr_ + 256); vB = *(const v4u*)(kr_ + 288); kropeS = loc_; \
        if (loc_) { const int ro_ = ((sc >> 3) ? (kp_ & 63) : (kp_ >> 6)) * 32 + 8 * (sc & 3); rA = *(const v4u*)(ropeH + ro_); rB = *(const v4u*)(ropeH + ro_ + 4); } } while (0)
#define AT_STORE(buf) do { LAS unsigned char* tb_ = lds + (buf) * AT_BUF; \
        if (kropeS) rope_pair_h(kA, kB, rA, rB); \
        *(LAS v4u*)(tb_ + AT_K + srow * (KSTR * 2) + 16 * sc) = kA; *(LAS v4u*)(tb_ + AT_K + srow * (KSTR * 2) + 16 * (sc + 4)) = kB; \
        *(LAS v4u*)(tb_ + AT_V + srow * (VSTR * 2) + 16 * sc) = vA; *(LAS v4u*)(tb_ + AT_V + srow * (VSTR * 2) + 16 * (sc + 4)) = vB; } while (0)
    AT_LOAD(AT_TILE(0));
    v4u qraw[8];
    { const bf16* qrow = PROJ + (seqbase + qpos) * ABW + head * HD + 8 * hi;
#pragma unroll
      for (int kk = 0; kk < 8; ++kk) qraw[kk] = *(const v4u*)(qrow + 16 * kk); }
    if (!isctx) {
        rope_pair(qraw[0], qraw[2], ropeC, ropeS, qpos >> 6, 8 * hi);
        rope_pair(qraw[1], qraw[3], ropeC, ropeS, qpos >> 6, 16 + 8 * hi);
        rope_pair(qraw[4], qraw[6], ropeC, ropeS, qpos & 63, 8 * hi);
        rope_pair(qraw[5], qraw[7], ropeC, ropeS, qpos & 63, 16 + 8 * hi);
    }
    bf16x8 qf[8];
#pragma unroll
    for (int kk = 0; kk < 8; ++kk) qf[kk] = __builtin_bit_cast(bf16x8, qraw[kk]);
    AT_FENCE();
    float m_run = sink[head] * LOG2E, l_run = 1.0f;
    f32x16 O[4];
#pragma unroll
    for (int d = 0; d < 4; ++d)
#pragma unroll
        for (int r = 0; r < 16; ++r) O[d][r] = 0.f;
    LAS float* wsf = (LAS float*)(lds + AT_WS) + wave * 64;
    AT_LDS_BAR();
    AT_STORE(0);
    if (ntile > 1) AT_LOAD(AT_TILE(1));
    AT_LDS_BAR();
#pragma unroll 1
    for (int it = 0; it < ntile; ++it) {
        const int tcur = AT_TILE(it);
        const LAS unsigned char* tb = lds + (it & 1) * AT_BUF;
        const LAS unsigned char* kb = tb + AT_K + r32 * (KSTR * 2) + 16 * hi;
        bf16x8 kf[8];
#pragma unroll
        for (int j = 0; j < 8; ++j) kf[j] = AT_KF(j);
        AT_FENCE();
        if (it + 1 < ntile) AT_STORE((it + 1) & 1);
        if (it + 2 < ntile) AT_LOAD(AT_TILE(it + 2));
        f32x16 p0, p1;
#pragma unroll
        for (int r = 0; r < 16; ++r) { p0[r] = 0.f; p1[r] = 0.f; }
#pragma unroll
        for (int kk = 0; kk < 8; ++kk) {
            p0 = __builtin_amdgcn_mfma_f32_32x32x16_bf16(kf[2 * (kk & 3)], qf[kk], p0, 0, 0, 0);
            p1 = __builtin_amdgcn_mfma_f32_32x32x16_bf16(kf[2 * (kk & 3) + 1], qf[kk], p1, 0, 0, 0);
            if (kk < 4) { kf[2 * kk] = AT_KF(2 * (kk + 4)); kf[2 * kk + 1] = AT_KF(2 * (kk + 4) + 1); AT_FENCE(); }
        }
        AT_FENCE();
        const LAS unsigned char* vb = tb + AT_V + (4 * hi + ((lane & 15) >> 2)) * (VSTR * 2) + (16 * ((lane >> 4) & 1) + 4 * (lane & 3)) * 2;
        s16x4 vlo[2][4], vhh[2][4];
#pragma unroll
        for (int d = 0; d < 4; ++d) { vlo[0][d] = AT_VLO(0, d); vhh[0][d] = AT_VHH(0, d); }
        AT_FENCE();
        const int qrel = 32 * rg + r32;
        if (tcur == 0) {
#pragma unroll
            for (int r = 0; r < 16; ++r) { const int kv0 = crow(r, hi); if (kv0 < qrel) p0[r] = -INFINITY; if (kv0 + 32 < qrel) p1[r] = -INFINITY; } }
        if (tcur == 4) {
#pragma unroll
            for (int r = 0; r < 16; ++r) { const int kv0 = crow(r, hi); if (kv0 > qrel) p0[r] = -INFINITY; if (kv0 + 32 > qrel) p1[r] = -INFINITY; } }
        float mx = fmaxf(p0[0], p1[0]);
#pragma unroll
        for (int r = 1; r < 16; ++r) mx = fmaxf(mx, fmaxf(p0[r], p1[r]));
        { const auto rr = __builtin_amdgcn_permlane32_swap(__float_as_uint(mx), __float_as_uint(mx), false, false); mx = fmaxf(__uint_as_float(rr[0]), __uint_as_float(rr[1])); }
        const float cand = mx * ATT_C2; const bool grow = cand > m_run + 8.0f;
        const float m_new = grow ? cand : m_run;
        float rs = 0.f;
#pragma unroll
        for (int r = 0; r < 16; ++r) { p0[r] = __builtin_amdgcn_exp2f(p0[r] * ATT_C2 - m_new); p1[r] = __builtin_amdgcn_exp2f(p1[r] * ATT_C2 - m_new); rs += p0[r] + p1[r]; }
        { const auto rr = __builtin_amdgcn_permlane32_swap(__float_as_uint(rs), __float_as_uint(rs), false, false); rs = __uint_as_float(rr[0]) + __uint_as_float(rr[1]); }
        if (__any(grow)) {
            const float alpha = __builtin_amdgcn_exp2f(m_run - m_new);
            l_run = l_run * alpha + rs; m_run = m_new;
            if (hi == 0) wsf[r32] = alpha;
            LDS_WAIT(); asm volatile("" ::: "memory");
            float al[16];
#pragma unroll
            for (int r = 0; r < 16; ++r) al[r] = wsf[crow(r, hi)];
#pragma unroll
            for (int d = 0; d < 4; ++d)
#pragma unroll
                for (int r = 0; r < 16; ++r) O[d][r] *= al[r];
            LDS_WAIT(); asm volatile("" ::: "memory");
        } else l_run += rs;
#pragma unroll
        for (int d = 0; d < 4; ++d) { vlo[1][d] = AT_VLO(1, d); vhh[1][d] = AT_VHH(1, d); }
        AT_FENCE();
#pragma unroll
        for (int gq = 0; gq < 4; ++gq) {
            const int half = gq >> 1, s = gq & 1;
            u32x4 pw;
            if (half == 0) { pw.x = cvtpk(p0[8 * s + 0], p0[8 * s + 1]); pw.y = cvtpk(p0[8 * s + 2], p0[8 * s + 3]); pw.z = cvtpk(p0[8 * s + 4], p0[8 * s + 5]); pw.w = cvtpk(p0[8 * s + 6], p0[8 * s + 7]); }
            else           { pw.x = cvtpk(p1[8 * s + 0], p1[8 * s + 1]); pw.y = cvtpk(p1[8 * s + 2], p1[8 * s + 3]); pw.z = cvtpk(p1[8 * s + 4], p1[8 * s + 5]); pw.w = cvtpk(p1[8 * s + 6], p1[8 * s + 7]); }
            const bf16x8 pa = __builtin_bit_cast(bf16x8, pw);
#pragma unroll
            for (int d = 0; d < 4; ++d) {
                const s16x4 lo = vlo[gq & 1][d], hh = vhh[gq & 1][d];
                const bf16x8 vf = (bf16x8){lo[0], lo[1], lo[2], lo[3], hh[0], hh[1], hh[2], hh[3]};
                O[d] = __builtin_amdgcn_mfma_f32_32x32x16_bf16(pa, vf, O[d], 0, 0, 0);
                if (gq < 2) { vlo[gq & 1][d] = AT_VLO(gq + 2, d); vhh[gq & 1][d] = AT_VHH(gq + 2, d); AT_FENCE(); }
            }
        }
        AT_LDS_BAR();
    }
#undef AT_TILE
#undef AT_FENCE
#undef AT_KF
#undef AT_VLO
#undef AT_VHH
#undef AT_STORE
#undef AT_LOAD
    if (hi == 0) wsf[32 + r32] = 1.0f / l_run;
    LDS_WAIT(); asm volatile("" ::: "memory");
    { LAS bf16* stg = (LAS bf16*)(lds + wave * 8704);
#pragma unroll
      for (int r = 0; r < 16; ++r) { const int q = crow(r, hi); const float il = wsf[32 + q];
#pragma unroll
          for (int d = 0; d < 4; ++d) stg[q * 136 + 32 * d + r32] = (bf16)f2bf(O[d][r] * il); }
      LDS_WAIT(); asm volatile("" ::: "memory");
      bf16* obase = MIX + (seqbase + 64 * qb + 32 * rg) * DM + head * HD;
#pragma unroll
      for (int j = 0; j < 8; ++j) { const int i = lane + 64 * j, row = i >> 4, ch = i & 15;
          const v4u w = *(const LAS v4u*)(stg + row * 136 + 8 * ch);
          *(v4u*)(obase + (size_t)row * DM + 8 * ch) = w; }
      LDS_WAIT(); asm volatile("" ::: "memory"); }
}

__device__ __forceinline__ void sconv_item_load(const bf16* __restrict__ PROJ, int it, v4u& bgv, v4u (&cg)[3], v4u (&uu)[3], float (&msk)[3]) {
    const int row = it >> 7, c = (it & 127) * 8;
    int pos, len; if (row < NLAT) { pos = row & (SEQ - 1); len = SEQ; } else { pos = (row - NLAT) & (CTXL - 1); len = CTXL; }
    const bf16* pr = PROJ + (size_t)row * ABW;
    bgv = *(const v4u*)(pr + 1536 + c);
#pragma unroll
    for (int k = 0; k < 3; ++k) { const int p2 = pos + k - 1; const bool ok = (p2 >= 0 && p2 < len); const bf16* q = pr + (ok ? (ptrdiff_t)(k - 1) * ABW : 0);
        cg[k] = *(const v4u*)(q + 2560 + c); uu[k] = *(const v4u*)(q + 3584 + c); msk[k] = ok ? 1.0f : 0.0f; }
}
__device__ __forceinline__ void sconv_item_finish(bf16* __restrict__ MIX, const float* cw, int it, const v4u& bgv, const v4u (&cg)[3], const v4u (&uu)[3], const float (&msk)[3]) {
    const int row = it >> 7, c = (it & 127) * 8;
    float acc[8];
#pragma unroll
    for (int j = 0; j < 8; ++j) acc[j] = 0.f;
#pragma unroll
    for (int k = 0; k < 3; ++k) {
        const f32x4 w0 = *(const f32x4*)(cw + k * 1024 + c) * msk[k], w1 = *(const f32x4*)(cw + k * 1024 + c + 4) * msk[k];
        const unsigned cgw[4] = {cg[k].x, cg[k].y, cg[k].z, cg[k].w}, uw[4] = {uu[k].x, uu[k].y, uu[k].z, uu[k].w};
        const float ww[8] = {w0.x, w0.y, w0.z, w0.w, w1.x, w1.y, w1.z, w1.w};
#pragma unroll
        for (int i = 0; i < 4; ++i) { acc[2 * i] += ww[2 * i] * (bf_lo(cgw[i]) * bf_lo(uw[i])); acc[2 * i + 1] += ww[2 * i + 1] * (bf_hi(cgw[i]) * bf_hi(uw[i])); }
    }
    const unsigned bw[4] = {bgv.x, bgv.y, bgv.z, bgv.w};
    v4u o;
    o.x = cvtpk(acc[0] * bf_lo(bw[0]), acc[1] * bf_hi(bw[0])); o.y = cvtpk(acc[2] * bf_lo(bw[1]), acc[3] * bf_hi(bw[1]));
    o.z = cvtpk(acc[4] * bf_lo(bw[2]), acc[5] * bf_hi(bw[2])); o.w = cvtpk(acc[6] * bf_lo(bw[3]), acc[7] * bf_hi(bw[3]));
    *(v4u*)(MIX + (size_t)row * DM + 1024 + c) = o;
}
__device__ __forceinline__ void sconv_items(const bf16* __restrict__ PROJ, bf16* __restrict__ MIX, const float* cw  , int gtid, int ngt) {
    constexpr int NIT = MROWS * 128;
    int it = gtid;
    for (; it + ngt < NIT; it += 2 * ngt) {
        v4u bA, cA[3], uA[3], bB, cB[3], uB[3]; float mA[3], mB[3];
        sconv_item_load(PROJ, it, bA, cA, uA, mA); sconv_item_load(PROJ, it + ngt, bB, cB, uB, mB);
        sconv_item_finish(MIX, cw, it, bA, cA, uA, mA); sconv_item_finish(MIX, cw, it + ngt, bB, cB, uB, mB);
    }
    if (it < NIT) { v4u bA, cA[3], uA[3]; float mA[3]; sconv_item_load(PROJ, it, bA, cA, uA, mA); sconv_item_finish(MIX, cw, it, bA, cA, uA, mA); }
}

__device__ __forceinline__ void sconv_strips(const bf16* __restrict__ PROJ, bf16* __restrict__ MIX, const float* cw  , int gtid, int ngt) {
    constexpr int R = 18, NGRP = (MROWS + R - 1) / R, NTASK = NGRP * 128;
    for (int task = gtid; task < NTASK; task += ngt) {
        const int grp = __builtin_amdgcn_readfirstlane(task >> 7), c = (task & 127) * 8;
        const int r0 = grp * R;
        float w[3][8];
#pragma unroll
        for (int k = 0; k < 3; ++k) { const f32x4 a = *(const f32x4*)(cw + k * 1024 + c), b = *(const f32x4*)(cw + k * 1024 + c + 4);
            w[k][0] = a.x; w[k][1] = a.y; w[k][2] = a.z; w[k][3] = a.w; w[k][4] = b.x; w[k][5] = b.y; w[k][6] = b.z; w[k][7] = b.w; }
        v4u cgq[4], uq[4], bgq[4];
#define SC_LOAD(slot, j) do { int rr_ = r0 + (j); rr_ = rr_ < 0 ? 0 : (rr_ >= MROWS ? MROWS - 1 : rr_); const bf16* pr_ = PROJ + (size_t)rr_ * ABW + c; \
        bgq[slot] = *(const v4u*)(pr_ + 1536); cgq[slot] = *(const v4u*)(pr_ + 2560); uq[slot] = *(const v4u*)(pr_ + 3584); } while (0)
        SC_LOAD(0, -1); SC_LOAD(1, 0); SC_LOAD(2, 1); SC_LOAD(3, 2);
        float P0[8], P1[8], P2[8]; v4u B1 = (v4u){0u, 0u, 0u, 0u}, B2;
#pragma unroll
        for (int i = 0; i < 8; ++i) { P0[i] = 0.f; P1[i] = 0.f; }
#pragma unroll 1
        for (int jb = -1; jb < R + 1; jb += 4) {
#pragma unroll
            for (int q = 0; q < 4; ++q) {
                const int j = jb + q;
                { const unsigned cgw[4] = {cgq[q].x, cgq[q].y, cgq[q].z, cgq[q].w}, uw[4] = {uq[q].x, uq[q].y, uq[q].z, uq[q].w};
#pragma unroll
                  for (int i = 0; i < 4; ++i) { P2[2 * i] = bf_lo(cgw[i]) * bf_lo(uw[i]); P2[2 * i + 1] = bf_hi(cgw[i]) * bf_hi(uw[i]); }
                  B2 = bgq[q]; }
                if (j + 4 <= R) SC_LOAD(q, j + 4);
                const int orow = r0 + j - 1;
                if (j >= 1 && orow < MROWS) {
                    int pos, len; if (orow < NLAT) { pos = orow & (SEQ - 1); len = SEQ; } else { pos = (orow - NLAT) & (CTXL - 1); len = CTXL; }
                    float acc[8];
#pragma unroll
                    for (int i = 0; i < 8; ++i) acc[i] = 0.f;
                    if (pos > 0) {
#pragma unroll
                        for (int i = 0; i < 8; ++i) acc[i] += w[0][i] * P0[i]; }
#pragma unroll
                    for (int i = 0; i < 8; ++i) acc[i] += w[1][i] * P1[i];
                    if (pos < len - 1) {
#pragma unroll
                        for (int i = 0; i < 8; ++i) acc[i] += w[2][i] * P2[i]; }
                    const unsigned bw[4] = {B1.x, B1.y, B1.z, B1.w};
                    v4u o;
                    o.x = cvtpk(acc[0] * bf_lo(bw[0]), acc[1] * bf_hi(bw[0])); o.y = cvtpk(acc[2] * bf_lo(bw[1]), acc[3] * bf_hi(bw[1]));
                    o.z = cvtpk(acc[4] * bf_lo(bw[2]), acc[5] * bf_hi(bw[2])); o.w = cvtpk(acc[6] * bf_lo(bw[3]), acc[7] * bf_hi(bw[3]));
                    *(v4u*)(MIX + (size_t)orow * DM + 1024 + c) = o;
                }
#pragma unroll
                for (int i = 0; i < 8; ++i) { P0[i] = P1[i]; P1[i] = P2[i]; }
                B1 = B2;
            }
        }
#undef SC_LOAD
    }
}

constexpr int UCF_STR = 132;
constexpr int SC_UC_BYTES = 32 * UCF_STR * 4 + 32 * KSTR * 2;
constexpr int SC_UC0 = 0, SC_Y = 2 * SC_UC_BYTES, SC_END = SC_Y + 2 * 32 * 128 * 4;
static_assert(SC_END <= RING_BYTES && (SC_UC_BYTES % 16) == 0 && ((32 * UCF_STR * 4) % 16) == 0, "scan LDS map");
__device__ __forceinline__ float sigmoid_f(float x) { return __builtin_amdgcn_rcpf(1.0f + __builtin_amdgcn_exp2f(-1.4426950408889634f * x)); }
__device__ __forceinline__ float neg_expm1_small(float x) { float p = 1.0f + x * (1.0f / 6.0f); p = 1.0f + x * (1.0f / 5.0f) * p; p = 1.0f + x * 0.25f * p; p = 1.0f + x * (1.0f / 3.0f) * p; p = 1.0f + x * 0.5f * p; return -x * p; }
__device__ __forceinline__ float gelu_tanh_f(float x) { const float z = 0.7978845608028654f * (x + 0.044715f * x * x * x); const float t = 1.0f - 2.0f * __builtin_amdgcn_rcpf(__builtin_amdgcn_exp2f(2.8853900817779268f * z) + 1.0f); return 0.5f * x * (1.0f + t); }

typedef _Float16 h2_t __attribute__((ext_vector_type(2)));
__device__ __forceinline__ float lane_partner(float x, int hi) {
    const auto rr = __builtin_amdgcn_permlane32_swap(__float_as_uint(x), __float_as_uint(x), false, false);
    return __uint_as_float(hi ? rr[0] : rr[1]);
}
template <bool REV, bool WANT_H, bool WANT_P = false>
__device__ __forceinline__ void lane_scan(const float (&av)[16], const float (&bv)[16], int hi, float carry, float (&hv)[16], float& Atot, float& Htot, float* pv = nullptr) {
    float As[4], Hs[4], Ap[4], Hp[4];
#pragma unroll
    for (int k = 0; k < 4; ++k) {
        float A = 1.0f, H = 0.0f;
#pragma unroll
        for (int i = 0; i < 4; ++i) { const int r = 4 * k + (REV ? 3 - i : i); H = av[r] * H + bv[r]; A *= av[r]; }
        As[k] = A; Hs[k] = H;
    }
#pragma unroll
    for (int k = 0; k < 4; ++k) { Ap[k] = lane_partner(As[k], hi); Hp[k] = lane_partner(Hs[k], hi); }
    const bool ownFirst = REV ? (hi == 1) : (hi == 0);
    float c = carry, c0 = 0.0f, At = 1.0f; float cin[4], pin[4];
#pragma unroll
    for (int kk = 0; kk < 4; ++kk) { const int k = REV ? 3 - kk : kk;
        const float A1 = ownFirst ? As[k] : Ap[k], H1 = ownFirst ? Hs[k] : Hp[k], A2 = ownFirst ? Ap[k] : As[k], H2 = ownFirst ? Hp[k] : Hs[k];
        const float cf = c; c = A1 * c + H1; const float cs = c; c = A2 * c + H2;
        cin[k] = ownFirst ? cf : cs;
        pin[k] = ownFirst ? At : At * A1;
        c0 = A1 * c0 + H1; c0 = A2 * c0 + H2; At *= A1 * A2; }
    Atot = At; Htot = c0;
    if (WANT_H) {
#pragma unroll
        for (int k = 0; k < 4; ++k) { float hcur = cin[k], pcur = pin[k];
#pragma unroll
            for (int i = 0; i < 4; ++i) { const int r = 4 * k + (REV ? 3 - i : i); hcur = av[r] * hcur + bv[r]; hv[r] = hcur; if (WANT_P) { pcur *= av[r]; pv[r] = pcur; } } }
    }
}

#define LDS_BAR() do { asm volatile("s_waitcnt lgkmcnt(0)" ::: "memory"); __builtin_amdgcn_s_barrier(); asm volatile("" ::: "memory"); } while (0)
template <bool PASS3>
__device__ __forceinline__ void scan_unit(const Args& a, unsigned char* ws, LAS unsigned char* lds, int p, int h, int tid, int wave, int lane, int k0 = 0, int k1 = 8) {
    const bf16* PROJ2 = (const bf16*)(ws + WS_H);
    bf16* MIX = (bf16*)(ws + WS_MIX);
    float* CS = (float*)(ws + WS_CS); float* PS = (float*)(ws + WS_PS);
    const bf16* WG = (const bf16*)(ws + WS_WGATE);
    LAS float* Y = (LAS float*)(lds + SC_Y);
    const int r32 = lane & 31, hi = lane >> 5;
    const int d = wave >> 2, cq = wave & 3;
    const int cabs = h * 128 + 32 * cq + r32;
    const int pseq0 = p < 64 ? (p & ~31) : p;
    const int seqlen = p < 64 ? SEQ : CTXL;
    const int pos0 = (p - pseq0) * 256;
    bf16x8 wfa[8], wfx[8];
    { const bf16* wa = WG + ((size_t)((d * 2 + 0) * 16 + h) * 128 + 32 * cq + r32) * 128 + 8 * hi;
      const bf16* wx = WG + ((size_t)((d * 2 + 1) * 16 + h) * 128 + 32 * cq + r32) * 128 + 8 * hi;
#pragma unroll
      for (int kk = 0; kk < 8; ++kk) { wfa[kk] = *(const bf16x8*)(wa + 16 * kk); wfx[kk] = *(const bf16x8*)(wx + 16 * kk); } }
    const float ba = a.in[I_RGBA][d * DM + cabs], bx = a.in[I_RGBX][d * DM + cabs];
    const float sp8 = 8.0f * log1pf(expf(-a.in[I_RGLAM][d * DM + cabs]));
    const int ct = tid >> 4, cc = (tid & 15) * 8;
    float cwv[4][8], cbv[8];
    { const float* cwp = a.in[I_RGCONVW] + h * 128 + cc; const float* cbp = a.in[I_RGCONVB] + h * 128 + cc;
#pragma unroll
      for (int kk = 0; kk < 4; ++kk) { const f32x4 w0 = *(const f32x4*)(cwp + kk * DM), w1 = *(const f32x4*)(cwp + kk * DM + 4);
          cwv[kk][0] = w0.x; cwv[kk][1] = w0.y; cwv[kk][2] = w0.z; cwv[kk][3] = w0.w; cwv[kk][4] = w1.x; cwv[kk][5] = w1.y; cwv[kk][6] = w1.z; cwv[kk][7] = w1.w; }
      const f32x4 b0 = *(const f32x4*)cbp, b1 = *(const f32x4*)(cbp + 4);
      cbv[0] = b0.x; cbv[1] = b0.y; cbv[2] = b0.z; cbv[3] = b0.w; cbv[4] = b1.x; cbv[5] = b1.y; cbv[6] = b1.z; cbv[7] = b1.w; }
    float cin[8];
    float PA = 1.0f, PH = 0.0f;
    if (PASS3) {
        const int b = p >> 5;
        float carry = 0.0f;
        { float ca[8], chh[8];
#pragma unroll
          for (int k = 0; k < 8; ++k) { ca[k] = CS[((size_t)(((64 + b) * 8 + k) * 2 + d) * 2 + 0) * DM + cabs]; chh[k] = CS[((size_t)(((64 + b) * 8 + k) * 2 + d) * 2 + 1) * DM + cabs]; }
#pragma unroll
          for (int k = 0; k < 8; ++k) { const int kk = d ? 7 - k : k; carry = ca[kk] * carry + chh[kk]; } }
        { const int nprev = d ? (32 * b + 31 - p) : (p - 32 * b);
          for (int q0 = 0; q0 < nprev; q0 += 8) { float pa[8], ph[8];
#pragma unroll
              for (int q = 0; q < 8; ++q) { const int qq = (q0 + q < nprev) ? q0 + q : q0; const int pp = d ? (32 * b + 31 - qq) : (32 * b + qq);
                  pa[q] = PS[((size_t)(pp * 2 + d) * 2 + 0) * DM + cabs]; ph[q] = PS[((size_t)(pp * 2 + d) * 2 + 1) * DM + cabs]; }
#pragma unroll
              for (int q = 0; q < 8; ++q) if (q0 + q < nprev) carry = pa[q] * carry + ph[q]; } }
        if (d == 0) { cin[0] = carry;
#pragma unroll
            for (int k = 0; k < 7; ++k) cin[k + 1] = CS[((size_t)((p * 8 + k) * 2 + 0) * 2 + 0) * DM + cabs] * cin[k] + CS[((size_t)((p * 8 + k) * 2 + 0) * 2 + 1) * DM + cabs]; }
        else { cin[7] = carry;
#pragma unroll
            for (int k = 7; k > 0; --k) cin[k - 1] = CS[((size_t)((p * 8 + k) * 2 + 1) * 2 + 0) * DM + cabs] * cin[k] + CS[((size_t)((p * 8 + k) * 2 + 1) * 2 + 1) * DM + cabs]; }
    }
    v4u un[4], gn = {0u, 0u, 0u, 0u};
#define SC_PREFETCH(k) do { const int pos_ = pos0 + 32 * (k) + ct; const size_t row_ = (size_t)p * 256 + 32 * (k) + ct; \
        _Pragma("unroll") for (int kk = 0; kk < 4; ++kk) { const int p2 = pos_ + kk - 2; \
            un[kk] = (p2 >= 0 && p2 < seqlen) ? *(const v4u*)(PROJ2 + (size_t)((ptrdiff_t)row_ + kk - 2) * RGW + 2048 + h * 128 + cc) : (v4u){0u, 0u, 0u, 0u}; } \
        if (PASS3) gn = *(const v4u*)(PROJ2 + row_ * RGW + h * 128 + cc); } while (0)
    SC_PREFETCH(k0);
    LDS_BAR();
#pragma unroll 1
    for (int k = k0; k < k1; ++k) {
        LAS unsigned char* ucb = lds + SC_UC0 + (k & 1) * SC_UC_BYTES;
        LAS float* UCF = (LAS float*)ucb;
        const v4u gcur = gn;
        { float acc[8];
#pragma unroll
          for (int j = 0; j < 8; ++j) acc[j] = cbv[j];
#pragma unroll
          for (int kk = 0; kk < 4; ++kk) {
              const unsigned uw[4] = {un[kk].x, un[kk].y, un[kk].z, un[kk].w};
#pragma unroll
              for (int i = 0; i < 4; ++i) { acc[2 * i] += cwv[kk][2 * i] * bf_lo(uw[i]); acc[2 * i + 1] += cwv[kk][2 * i + 1] * bf_hi(uw[i]); } }
          *(LAS f32x4*)(UCF + ct * UCF_STR + cc) = (f32x4){acc[0], acc[1], acc[2], acc[3]}; *(LAS f32x4*)(UCF + ct * UCF_STR + cc + 4) = (f32x4){acc[4], acc[5], acc[6], acc[7]};
          v4u o; o.x = cvtpk(acc[0], acc[1]); o.y = cvtpk(acc[2], acc[3]); o.z = cvtpk(acc[4], acc[5]); o.w = cvtpk(acc[6], acc[7]);
          *(LAS v4u*)(ucb + 32 * UCF_STR * 4 + ct * (KSTR * 2) + cc * 2) = o; }
        LDS_BAR();
        if (k + 1 < k1) SC_PREFETCH(k + 1);
        float ucv[16];
#pragma unroll
        for (int r = 0; r < 16; ++r) ucv[r] = UCF[crow(r, hi) * UCF_STR + 32 * cq + r32];
        asm volatile("" ::: "memory");
        f32x16 gr, gi;
#pragma unroll
        for (int r = 0; r < 16; ++r) { gr[r] = 0.f; gi[r] = 0.f; }
        { const LAS unsigned char* ub = ucb + 32 * UCF_STR * 4 + r32 * (KSTR * 2) + 16 * hi;
          bf16x8 af[8];
#pragma unroll
          for (int kk = 0; kk < 8; ++kk) af[kk] = *(const LAS bf16x8*)(ub + 32 * kk);
          asm volatile("" ::: "memory"); __builtin_amdgcn_sched_barrier(0);
#pragma unroll
          for (int kk = 0; kk < 8; ++kk) {
              gr = __builtin_amdgcn_mfma_f32_32x32x16_bf16(af[kk], wfa[kk], gr, 0, 0, 0);
              gi = __builtin_amdgcn_mfma_f32_32x32x16_bf16(af[kk], wfx[kk], gi, 0, 0, 0); } }
        float av[16], bv[16]; unsigned abw[16];
#pragma unroll
        for (int r = 0; r < 16; r += 2) {
            const f32x2 xr = (f32x2){gr[r], gr[r + 1]} + ba, xi = (f32x2){gi[r], gi[r + 1]} + bx;
            const f32x2 tr = xr * -1.4426950408889634f, ti = xi * -1.4426950408889634f;
            f32x2 er, ei; er.x = __builtin_amdgcn_exp2f(tr.x); er.y = __builtin_amdgcn_exp2f(tr.y); ei.x = __builtin_amdgcn_exp2f(ti.x); ei.y = __builtin_amdgcn_exp2f(ti.y);
            const f32x2 pr = er + 1.0f, pi = ei + 1.0f, P = pr * pi;
            f32x2 inv; inv.x = __builtin_amdgcn_rcpf(P.x); inv.y = __builtin_amdgcn_rcpf(P.y);
            const f32x2 rr = pi * inv, ii = pr * inv;
            const f32x2 la = rr * -sp8, l2u = la * 1.4426950408889634f;
            f32x2 a2; a2.x = __builtin_amdgcn_exp2f(l2u.x); a2.y = __builtin_amdgcn_exp2f(l2u.y);
            const f32x2 x = la * 2.0f;
            f32x2 pp = x * 0.2f + 1.0f; pp = (x * 0.25f) * pp + 1.0f; pp = (x * (1.0f / 3.0f)) * pp + 1.0f; pp = (x * 0.5f) * pp + 1.0f;
            const f32x2 ser = -x * pp, dir = 1.0f - a2 * a2;
            f32x2 m2; m2.x = la.x > -0.25f ? ser.x : dir.x; m2.y = la.y > -0.25f ? ser.y : dir.y;
            f32x2 mult; mult.x = __builtin_amdgcn_sqrtf(m2.x); mult.y = __builtin_amdgcn_sqrtf(m2.y);
            const f32x2 uc = (f32x2){ucv[r], ucv[r + 1]};
            const f32x2 bbu = mult * ii * uc;
            av[r] = a2.x; av[r + 1] = a2.y; bv[r] = bbu.x; bv[r + 1] = bbu.y;
        }
        float hv[16], At, Ht;
        if (!PASS3) {
            float pv[16];
            if (d == 0) lane_scan<false, true, true>(av, bv, hi, 0.0f, hv, At, Ht, pv); else lane_scan<true, true, true>(av, bv, hi, 0.0f, hv, At, Ht, pv);
            if (p < 64) {
#pragma unroll
                for (int r = 0; r < 16; ++r) { h2_t w; w.x = (_Float16)hv[r]; w.y = (_Float16)pv[r]; abw[r] = __builtin_bit_cast(unsigned, w); }
                unsigned* dst = (unsigned*)(ws + WS_ABH) + ((size_t)((p * 16 + h) * 8 + k) * 8 + wave) * (64 * 16) + lane * 4;
#pragma unroll
                for (int q = 0; q < 4; ++q) *(v4u*)(dst + 256 * q) = (v4u){abw[4 * q], abw[4 * q + 1], abw[4 * q + 2], abw[4 * q + 3]};
            }
            if (hi == 0) { CS[((size_t)((p * 8 + k) * 2 + d) * 2 + 0) * DM + cabs] = At; CS[((size_t)((p * 8 + k) * 2 + d) * 2 + 1) * DM + cabs] = Ht; }
            if (d == 0) { PH = At * PH + Ht; PA *= At; } else { PH = PA * Ht + PH; PA *= At; }
        } else {
            float c0 = cin[0];
#pragma unroll
            for (int j = 1; j < 8; ++j) c0 = (k == j) ? cin[j] : c0;
            if (d == 0) lane_scan<false, true>(av, bv, hi, c0, hv, At, Ht); else lane_scan<true, true>(av, bv, hi, c0, hv, At, Ht);
#pragma unroll
            for (int r = 0; r < 16; ++r) Y[(d * 32 + crow(r, hi)) * 128 + 32 * cq + r32] = hv[r];
            LDS_BAR();
            const size_t row = (size_t)p * 256 + 32 * k + ct;
            const f32x4 y0 = *(const LAS f32x4*)(Y + ct * 128 + cc) + *(const LAS f32x4*)(Y + (32 + ct) * 128 + cc);
            const f32x4 y1 = *(const LAS f32x4*)(Y + ct * 128 + cc + 4) + *(const LAS f32x4*)(Y + (32 + ct) * 128 + cc + 4);
            v4u o;
            o.x = cvtpk(y0.x * gelu_tanh_f(bf_lo(gcur.x)), y0.y * gelu_tanh_f(bf_hi(gcur.x))); o.y = cvtpk(y0.z * gelu_tanh_f(bf_lo(gcur.y)), y0.w * gelu_tanh_f(bf_hi(gcur.y)));
            o.z = cvtpk(y1.x * gelu_tanh_f(bf_lo(gcur.z)), y1.y * gelu_tanh_f(bf_hi(gcur.z))); o.w = cvtpk(y1.z * gelu_tanh_f(bf_lo(gcur.w)), y1.w * gelu_tanh_f(bf_hi(gcur.w)));
            *(v4u*)(MIX + row * DM + h * 128 + cc) = o;
        }
    }
#undef SC_PREFETCH
    if (!PASS3 && hi == 0 && k1 - k0 == 8) { PS[((size_t)(p * 2 + d) * 2 + 0) * DM + cabs] = PA; PS[((size_t)(p * 2 + d) * 2 + 1) * DM + cabs] = PH; }
}

template <int NU>
__device__ __forceinline__ void scan_carry(const float* __restrict__ CS, const float* __restrict__ PS, const int (&pp)[NU], int d, int cabs, float (&cin)[NU][8]) {
    float carry[NU]; int nprev[NU], nmax = 0;
#pragma unroll
    for (int u = 0; u < NU; ++u) { const int b = pp[u] >> 5; float ca[8], chh[8];
#pragma unroll
        for (int k = 0; k < 8; ++k) { ca[k] = CS[((size_t)(((64 + b) * 8 + k) * 2 + d) * 2 + 0) * DM + cabs]; chh[k] = CS[((size_t)(((64 + b) * 8 + k) * 2 + d) * 2 + 1) * DM + cabs]; }
        float c = 0.0f;
#pragma unroll
        for (int k = 0; k < 8; ++k) { const int kk = d ? 7 - k : k; c = ca[kk] * c + chh[kk]; }
        carry[u] = c; nprev[u] = d ? (32 * b + 31 - pp[u]) : (pp[u] - 32 * b); nmax = nprev[u] > nmax ? nprev[u] : nmax; }
    for (int q0 = 0; q0 < nmax; q0 += 8) {
        float pa[NU][8], ph[NU][8];
#pragma unroll
        for (int u = 0; u < NU; ++u) { const int b = pp[u] >> 5;
#pragma unroll
            for (int q = 0; q < 8; ++q) { const int qq = (q0 + q < nprev[u]) ? q0 + q : 0; const int pq = d ? (32 * b + 31 - qq) : (32 * b + qq);
                pa[u][q] = PS[((size_t)(pq * 2 + d) * 2 + 0) * DM + cabs]; ph[u][q] = PS[((size_t)(pq * 2 + d) * 2 + 1) * DM + cabs]; } }
#pragma unroll
        for (int u = 0; u < NU; ++u)
#pragma unroll
            for (int q = 0; q < 8; ++q) if (q0 + q < nprev[u]) carry[u] = pa[u][q] * carry[u] + ph[u][q];
    }
#pragma unroll
    for (int u = 0; u < NU; ++u) { const int p = pp[u]; float cj[8];
        float c = carry[u];
#pragma unroll
        for (int j = 0; j < 8; ++j) { const int k = d ? 7 - j : j; cj[j] = c;
            if (j < 7) c = CS[((size_t)((p * 8 + k) * 2 + d) * 2 + 0) * DM + cabs] * c + CS[((size_t)((p * 8 + k) * 2 + d) * 2 + 1) * DM + cabs]; }
#pragma unroll
        for (int k = 0; k < 8; ++k) cin[u][k] = d ? cj[7 - k] : cj[k]; }
}

__device__ __forceinline__ void scan_carry4(const float* __restrict__ CS, const float* __restrict__ PS, const int (&pp)[4], int d, int cabs, float (&cin)[4][8]) {
    float carry[4] = {0.f, 0.f, 0.f, 0.f};
    float cg[2]; int n0[2], n1[2]; const float* pb[2];
    { float ca[2][8], chh[2][8];
#pragma unroll
      for (int g = 0; g < 2; ++g) { const int b = pp[2 * g] >> 5;
#pragma unroll
          for (int k = 0; k < 8; ++k) { ca[g][k] = CS[((size_t)(((64 + b) * 8 + k) * 2 + d) * 2 + 0) * DM + cabs]; chh[g][k] = CS[((size_t)(((64 + b) * 8 + k) * 2 + d) * 2 + 1) * DM + cabs]; } }
#pragma unroll
      for (int g = 0; g < 2; ++g) { const int b = pp[2 * g] >> 5; float c = 0.0f;
#pragma unroll
          for (int k = 0; k < 8; ++k) { const int kk = d ? 7 - k : k; c = ca[g][kk] * c + chh[g][kk]; }
          cg[g] = c;
          n0[g] = d ? (32 * b + 31 - pp[2 * g]) : (pp[2 * g] - 32 * b); n1[g] = d ? (32 * b + 31 - pp[2 * g + 1]) : (pp[2 * g + 1] - 32 * b);
          pb[g] = PS + ((size_t)((d ? 32 * b + 31 : 32 * b) * 2 + d) * 2) * DM + cabs; } }
    const ptrdiff_t st = d ? -(ptrdiff_t)(4 * DM) : (ptrdiff_t)(4 * DM);
#pragma unroll 1
    for (int q0 = 0; q0 < 32; q0 += 16) {
        float pa[2][16], ph[2][16];
#pragma unroll
        for (int g = 0; g < 2; ++g)
#pragma unroll
            for (int q = 0; q < 16; ++q) { const float* pq = pb[g] + (ptrdiff_t)(q0 + q) * st; pa[g][q] = pq[0]; ph[g][q] = pq[DM]; }
#pragma unroll
        for (int g = 0; g < 2; ++g)
#pragma unroll
            for (int q = 0; q < 16; ++q) { carry[2 * g] = (q0 + q == n0[g]) ? cg[g] : carry[2 * g]; carry[2 * g + 1] = (q0 + q == n1[g]) ? cg[g] : carry[2 * g + 1]; cg[g] = pa[g][q] * cg[g] + ph[g][q]; }
    }
#pragma unroll
    for (int u = 0; u < 4; ++u) { const int p = pp[u]; float cj[8];
        float c = carry[u];
#pragma unroll
        for (int j = 0; j < 8; ++j) { const int k = d ? 7 - j : j; cj[j] = c;
            if (j < 7) c = CS[((size_t)((p * 8 + k) * 2 + d) * 2 + 0) * DM + cabs] * c + CS[((size_t)((p * 8 + k) * 2 + d) * 2 + 1) * DM + cabs]; }
#pragma unroll
        for (int k = 0; k < 8; ++k) cin[u][k] = d ? cj[7 - k] : cj[k]; }
}

__device__ __forceinline__ void sa_prefetch_pair(unsigned char* ws, int p, int h, int k, int tid, int wave, int lane, v4u (&ab0)[4], v4u (&ab1)[4], v4u& g0, v4u& g1) {
    const bf16* PROJ2 = (const bf16*)(ws + WS_H);
    const int ct = tid >> 4, cc = (tid & 15) * 8;
    const unsigned* s0 = (const unsigned*)(ws + WS_ABH) + ((size_t)((p * 16 + h) * 8 + k) * 8 + wave) * (64 * 16) + lane * 4;
#pragma unroll
    for (int q = 0; q < 4; ++q) { ab0[q] = *(const v4u*)(s0 + 256 * q); ab1[q] = *(const v4u*)(s0 + 8 * 64 * 16 + 256 * q); }
    g0 = *(const v4u*)(PROJ2 + ((size_t)p * 256 + 32 * k + ct) * RGW + h * 128 + cc);
    g1 = *(const v4u*)(PROJ2 + ((size_t)p * 256 + 32 * (k + 1) + ct) * RGW + h * 128 + cc);
}

constexpr int SA_Y = 0;
static_assert(SA_Y + 2 * 4 * 32 * 128 * 4 <= RING_BYTES, "scan pass 3 LDS map");
__device__ __forceinline__ void scan_apply_unit(const Args& a, unsigned char* ws, LAS unsigned char* lds, int p, int h, int tid, int wave, int lane,
                                                float ci0, float ci1, float ci2, float ci3, float ci4, float ci5, float ci6, float ci7,
                                                v4u (&ab0)[4], v4u (&ab1)[4], v4u& g0, v4u& g1, int pnext, int hnext) {
    const float cin[8] = {ci0, ci1, ci2, ci3, ci4, ci5, ci6, ci7};
    const bf16* PROJ2 = (const bf16*)(ws + WS_H);
    bf16* MIX = (bf16*)(ws + WS_MIX);
    const int r32 = lane & 31, hi = lane >> 5;
    const int d = wave >> 2, cq = wave & 3;
    const int ct = tid >> 4, cc = (tid & 15) * 8;
    const unsigned* abase = (const unsigned*)(ws + WS_ABH) + ((size_t)((p * 16 + h) * 8) * 8 + wave) * (64 * 16) + lane * 4;
#define SA_PREFETCH(AB, GG, k) do { const unsigned* s_ = abase + (size_t)(k) * (8 * 64 * 16); \
        _Pragma("unroll") for (int q = 0; q < 4; ++q) AB[q] = *(const v4u*)(s_ + 256 * q); \
        GG = *(const v4u*)(PROJ2 + ((size_t)p * 256 + 32 * (k) + ct) * RGW + h * 128 + cc); } while (0)
#define SA_UNPACK(AB, HV, CI) do { _Pragma("unroll") for (int q = 0; q < 4; ++q) { const unsigned w[4] = {AB[q].x, AB[q].y, AB[q].z, AB[q].w}; \
        _Pragma("unroll") for (int e = 0; e < 4; ++e) { const h2_t hv2 = __builtin_bit_cast(h2_t, w[e]); HV[4 * q + e] = (float)hv2.x + (float)hv2.y * (CI); } } } while (0)
#define SA_EMIT(YB, GC, k) do { const size_t row = (size_t)p * 256 + 32 * (k) + ct; \
        const f32x4 y0 = *(const LAS f32x4*)(YB + ct * 128 + cc) + *(const LAS f32x4*)(YB + (32 + ct) * 128 + cc); \
        const f32x4 y1 = *(const LAS f32x4*)(YB + ct * 128 + cc + 4) + *(const LAS f32x4*)(YB + (32 + ct) * 128 + cc + 4); \
        v4u o; \
        o.x = cvtpk(y0.x * gelu_tanh_f(bf_lo(GC.x)), y0.y * gelu_tanh_f(bf_hi(GC.x))); o.y = cvtpk(y0.z * gelu_tanh_f(bf_lo(GC.y)), y0.w * gelu_tanh_f(bf_hi(GC.y))); \
        o.z = cvtpk(y1.x * gelu_tanh_f(bf_lo(GC.z)), y1.y * gelu_tanh_f(bf_hi(GC.z))); o.w = cvtpk(y1.z * gelu_tanh_f(bf_lo(GC.w)), y1.w * gelu_tanh_f(bf_hi(GC.w))); \
        *(v4u*)(MIX + row * DM + h * 128 + cc) = o; } while (0)
    LDS_BAR();
#pragma unroll 1
    for (int k = 0; k < 8; k += 2) {
        LAS float* Y0 = (LAS float*)(lds + SA_Y + ((k >> 1) & 1) * (4 * 32 * 128 * 4));
        LAS float* Y1 = Y0 + 2 * 32 * 128;
        const v4u gc0 = g0, gc1 = g1;
        float c0 = cin[0], c1 = cin[1];
#pragma unroll
        for (int j = 2; j < 8; j += 2) { c0 = (k == j) ? cin[j] : c0; c1 = (k == j) ? cin[j + 1] : c1; }
        float hv0[16], hv1[16];
        SA_UNPACK(ab0, hv0, c0); SA_UNPACK(ab1, hv1, c1);
        if (k + 2 < 8) { SA_PREFETCH(ab0, g0, k + 2); SA_PREFETCH(ab1, g1, k + 3); }
        else if (pnext >= 0) sa_prefetch_pair(ws, pnext, hnext, 0, tid, wave, lane, ab0, ab1, g0, g1);
#pragma unroll
        for (int r = 0; r < 16; ++r) { Y0[(d * 32 + crow(r, hi)) * 128 + 32 * cq + r32] = hv0[r]; Y1[(d * 32 + crow(r, hi)) * 128 + 32 * cq + r32] = hv1[r]; }
        LDS_BAR();
        SA_EMIT(Y0, gc0, k); SA_EMIT(Y1, gc1, k + 1);
    }
#undef SA_UNPACK
#undef SA_EMIT
#undef SA_PREFETCH
}

#ifndef MK_ONE_LAUNCH
#define MK_ONE_LAUNCH 1
#endif
constexpr int N_PHASES = 23;
#define C8(x) x[0], x[1], x[2], x[3], x[4], x[5], x[6], x[7]
#ifndef PG8_SP2
#define PG8_SP2 true
#endif
#ifndef REP_THIN
#define REP_THIN 1
#endif
#ifndef REP_UP
#define REP_UP 1
#endif
#ifndef REP_DOWN
#define REP_DOWN 1
#endif
#ifndef REP_P0
#define REP_P0 REP_THIN
#endif
#ifndef REP_NORM
#define REP_NORM REP_THIN
#endif
#ifndef REP_AT
#define REP_AT 1
#endif
#ifndef REP_CONV
#define REP_CONV 1
#endif
#ifndef REP_ATTN
#define REP_ATTN REP_THIN
#endif
#ifndef REP_SCAN
#define REP_SCAN REP_THIN
#endif
#ifndef REP_SCAN1
#define REP_SCAN1 REP_SCAN
#endif
#define RT_(n) _Pragma("unroll 1") for (int rt_ = 0; rt_ < (n); ++rt_)
#define RU_
#ifndef EXP_THR_PHASE
#define EXP_THR_PHASE -1
#endif
#ifndef EXP_CLK_PHASE
#define EXP_CLK_PHASE -1
#endif
#ifndef TLB_TOUCH_PHASE
#define TLB_TOUCH_PHASE -1
#endif
#ifndef REP_UP_PHASE
#define REP_UP_PHASE -1
#endif
#ifdef DIS_NORM
#define final_norm_phase(...) do {} while (0)
#endif
__device__ __forceinline__ void tlb_touch(const void* p, size_t bytes, int G, int bid, int tid) {
    const size_t id = (size_t)(bid >> 3) * NTHR + tid, n = (size_t)(G >> 3) * NTHR, np = bytes >> 12;
    unsigned acc = 0;
    for (size_t i = id; i < np; i += n) acc += __builtin_nontemporal_load((const unsigned*)((const char*)p + (i << 12)));
    asm volatile("" :: "v"(acc));
}
template <class Epi, class Sched> __device__ __forceinline__ void run_gemm(LAS unsigned char* lds, const bf16* A, const bf16* Bt, int M, int N, int K, int G, int bid, const Epi& E, int slow = -1) {
    pg8::Gemm g{A, Bt, K, 128, 128}; Sched S; S.init(G, bid, slow); pg8::gemm_phase<Epi, Sched, true, PG8_SP2>(lds, g, S, E);
}
template <class Epi, class Sched> __device__ __forceinline__ void run_gemm_kt(LAS unsigned char* lds, const bf16* A, const bf16* Bt, int M, int N, int G, int bid, const Epi& E, int slow = -1, int thr = 0) {
    pg8::Gemm g{A, Bt, 0, (size_t)M * 128, (size_t)N * 128, thr}; Sched S; S.init(G, bid, slow); pg8::gemm_phase<Epi, Sched, true, PG8_SP2>(lds, g, S, E);
}
__global__ void __launch_bounds__(NTHR, 2) fwd_kernel(Args args) {
    extern __shared__ __attribute__((aligned(16))) unsigned char lds_raw[];
    LAS unsigned char* lds = (LAS unsigned char*)lds_raw;
    volatile LAS unsigned* MISC = (volatile LAS unsigned*)(lds + MISC_OFF);
    const int tid = threadIdx.x, lane = tid & 63, wave = __builtin_amdgcn_readfirstlane(tid >> 6);
    const int G = gridDim.x, bid = blockIdx.x;
    unsigned char* ws = args.ws;
    for (int u = tid; u < (LDS_BYTES - LDSCTL_OFF) / 4; u += NTHR) ((LAS unsigned*)(lds + LDSCTL_OFF))[u] = 0u;
    __syncthreads();
    const int lo = args.ph_lo, hi = args.ph_hi;
    XcdBarrier bar; bar.bar = (unsigned*)(ws + WS_CTL) + CW_BAR; bar.x = 0; bar.st = nullptr;
    if (hi - lo > 1) bar = xcd_barrier_post((unsigned*)(ws + WS_CTL) + CW_BAR, MISC + 8);
#define IN(k) (lo <= (k) && (k) < hi)
#ifndef REP_BAR
#define REP_BAR 1
#endif
#if defined(PROBE_WAIT)
#ifndef PROBE_GRP
#define PROBE_GRP 0
#endif
#ifndef PROBE_PHASE
#define PROBE_PHASE 1000
#endif
#ifndef PROBE_CUM
#define PROBE_CUM 0
#endif
#ifndef PROBE_BASE
#define PROBE_BASE 0
#endif
#ifndef PROBE_SCALE
#define PROBE_SCALE 0.1f
#endif
#define SEAM(k) do { if (IN(k) && IN((k) + 1)) { if ((k) == 2) CALIBRATE_ARRIVE(); const unsigned long long t0_ = __builtin_amdgcn_s_memrealtime(); xcd_barrier(bar); \
        if (tid == 0 && ((PROBE_WAIT >> (k)) & 1)) { const unsigned long long dt_ = __builtin_amdgcn_s_memrealtime() - t0_; atomicAdd((unsigned long long*)(ws + WS_CTL) + 4000, dt_); \
            atomicAdd((unsigned long long*)(ws + WS_CTL) + 4010 + 2 * (PROBE_GRP ? (bid & 7) : xb_xcc_id()), dt_); atomicAdd((unsigned long long*)(ws + WS_CTL) + 4011 + 2 * (PROBE_GRP ? (bid & 7) : xb_xcc_id()), 1ull); } if ((k) == 2) CALIBRATE_DECIDE(); \
        if (bid == 0 && tid == 0) { if ((k) == PROBE_PHASE - 1 && !PROBE_CUM) *((unsigned long long*)(ws + WS_CTL) + 4100) = __builtin_amdgcn_s_memrealtime(); if ((k) == PROBE_PHASE) *((unsigned long long*)(ws + WS_CTL) + 4101) = __builtin_amdgcn_s_memrealtime(); } } } while (0)
#else
#define SEAM(k) do { if (IN(k) && IN((k) + 1)) { if ((k) == 2) CALIBRATE_ARRIVE(); _Pragma("unroll 1") for (int rb_ = 0; rb_ < REP_BAR; ++rb_) xcd_barrier(bar); if ((k) == 2) CALIBRATE_DECIDE(); } } while (0)
#endif
#if !defined(USE_ADAPT)
#define NO_ADAPT_HOOK slow = -1;
#else
#define NO_ADAPT_HOOK
#endif
#if defined(USE_ADAPT)
#define CALIBRATE_ARRIVE() do { if (G == 256 && tid == 0) __hip_atomic_store((unsigned long long*)(ws + WS_CTL) + 8192 + bid, (unsigned long long)__builtin_amdgcn_s_memrealtime(), __ATOMIC_RELAXED, __HIP_MEMORY_SCOPE_AGENT); } while (0)
#define CALIBRATE_DECIDE() do { if (G == 256) { if (wave == 0) { const unsigned long long* T_ = (const unsigned long long*)(ws + WS_CTL) + 8192; const unsigned long long b_ = T_[0]; \
            long long v_ = (long long)(T_[lane] - b_) + (long long)(T_[lane + 64] - b_) + (long long)(T_[lane + 128] - b_) + (long long)(T_[lane + 192] - b_); \
            v_ += __shfl_xor(v_, 8); v_ += __shfl_xor(v_, 16); v_ += __shfl_xor(v_, 32); int i_ = lane & 7; \
            _Pragma("unroll") for (int o_ = 1; o_ < 8; o_ <<= 1) { const long long ov_ = __shfl_xor(v_, o_); const int oi_ = __shfl_xor(i_, o_); if (ov_ > v_ || (ov_ == v_ && oi_ < i_)) { v_ = ov_; i_ = oi_; } } \
            const long long tot_ = v_  ; long long all_ = (long long)(T_[lane] - b_) + (long long)(T_[lane + 64] - b_) + (long long)(T_[lane + 128] - b_) + (long long)(T_[lane + 192] - b_); \
            all_ += __shfl_xor(all_, 1); all_ += __shfl_xor(all_, 2); all_ += __shfl_xor(all_, 4); all_ += __shfl_xor(all_, 8); all_ += __shfl_xor(all_, 16); all_ += __shfl_xor(all_, 32); \
              \
            const bool sig_ = (tot_ * 7 - (all_ - tot_)) > 800LL * 224; \
            if (lane == 0) MISC[16] = sig_ ? (unsigned)(i_ + 1) : 0u; } \
        __syncthreads(); slow = __builtin_amdgcn_readfirstlane((int)MISC[16]) - 1; __syncthreads(); NO_ADAPT_HOOK } } while (0)
#else
#define CALIBRATE_ARRIVE() do {} while (0)
#define CALIBRATE_DECIDE() do {} while (0)
#endif
    const int gw = bid * NWAVES + wave, ngw = G * NWAVES, gwalt = wave * G + bid;
    float* MOD = (float*)(ws + WS_MOD);
    bf16* X = (bf16*)(ws + WS_X);
    bf16* XN = (bf16*)(ws + WS_XN);
    bf16* HB = (bf16*)(ws + WS_H);
    bf16* MIX = (bf16*)(ws + WS_MIX);
    float* SLAB = (float*)(ws + WS_SLAB);

#if defined(PROBE_WAIT)
    if ((PROBE_PHASE == 0 || PROBE_PHASE == 23 || PROBE_CUM) && bid == 0 && tid == 0) *((unsigned long long*)(ws + WS_CTL) + 4100) = __builtin_amdgcn_s_memrealtime();
#if defined(EXP_SLEEP_US)
    { const unsigned long long t0_ = __builtin_amdgcn_s_memrealtime(); while (__builtin_amdgcn_s_memrealtime() - t0_ < (unsigned long long)(EXP_SLEEP_US) * 100ull) __builtin_amdgcn_s_sleep(100); }
#endif
#if defined(EXP_STREAM_US)
    { const unsigned long long t0_ = __builtin_amdgcn_s_memrealtime(); unsigned sacc_ = 0; size_t so_ = ((size_t)bid * NTHR + tid) * 16;
      while (__builtin_amdgcn_s_memrealtime() - t0_ < (unsigned long long)(EXP_STREAM_US) * 100ull) {
#pragma unroll
          for (int i = 0; i < 8; ++i) { const v4u v_ = __builtin_nontemporal_load((const v4u*)(ws + WS_H + so_)); sacc_ += v_.x ^ v_.w; so_ += (size_t)G * NTHR * 16; if (so_ >= (size_t)512 * MiB) so_ -= (size_t)512 * MiB; } }
      asm volatile("" :: "v"(sacc_)); }
#endif
#if defined(EXP_HEAT_US)
    { const unsigned long long t0_ = __builtin_amdgcn_s_memrealtime(); f32x16 hacc_; for (int r = 0; r < 16; ++r) hacc_[r] = 0.f;
      v4u ha_ = {0x3f803f80u + tid * 0x10001u, 0xbf80bf80u ^ (tid * 77u), 0x3e803e80u + lane, 0xbe80be80u}, hb_ = {0x3f003f00u + lane * 3u, 0xbf00bf00u, 0x3f803f80u ^ tid, 0x3e003e00u};
      while (__builtin_amdgcn_s_memrealtime() - t0_ < (unsigned long long)(EXP_HEAT_US) * 100ull) {
#pragma unroll
          for (int i = 0; i < 32; ++i) hacc_ = __builtin_amdgcn_mfma_f32_32x32x16_bf16(__builtin_bit_cast(bf16x8, ha_), __builtin_bit_cast(bf16x8, hb_), hacc_, 0, 0, 0); }
      if (hacc_[0] == 12345.678f && hacc_[5] == 3.0f) args.out[1] = hacc_[0]; }
#endif
#if defined(PROBE_WARM)
    unsigned warm_ = 0; if (bid == 0 && tid == 0) warm_ = __hip_atomic_load((unsigned*)(ws + WS_ROPE + 262144), __ATOMIC_RELAXED, __HIP_MEMORY_SCOPE_AGENT);
#endif
#endif
    int slow = -1;
#ifndef DIS_P0
    if (IN(0)) RT_(REP_P0) { p0_prologue(args, ws, lds, G, bid, tid, wave, lane); }
#endif
    SEAM(0);

#define FILL_TAIL(nbusy, a0, a1, b0, b1) do { const int rk_ = pg8::xrank(bid, slow);     \
        if (rk_ >= (nbusy) && rk_ < 0x3fffffff) convert_ranges(args, ws, lds, a0, a1, b0, b1, (rk_ - (nbusy)) * NWAVES + wave, ((slow < 0 ? G : G - G / 8) - (nbusy)) * NWAVES, wave, lane); } while (0)
#define FFN_BLOCK(MP, s, base, nslab_in, FILL) do { \
        const int l_ = (s) >> 1, which_ = (s) & 1; \
        const float* modl_ = MOD + (size_t)l_ * 3 * MODW; \
        if (IN(base)) RT_(REP_NORM) { const float* g_ = (which_ ? args.in[I_NF2] : args.in[I_NF1]) + (size_t)l_ * DM; \
            if ((s) == 0) norm_phase<true, true>(args.in[I_X], args.in[I_CTX], (MP) * 256, g_, modl_ + (which_ ? 6 : 0) * DM, modl_ + (which_ ? 7 : 1) * DM, XN, gw, ngw, lane, gwalt, SLAB, nslab_in, X + (size_t)NLAT * DM, lds); \
            else norm_phase<false, false>(X, X + (size_t)NLAT * DM, (MP) * 256, g_, modl_ + (which_ ? 6 : 0) * DM, modl_ + (which_ ? 7 : 1) * DM, XN, gw, ngw, lane, gwalt, SLAB, nslab_in, X + (size_t)NLAT * DM, lds); } \
        SEAM(base); \
        if (IN((base) + 1)) RU_ { pg8::EpiSwiGLU E_{HB, MROWS}; \
            if (EXP_CLK_PHASE == (base) + 1) { const unsigned long long t0_ = __builtin_amdgcn_s_memrealtime(); f32x16 hacc_; for (int r = 0; r < 16; ++r) hacc_[r] = 0.f; \
                v4u ha_ = {0x3f803f80u + tid * 0x10001u, 0xbf80bf80u ^ (tid * 77u), 0x3e803e80u + lane, 0xbe80be80u}, hb_ = {0x3f003f00u + lane * 3u, 0xbf00bf00u, 0x3f803f80u ^ tid, 0x3e003e00u}; \
                _Pragma("unroll 1") for (int i_ = 0; i_ < 100; ++i_) { _Pragma("unroll") for (int j_ = 0; j_ < 32; ++j_) hacc_ = __builtin_amdgcn_mfma_f32_32x32x16_bf16(__builtin_bit_cast(bf16x8, ha_), __builtin_bit_cast(bf16x8, hb_), hacc_, 0, 0, 0); } \
                if (hacc_[0] == 12345.678f && hacc_[5] == 3.0f) args.out[1] = hacc_[0]; \
                if (bid == 0 && tid == 0) *((unsigned long long*)(ws + WS_CTL) + 4102) = __builtin_amdgcn_s_memrealtime() - t0_; } \
            if (TLB_TOUCH_PHASE == (base) + 1 || TLB_TOUCH_PHASE == -2) { tlb_touch(ws + WS_WIN + (size_t)(s) * WIN_BYTES, WIN_BYTES, G, bid, tid); tlb_touch(XN, (size_t)MROWS * DM * 2, G, bid, tid); tlb_touch(HB, (size_t)MROWS * DFF * 2, G, bid, tid); } \
            run_gemm_kt<pg8::EpiSwiGLU, pg8::StaticOrderC<MP, 44, 32>>(lds + RING_OFF, XN, (const bf16*)(ws + WS_WIN + (size_t)(s) * WIN_BYTES), MROWS, 2 * DFF, G, bid, E_, slow, ((base) + 1 == EXP_THR_PHASE) ? 1 : 0); \
            if (REP_UP > 1 && (REP_UP_PHASE < 0 || (base) + 1 == REP_UP_PHASE)) run_gemm_kt<pg8::EpiSwiGLU, pg8::StaticOrderC<MP, 44, 32>>(lds + RING_OFF, XN, (const bf16*)(ws + WS_WIN + (size_t)(s) * WIN_BYTES), MROWS, 2 * DFF, G, bid, E_, slow); \
            FILL; } \
        SEAM((base) + 1); \
        if (IN((base) + 2)) { pg8::EpiResid E_{((s) == 0) ? args.in[I_X] : nullptr, ((s) == 0) ? args.in[I_CTX] : nullptr, X, modl_ + (which_ ? 8 : 2) * DM, MODW, 0.5f, SLAB}; \
            if ((MP) == 66) run_gemm_kt<pg8::EpiResid, pg8::SplitCtxOrder<8, 88>>(lds + RING_OFF, HB, (const bf16*)(ws + WS_WOUT + (size_t)(s) * WOUT_BYTES), MROWS, DM, G, bid, E_, slow); \
            else run_gemm_kt<pg8::EpiResid, pg8::StaticOrderC<64, 8, 88, 4>>(lds + RING_OFF, HB, (const bf16*)(ws + WS_WOUT + (size_t)(s) * WOUT_BYTES), MROWS, DM, G, bid, E_, slow); \
            if (REP_DOWN == 2) { pg8::EpiResid E2_{nullptr, nullptr, X, modl_ + (which_ ? 8 : 2) * DM, MODW, 0.0f, SLAB}; \
                run_gemm_kt<pg8::EpiResid, pg8::StaticOrderC<64, 8, 88, 4>>(lds + RING_OFF, HB, (const bf16*)(ws + WS_WOUT + (size_t)(s) * WOUT_BYTES), MROWS, DM, G, bid, E2_, slow); } \
            if (REP_DOWN == 3) { pg8::EpiNull E3_{}; \
                run_gemm_kt<pg8::EpiNull, pg8::StaticOrderC<64, 8, 88, 4>>(lds + RING_OFF, HB, (const bf16*)(ws + WS_WOUT + (size_t)(s) * WOUT_BYTES), MROWS, DM, G, bid, E3_, slow); } } \
        SEAM((base) + 2); \
    } while (0)

    FFN_BLOCK(66, 0, 1, 0, do { FILL_TAIL(88, TL_WOUT, TL_WOUT + T_WOUT, TL_ABIN, TL_ABOUT + T_SQ); __syncthreads(); if (bid >= 88) mod_gemv_tasks(args, ws, lds, 144, 288, bid - 88, G - 88, tid, wave, lane); } while (0));
    { const float* modl = MOD;
            if (IN(4)) RT_(REP_NORM) norm_phase<false, true>(X, args.in[I_CTX], MROWS, args.in[I_NMIX], modl + 3 * DM, modl + 4 * DM, XN, gw, ngw, lane, gwalt, SLAB, 11, X + (size_t)NLAT * DM, lds);
            SEAM(4);
            if (IN(5)) RU_ { pg8::EpiBf16 E{HB, ABW};
                run_gemm_kt<pg8::EpiBf16, pg8::StaticOrderC<66, 18, 32>>(lds + RING_OFF, XN, (const bf16*)(ws + WS_WABIN), MROWS, ABW, G, bid, E, slow);
                if (REP_UP > 1) run_gemm_kt<pg8::EpiBf16, pg8::StaticOrderC<66, 18, 32>>(lds + RING_OFF, XN, (const bf16*)(ws + WS_WABIN), MROWS, ABW, G, bid, E, slow);
                FILL_TAIL(164, TL_WIN + T_WIN, TL_WIN + 2 * T_WIN, 0, 0); }
            SEAM(5);
            if (IN(6)) RT_(REP_ATTN) {
                const float* ropeC = (const float*)(ws + WS_ROPE); const float* ropeS = ropeC + 4096;
#ifndef DIS_ATTN
                RT_(REP_AT) for (int u = bid; u < 528; u += G) attn_unit(HB, MIX, args.in[I_SINK], ropeC, ropeS, lds, u, tid, wave, lane);
#endif
                RT_(REP_CONV) { if (G > 32) { if (bid >= 16) sconv_strips(HB, MIX, args.in[I_ABCONV], (bid - 16) * NTHR + tid, (G - 16) * NTHR); }
                else sconv_strips(HB, MIX, args.in[I_ABCONV], bid * NTHR + tid, G * NTHR); }
            }
            SEAM(6);
            if (IN(7)) { pg8::EpiResid E{nullptr, nullptr, X, modl + 5 * DM, MODW, 1.0f, SLAB};
                run_gemm<pg8::EpiResid, pg8::SplitCtxOrder<8, 32>>(lds + RING_OFF, MIX, (const bf16*)(ws + WS_WABOUT), MROWS, DM, DM, G, bid, E, slow); }
            SEAM(7);
    }
    FFN_BLOCK(66, 1, 8, 8, FILL_TAIL(88, TL_WOUT + T_WOUT, TL_WOUT + 2 * T_WOUT, TL_WIN + 2 * T_WIN, TL_WIN + 3 * T_WIN));
    FFN_BLOCK(66, 2, 11, 11, FILL_TAIL(88, TL_WOUT + 2 * T_WOUT, TL_WOUT + 3 * T_WOUT, TL_RGIN, T_TOTAL));
    { const float* modl = MOD + (size_t)3 * MODW;
            if (IN(14)) RT_(REP_NORM) norm_phase<false, false>(X, X + (size_t)NLAT * DM, MROWS, args.in[I_NMIX] + DM, modl + 3 * DM, modl + 4 * DM, XN, gw, ngw, lane, gwalt, SLAB, 11, X + (size_t)NLAT * DM, lds);
            SEAM(14);
            if (IN(15)) RU_ { pg8::EpiBf16 E{HB, RGW};
                run_gemm_kt<pg8::EpiBf16, pg8::StaticOrderC<66, 16, 32>>(lds + RING_OFF, XN, (const bf16*)(ws + WS_WRGIN), MROWS, RGW, G, bid, E, slow);
                if (REP_UP > 1) run_gemm_kt<pg8::EpiBf16, pg8::StaticOrderC<66, 16, 32>>(lds + RING_OFF, XN, (const bf16*)(ws + WS_WRGIN), MROWS, RGW, G, bid, E, slow);
                FILL_TAIL(32, TL_WIN + 3 * T_WIN, TL_WIN + 4 * T_WIN, TL_WOUT + 3 * T_WOUT, TL_WOUT + 4 * T_WOUT); }
            SEAM(15);
#ifndef DIS_SCAN
            if (IN(16)) RT_(REP_SCAN1) { for (int u = bid; u < 64 * 16 + 128; u += G) { if (u < 1024) scan_unit<false>(args, ws, lds, u >> 4, u & 15, tid, wave, lane);
                    else { const int v = u - 1024; scan_unit<false>(args, ws, lds, 64 + (v >> 6), (v >> 2) & 15, tid, wave, lane, 2 * (v & 3), 2 * (v & 3) + 2); } } }
            SEAM(16);
            if (IN(17)) RT_(REP_SCAN) { { const float* CSp = (const float*)(ws + WS_CS); const float* PSp = (const float*)(ws + WS_PS);
                    const int sd_ = wave >> 2, scabs_ = 32 * (wave & 3) + (lane & 31);
                    if (G == 256) {
                        const int hh = bid & 15; const int pp[4] = {bid >> 4, (bid >> 4) + 16, (bid >> 4) + 32, (bid >> 4) + 48}; float cin4[4][8];
                        v4u ab0_[4], ab1_[4], g0_, g1_; sa_prefetch_pair(ws, pp[0], hh, 0, tid, wave, lane, ab0_, ab1_, g0_, g1_);
                        scan_carry4(CSp, PSp, pp, sd_, hh * 128 + scabs_, cin4);
                        scan_apply_unit(args, ws, lds, pp[0], hh, tid, wave, lane, C8(cin4[0]), ab0_, ab1_, g0_, g1_, pp[1], hh); scan_apply_unit(args, ws, lds, pp[1], hh, tid, wave, lane, C8(cin4[1]), ab0_, ab1_, g0_, g1_, pp[2], hh);
                        scan_apply_unit(args, ws, lds, pp[2], hh, tid, wave, lane, C8(cin4[2]), ab0_, ab1_, g0_, g1_, pp[3], hh); scan_apply_unit(args, ws, lds, pp[3], hh, tid, wave, lane, C8(cin4[3]), ab0_, ab1_, g0_, g1_, -1, 0);
                    } else for (int u = bid; u < 64 * 16; u += G) { const int pp[1] = {u >> 4}; float cin1[1][8]; scan_carry<1>(CSp, PSp, pp, sd_, (u & 15) * 128 + scabs_, cin1);
                        v4u ab0_[4], ab1_[4], g0_, g1_; sa_prefetch_pair(ws, u >> 4, u & 15, 0, tid, wave, lane, ab0_, ab1_, g0_, g1_);
                        scan_apply_unit(args, ws, lds, u >> 4, u & 15, tid, wave, lane, C8(cin1[0]), ab0_, ab1_, g0_, g1_, -1, 0); } } }
#endif
            SEAM(17);
            if (IN(18)) { pg8::EpiResid E{nullptr, nullptr, X, modl + 5 * DM, MODW, 1.0f, SLAB};
                run_gemm<pg8::EpiResid, pg8::StaticOrderC<64, 8, 32>>(lds + RING_OFF, MIX, (const bf16*)(ws + WS_WRGOUT), NLAT, DM, DM, G, bid, E, slow); }
            SEAM(18);
    }
    FFN_BLOCK(64, 3, 19, 0, (void)0);
    if (IN(22)) RT_(REP_NORM) final_norm_phase(X, args.in[I_FNORM], args.out, gw, ngw, lane);
#if defined(PROBE_WAIT)
    if (bid == 0 && tid == 0) { __threadfence(); const unsigned long long tw = __hip_atomic_load((unsigned long long*)(ws + WS_CTL) + 4000, __ATOMIC_RELAXED, __HIP_MEMORY_SCOPE_AGENT);
        asm volatile("s_waitcnt vmcnt(0)" ::: "memory");
#if defined(PROBE_RATE)
        args.out[0] += (float)*((int*)(ws + WS_CTL + 8 * 4200)) * 1e-5f;
#elif defined(PROBE_WARM)
        { const bool w_ = warm_ == 0x600DF00Du; __hip_atomic_store((unsigned*)(ws + WS_ROPE + 262144), 0x600DF00Du, __ATOMIC_RELAXED, __HIP_MEMORY_SCOPE_AGENT);
          const unsigned long long p0_ = *((unsigned long long*)(ws + WS_CTL) + 4100), p1_ = (PROBE_PHASE >= 22) ? __builtin_amdgcn_s_memrealtime() : *((unsigned long long*)(ws + WS_CTL) + 4101); const float us_ = (float)(p1_ - p0_) * 0.01f;
          if (PROBE_WARM == 5 || PROBE_WARM == 6) { float* cs_ = (float*)(ws + WS_ROPE + 262144 + 64); const float c_ = (float)*((unsigned long long*)(ws + WS_CTL) + 4102) * 0.01f;
              if (!w_) *cs_ = c_; args.out[0] += ((PROBE_WARM == 5 ? *cs_ : c_) - (float)PROBE_BASE) * PROBE_SCALE; } else
          if (PROBE_WARM == 4) { float* cs_ = (float*)(ws + WS_ROPE + 262144 + 64); if (!w_) *cs_ = us_; args.out[0] += (*cs_ - (float)PROBE_BASE) * PROBE_SCALE; } else
          args.out[0] += PROBE_WARM == 1 ? (w_ ? 3.0f : 0.0f) : PROBE_WARM == 2 ? (w_ ? (us_ - (float)PROBE_BASE) * PROBE_SCALE : 0.0f) : (w_ ? 0.0f : (us_ - (float)PROBE_BASE) * PROBE_SCALE); }
#elif PROBE_PHASE < 1000
        { const unsigned long long p0_ = *((unsigned long long*)(ws + WS_CTL) + 4100), p1_ = (PROBE_PHASE >= 22) ? __builtin_amdgcn_s_memrealtime() : *((unsigned long long*)(ws + WS_CTL) + 4101); args.out[0] += ((float)(p1_ - p0_) * 0.01f - (float)PROBE_BASE) * PROBE_SCALE; }
#elif !defined(PROBE_XCD)
        args.out[0] += (float)tw * (0.01f / 256.0f) * 0.01f;
#else
        float mx = 0.f, mn = 1e30f;
        for (int x = 0; x < 8; ++x) { const unsigned long long s = __hip_atomic_load((unsigned long long*)(ws + WS_CTL) + 4010 + 2 * x, __ATOMIC_RELAXED, __HIP_MEMORY_SCOPE_AGENT), n = __hip_atomic_load((unsigned long long*)(ws + WS_CTL) + 4011 + 2 * x, __ATOMIC_RELAXED, __HIP_MEMORY_SCOPE_AGENT);
            if (n) { const float av = (float)s / (float)n * 0.01f; mx = fmaxf(mx, av); mn = fminf(mn, av); } }
        int imn = 0; { float best = 1e30f; for (int x = 0; x < 8; ++x) { const unsigned long long s = __hip_atomic_load((unsigned long long*)(ws + WS_CTL) + 4010 + 2 * x, __ATOMIC_RELAXED, __HIP_MEMORY_SCOPE_AGENT), n = __hip_atomic_load((unsigned long long*)(ws + WS_CTL) + 4011 + 2 * x, __ATOMIC_RELAXED, __HIP_MEMORY_SCOPE_AGENT); if (n && (float)s / (float)n < best) { best = (float)s / (float)n; imn = x; } } }
        args.out[0] += (PROBE_XCD == 1 ? mx * 0.01f : (PROBE_XCD == 2 ? mn * 0.01f : (float)(imn + 1)));
#endif
        }
#endif
#undef IN
#undef SEAM
}

extern "C" void kernel_launch(void* const* d_in, const int* in_sizes, int n_in, void* d_out, int out_size, void* d_ws, size_t ws_size, hipStream_t stream) {
    static int grid = 0;
    if (grid == 0) {
        if (n_in != N_IN || in_sizes[0] != NLAT * DM || out_size != NLAT * DM || ws_size < WS_END) { fprintf(stderr, "kernel_launch: unexpected shapes (n_in %d, ws %zu)\n", n_in, ws_size); grid = -1; return; }
        int dev = 0, cus = 0, per_cu = 0;
        if (hipGetDevice(&dev) != hipSuccess || hipDeviceGetAttribute(&cus, hipDeviceAttributeMultiprocessorCount, dev) != hipSuccess) { grid = -1; return; }
        if (hipFuncSetAttribute((const void*)fwd_kernel, hipFuncAttributeMaxDynamicSharedMemorySize, LDS_BYTES) != hipSuccess) { fprintf(stderr, "kernel_launch: hipFuncSetAttribute failed\n"); grid = -1; return; }
        if (hipOccupancyMaxActiveBlocksPerMultiprocessor(&per_cu, (const void*)fwd_kernel, NTHR, LDS_BYTES) != hipSuccess || per_cu < 1) fprintf(stderr, "kernel_launch: occupancy query reports %d\n", per_cu);
        (void)hipGetLastError();
        grid = cus;
    }
    if (grid < 0) return;
    if (hipMemsetAsync((char*)d_ws + WS_CTL, 0, CTL_ZERO_BYTES, stream) != hipSuccess) return;
#if defined(PROBE_RATE)
    { int dev_ = 0, khz_ = 0; (void)hipGetDevice(&dev_); (void)hipDeviceGetAttribute(&khz_, hipDeviceAttributeWallClockRate, dev_);
      (void)hipMemsetD32Async((hipDeviceptr_t)((char*)d_ws + WS_CTL + 8 * 4200), khz_, 1, stream); }
#endif
    Args a{};
    for (int i = 0; i < N_IN; ++i) a.in[i] = (const float*)d_in[i];
    a.out = (float*)d_out; a.ws = (unsigned char*)d_ws;
#if MK_ONE_LAUNCH
    a.ph_lo = 0; a.ph_hi = N_PHASES;
    hipLaunchKernelGGL(fwd_kernel, dim3(grid), dim3(NTHR), LDS_BYTES, stream, a);
#else
    for (int p = 0; p < N_PHASES; ++p) { a.ph_lo = p; a.ph_hi = p + 1; hipLaunchKernelGGL(fwd_kernel, dim3(grid), dim3(NTHR), LDS_BYTES, stream, a); }
#endif
}
```

```cpp
#include <hip/hip_runtime.h>
#include <cstdio>
#include <cstdint>
#ifndef PG8_WGM
#define PG8_WGM 8
#endif
namespace pg8 {
#define PG8_LAS __attribute__((address_space(3)))
typedef unsigned short bf16_t;
typedef short bf16x8 __attribute__((ext_vector_type(8)));
typedef float f32x4 __attribute__((ext_vector_type(4)));
typedef unsigned u32x4 __attribute__((ext_vector_type(4)));
constexpr int BM = 256, BK = 64, HALF = 128, HTB = HALF * BK * 2  , STAGE_BYTES = 8 * HTB, NXCD = 8, WGM = PG8_WGM;

__host__ __device__ __forceinline__ int lds_byte(int r, int c) { const int st = (r >> 4) * 2 + (c >> 5), rr = r & 15, cc = c & 31, ob = rr * 64 + cc * 2; return st * 1024 + (ob ^ (((ob >> 9) & 1) << 5)); }
__host__ __device__ __forceinline__ void stage_rc(int b, int& R, int& C) { const int st = b / 1024, sb = b % 1024, swz = sb ^ (((sb >> 9) & 1) << 5); R = (st >> 1) * 16 + swz / 64; C = (st & 1) * 32 + (swz % 64) / 2; }
__host__ __device__ __forceinline__ int perm32(int rho) { const int n = rho >> 4, i = rho & 15; return 8 * (i >> 2) + 4 * n + (i & 3); }

struct Unit { int pm, pn, kt0, nt, ks; };
struct Gemm { const bf16_t* A; const bf16_t* Bt; int ld; size_t kstepA, kstepB; int thr; };

__host__ __device__ __forceinline__ int xrank(int c, int slow) { return slow < 0 ? c : (((c & 7) == slow) ? 0x3fffffff : c - ((c + 7 - slow) >> 3)); }
template <int NM_, int NN_, int KT, int WGM_ = WGM> struct StaticOrderC {
    static constexpr int nM = NM_, nN = NN_, nwg = NM_ * NN_;
    int G, c, slow;
    __host__ __device__ __forceinline__ void init(int G_, int c_, int slow_ = -1) { G = G_; c = c_; slow = (G_ == 256) ? slow_ : -1; }
    static __host__ __device__ __forceinline__ void map(int L, int& pm, int& pn) {
        int wgid = L; { constexpr int q = nwg / NXCD, r = nwg % NXCD; const int xcd = wgid % NXCD, off = wgid / NXCD; wgid = (xcd < r ? xcd * (q + 1) : r * (q + 1) + (xcd - r) * q) + off; }
        constexpr int WGMv = WGM_; constexpr int nig = WGMv * nN; const int gid = wgid / nig, fm = gid * WGMv, gsz = (nM - fm) < WGMv ? (nM - fm) : WGMv;
        const int w = wgid - gid * nig;
        if (gsz == WGMv) { pm = fm + (w % WGMv); pn = w / WGMv; } else { pm = fm + (w % gsz); pn = w / gsz; }
    }
    __host__ __device__ __forceinline__ bool next(int i, Unit& u) const {
        const int full = nwg / G;
        int L = i * G + c;
        if (i >= full) { if (i > full) return false; const int rk = xrank(c, slow); if (rk >= nwg - full * G) return false; L = full * G + rk; }
        int pm, pn; map(L, pm, pn);
        u.pm = pm; u.pn = pn; u.kt0 = 0; u.nt = KT; u.ks = -1;
        return true;
    }
    __device__ __forceinline__ void a_ready(const Unit&) const {}
    __device__ __forceinline__ void done(const Unit&) const {}
};

template <int NN_, int KT> struct SplitCtxOrder {
    static constexpr int NPIECE = (KT == 88) ? 11 : 8, NLATU = 64 * NN_, NSUB = 2 * NN_ * NPIECE;
    int G, c, slow;
    __host__ __device__ __forceinline__ void init(int G_, int c_, int slow_ = -1) { G = G_; c = c_; slow = (G_ == 256) ? slow_ : -1; }
    static __host__ __device__ __forceinline__ void piece(int p, int& kt0, int& nt) {
        if (KT == 88) { nt = 8; kt0 = 8 * p; } else { nt = 4; kt0 = 4 * p; }
    }
    __host__ __device__ __forceinline__ bool next(int i, Unit& u) const {
        int pm, pn, kt0 = 0, nt = KT, ks = -1;
        const int rk = xrank(c, slow); const bool has_piece = rk < NSUB;
        if (has_piece && i == 0) { const int un = rk % (2 * NN_); ks = rk / (2 * NN_); pm = 64 + (un & 1); pn = un >> 1; piece(ks, kt0, nt); }
        else { const int L = (has_piece ? i - 1 : i) * G + c; if (L >= NLATU) return false; StaticOrderC<64, NN_, KT, (KT == 88 ? 4 : WGM)>::map(L, pm, pn); }
        u.pm = pm; u.pn = pn; u.kt0 = kt0; u.nt = nt; u.ks = ks;
        return true;
    }
    __device__ __forceinline__ void a_ready(const Unit&) const {}
    __device__ __forceinline__ void done(const Unit&) const {}
};

__device__ __forceinline__ unsigned cvt_pk_bf16(float lo, float hi) { unsigned r; asm volatile("v_cvt_pk_bf16_f32 %0, %1, %2" : "=v"(r) : "v"(lo), "v"(hi)); return r; }
constexpr int ROWS_LAT = 16384, D_MODEL = 2048;

struct EpiBf16 {
    static constexpr bool PERM = true, AFTER_DRAIN = false;
    bf16_t* O; int ldc;
    __device__ __forceinline__ void operator()(const f32x4 (&acc)[2][2][4][2], const Unit& u, int wr, int wc, int fr, int fq) const {
        const int row0 = u.pm * BM + wr * 64 + fr; const int col0 = u.pn * BM + wc * 32 + 8 * fq;
#pragma unroll
        for (int ai = 0; ai < 2; ++ai)
#pragma unroll
            for (int m = 0; m < 4; ++m) { bf16_t* rowp = O + (size_t)(row0 + ai * HALF + m * 16) * ldc + col0;
#pragma unroll
                for (int bj = 0; bj < 2; ++bj) { const f32x4 v0 = acc[ai][bj][m][0], v1 = acc[ai][bj][m][1];
                    u32x4 w; w.x = cvt_pk_bf16(v0[0], v0[1]); w.y = cvt_pk_bf16(v0[2], v0[3]); w.z = cvt_pk_bf16(v1[0], v1[1]); w.w = cvt_pk_bf16(v1[2], v1[3]);
                    *(u32x4*)(rowp + bj * HALF) = w; } }
    }
};
__device__ __forceinline__ float silu_f(float g) { return g * __builtin_amdgcn_rcpf(1.0f + __expf(-g)); }
struct EpiSwiGLU {
    static constexpr bool PERM = true, AFTER_DRAIN = false;
    bf16_t* H; int mrows;
    __device__ __forceinline__ void operator()(const f32x4 (&acc)[2][2][4][2], const Unit& u, int wr, int wc, int fr, int fq) const {
        const int row0 = u.pm * BM + wr * 64 + fr; const int col0 = u.pn * HALF + wc * 32 + 8 * fq;
#pragma unroll
        for (int ai = 0; ai < 2; ++ai)
#pragma unroll
            for (int m = 0; m < 4; ++m) { const int rr = row0 + ai * HALF + m * 16;
                bf16_t* rowp = (bf16_t*)((char*)H + ((size_t)(col0 >> 6) * (mrows >> 7) + (rr >> 7)) * HTB + lds_byte(rr & 127, col0 & 63));
                const f32x4 g0 = acc[ai][0][m][0], g1 = acc[ai][0][m][1], u0 = acc[ai][1][m][0], u1 = acc[ai][1][m][1];
                u32x4 w;
                w.x = cvt_pk_bf16(silu_f(g0[0]) * u0[0], silu_f(g0[1]) * u0[1]); w.y = cvt_pk_bf16(silu_f(g0[2]) * u0[2], silu_f(g0[3]) * u0[3]);
                w.z = cvt_pk_bf16(silu_f(g1[0]) * u1[0], silu_f(g1[1]) * u1[1]); w.w = cvt_pk_bf16(silu_f(g1[2]) * u1[2], silu_f(g1[3]) * u1[3]);
                *(u32x4*)rowp = w; }
    }
};
struct EpiResid {
    static constexpr bool PERM = true, AFTER_DRAIN = false;
    const float* resLatF; const float* resCtxF; bf16_t* X; const float* gate; int gstride; float gscale; float* slab;
    __device__ __forceinline__ void operator()(const f32x4 (&acc)[2][2][4][2], const Unit& u, int wr, int wc, int fr, int fq) const {
        const int v = u.pm < 32 ? 0 : (u.pm < 64 ? 1 : 2);
        const float* gv = gate + (size_t)v * gstride;
        const int col0 = u.pn * BM + wc * 32 + 8 * fq;
        f32x4 gvec[2][2];
#pragma unroll
        for (int bj = 0; bj < 2; ++bj)
#pragma unroll
            for (int n = 0; n < 2; ++n) gvec[bj][n] = *(const f32x4*)(gv + col0 + bj * HALF + n * 4) * gscale;
#pragma unroll
        for (int ai = 0; ai < 2; ++ai)
#pragma unroll
            for (int m = 0; m < 4; ++m) { const int row = u.pm * BM + ai * HALF + wr * 64 + m * 16 + fr;
                bf16_t* xp = X + (size_t)row * D_MODEL;
                if (u.ks >= 0) {
                    bf16_t* sp = (bf16_t*)slab + ((size_t)u.ks * 512 + (row - ROWS_LAT)) * D_MODEL;
#pragma unroll
                    for (int bj = 0; bj < 2; ++bj) { const int c = col0 + bj * HALF; const f32x4 o0 = gvec[bj][0] * acc[ai][bj][m][0], o1 = gvec[bj][1] * acc[ai][bj][m][1];
                        u32x4 w; w.x = cvt_pk_bf16(o0[0], o0[1]); w.y = cvt_pk_bf16(o0[2], o0[3]); w.z = cvt_pk_bf16(o1[0], o1[1]); w.w = cvt_pk_bf16(o1[2], o1[3]);
                        *(u32x4*)(sp + c) = w; }
                } else {
#pragma unroll
                    for (int bj = 0; bj < 2; ++bj) { const int c = col0 + bj * HALF; f32x4 r0, r1;
                        if (resLatF) { const float* rp = ((row < ROWS_LAT) ? resLatF + (size_t)row * D_MODEL : resCtxF + (size_t)(row - ROWS_LAT) * D_MODEL) + c;
                            r0 = *(const f32x4*)rp; r1 = *(const f32x4*)(rp + 4); }
                        else { const u32x4 rw = *(const u32x4*)(xp + c);
                            r0 = (f32x4){__builtin_bit_cast(float, rw.x << 16), __builtin_bit_cast(float, rw.x & 0xffff0000u), __builtin_bit_cast(float, rw.y << 16), __builtin_bit_cast(float, rw.y & 0xffff0000u)};
                            r1 = (f32x4){__builtin_bit_cast(float, rw.z << 16), __builtin_bit_cast(float, rw.z & 0xffff0000u), __builtin_bit_cast(float, rw.w << 16), __builtin_bit_cast(float, rw.w & 0xffff0000u)}; }
                        const f32x4 o0 = r0 + gvec[bj][0] * acc[ai][bj][m][0], o1 = r1 + gvec[bj][1] * acc[ai][bj][m][1];
                        u32x4 w; w.x = cvt_pk_bf16(o0[0], o0[1]); w.y = cvt_pk_bf16(o0[2], o0[3]); w.z = cvt_pk_bf16(o1[0], o1[1]); w.w = cvt_pk_bf16(o1[2], o1[3]);
                        *(u32x4*)(xp + c) = w; }
                }
                if (m & 1) asm volatile("" ::: "memory"); }
    }
};

struct EpiNull {
    static constexpr bool PERM = true, AFTER_DRAIN = false;
    __device__ __forceinline__ void operator()(const f32x4 (&acc)[2][2][4][2], const Unit& u, int wr, int wc, int fr, int fq) const {
#pragma unroll
        for (int ai = 0; ai < 2; ++ai)
#pragma unroll
            for (int bj = 0; bj < 2; ++bj)
#pragma unroll
                for (int m = 0; m < 4; ++m)
#pragma unroll
                    for (int n = 0; n < 2; ++n) asm volatile("" :: "v"(acc[ai][bj][m][n]));
    }
};
template <class Epi, class Sched, bool ALIGN_EPI = false, bool SP2 = false>
__device__ __forceinline__ void gemm_phase(PG8_LAS unsigned char* lds, const Gemm g, const Sched& S, const Epi& E) {
    const int tid = threadIdx.x, wid = __builtin_amdgcn_readfirstlane(tid >> 6), lane = tid & 63, wr = wid >> 2, wc = wid & 3, fr = lane & 15, fq = lane >> 4;
    unsigned voffA[2], voffB[2];
#pragma unroll
    for (int i = 0; i < 2; ++i) { int R, C; stage_rc(tid * 16 + i * 8192, R, C); const int Rb = Epi::PERM ? ((R & ~31) + perm32(R & 31)) : R;
        voffA[i] = g.ld ? (unsigned)(R * g.ld + C) * 2u : (unsigned)(tid * 16 + i * 8192); voffB[i] = g.ld ? (unsigned)(Rb * g.ld + C) * 2u : (unsigned)(tid * 16 + i * 8192); }
    const size_t kstepA = g.kstepA, kstepB = g.kstepB;
    const size_t hstep = g.ld ? (size_t)HALF * g.ld * 2 : (size_t)HTB;
    const size_t tstep = 2 * hstep;
    const unsigned ldsw = (unsigned)wid * 1024u;
    const int aoff = lds_byte(wr * 64 + fr, fq * 8), boff = lds_byte(wc * 32 + fr, fq * 8);
#define PG8_SA(b, h) (((b) * 2 + (h)) * HTB)
#define PG8_SB(b, h) ((4 + (b) * 2 + (h)) * HTB)
#define PG8_STAGE(bufoff, gbase, voff) do { _Pragma("unroll") for (int _i = 0; _i < 2; ++_i) \
        __builtin_amdgcn_global_load_lds((const unsigned*)((const char*)(gbase) + (voff)[_i]), (PG8_LAS unsigned*)(lds + (bufoff) + ldsw + _i * 8192), 16, 0, 0); } while (0)
#define PG8_LDA(dst, b, h) do { _Pragma("unroll") for (int m = 0; m < 4; ++m) _Pragma("unroll") for (int k = 0; k < 2; ++k) dst[m][k] = *(const PG8_LAS bf16x8*)(lds + PG8_SA(b, h) + aoff + m * 2048 + k * 1024); } while (0)
#define PG8_LDB(dst, b, h) do { _Pragma("unroll") for (int n = 0; n < 2; ++n) _Pragma("unroll") for (int k = 0; k < 2; ++k) dst[n][k] = *(const PG8_LAS bf16x8*)(lds + PG8_SB(b, h) + boff + n * 2048 + k * 1024); } while (0)
#define PG8_MMA(ai, bj, At, Bt) do { __builtin_amdgcn_s_setprio(1); _Pragma("unroll") for (int m = 0; m < 4; ++m) _Pragma("unroll") for (int n = 0; n < 2; ++n) _Pragma("unroll") for (int k = 0; k < 2; ++k) \
        acc[ai][bj][m][n] = __builtin_amdgcn_mfma_f32_16x16x32_bf16(Bt[n][k], At[m][k], acc[ai][bj][m][n], 0, 0, 0); __builtin_amdgcn_s_setprio(0); } while (0)
#define PG8_WAIT_V(n) asm volatile("s_waitcnt vmcnt(" #n ")" ::: "memory")
#define PG8_WAIT_L(n) asm volatile("s_waitcnt lgkmcnt(" #n ")" ::: "memory")
#define PG8_BAR __builtin_amdgcn_s_barrier()
#define PG8_SCHED __builtin_amdgcn_sched_barrier(0)
    Unit cur, nxt; int ui = 0;
    if (!S.next(0, cur)) return;
    f32x4 acc[2][2][4][2];
#pragma unroll
    for (int a = 0; a < 2; ++a)
#pragma unroll
        for (int b = 0; b < 2; ++b)
#pragma unroll
            for (int m = 0; m < 4; ++m)
#pragma unroll
                for (int n = 0; n < 2; ++n) acc[a][b][m][n] = (f32x4){0.f, 0.f, 0.f, 0.f};
    bf16x8 At[4][2], B0[2][2], B1[2][2];
    const char* cA = (const char*)g.A + (size_t)cur.pm * tstep + (size_t)cur.kt0 * kstepA; const char* cB = (const char*)g.Bt + (size_t)cur.pn * tstep + (size_t)cur.kt0 * kstepB;
    S.a_ready(cur);
    if constexpr (SP2) {
        PG8_STAGE(PG8_SB(0, 0), cB, voffB); PG8_STAGE(PG8_SB(0, 1), cB + hstep, voffB); PG8_STAGE(PG8_SA(0, 0), cA, voffA); PG8_STAGE(PG8_SA(0, 1), cA + hstep, voffA);
        if (wr == 1) PG8_BAR;
        PG8_WAIT_V(2); PG8_BAR;
        PG8_STAGE(PG8_SB(1, 0), cB + kstepB, voffB); PG8_STAGE(PG8_SA(1, 0), cA + kstepA, voffA); PG8_STAGE(PG8_SB(1, 1), cB + hstep + kstepB, voffB);
        PG8_WAIT_V(6); PG8_BAR;
    } else {
        PG8_STAGE(PG8_SB(0, 0), cB, voffB); PG8_STAGE(PG8_SA(0, 0), cA, voffA); PG8_STAGE(PG8_SB(0, 1), cB + hstep, voffB); PG8_STAGE(PG8_SA(0, 1), cA + hstep, voffA);
        if (wr == 1) PG8_BAR;
        PG8_WAIT_V(4); PG8_BAR;
        PG8_STAGE(PG8_SB(1, 0), cB + kstepB, voffB); PG8_STAGE(PG8_SA(1, 0), cA + kstepA, voffA); PG8_STAGE(PG8_SB(1, 1), cB + hstep + kstepB, voffB);
        PG8_WAIT_V(6); PG8_BAR;
    }
    for (;;) {
        const bool has_next = S.next(ui + 1, nxt);
        const char* nA = has_next ? (const char*)g.A + (size_t)nxt.pm * tstep + (size_t)nxt.kt0 * kstepA : cA; const char* nB = has_next ? (const char*)g.Bt + (size_t)nxt.pn * tstep + (size_t)nxt.kt0 * kstepB : cB;
        const int nt = cur.nt;
        for (int t = 0; t < nt; t += 2) {
            const bool last = (t == nt - 2);
#if defined(EXP_THR)
            if (g.thr > 0) __builtin_amdgcn_s_sleep(EXP_THR);
#endif
            const char* a1 = cA + (size_t)(t + 1) * kstepA;
            const char* a2 = last ? nA : cA + (size_t)(t + 2) * kstepA; const char* b2 = last ? nB : cB + (size_t)(t + 2) * kstepB;
            const char* a3 = a2 + kstepA; const char* b3 = b2 + kstepB;
            if (last && has_next) S.a_ready(nxt);
            if constexpr (SP2) {
            PG8_LDB(B0, 0, 0); PG8_LDB(B1, 0, 1); PG8_SCHED; PG8_LDA(At, 0, 0); PG8_STAGE(PG8_SA(1, 1), a1 + hstep, voffA);
            PG8_WAIT_V(8); PG8_WAIT_L(0); PG8_BAR; PG8_MMA(0, 0, At, B0); PG8_MMA(0, 1, At, B1); PG8_BAR; PG8_SCHED;
            PG8_LDA(At, 0, 1); PG8_STAGE(PG8_SB(0, 0), b2, voffB); PG8_STAGE(PG8_SB(0, 1), b2 + hstep, voffB); PG8_STAGE(PG8_SA(0, 0), a2, voffA);
            PG8_WAIT_V(8); PG8_WAIT_L(0); PG8_BAR; PG8_MMA(1, 0, At, B0); PG8_MMA(1, 1, At, B1); PG8_BAR; PG8_SCHED;
            PG8_LDB(B0, 1, 0); PG8_LDB(B1, 1, 1); PG8_SCHED; PG8_LDA(At, 1, 0); PG8_STAGE(PG8_SA(0, 1), a2 + hstep, voffA);
            PG8_WAIT_V(8); PG8_WAIT_L(0); PG8_BAR; PG8_MMA(0, 0, At, B0); PG8_MMA(0, 1, At, B1); PG8_BAR; PG8_SCHED;
            PG8_LDA(At, 1, 1); PG8_STAGE(PG8_SB(1, 0), b3, voffB); PG8_STAGE(PG8_SB(1, 1), b3 + hstep, voffB); PG8_STAGE(PG8_SA(1, 0), a3, voffA);
            PG8_WAIT_V(8); PG8_WAIT_L(0); PG8_BAR; PG8_MMA(1, 0, At, B0); PG8_MMA(1, 1, At, B1); PG8_BAR; PG8_SCHED;
            } else {
            PG8_LDB(B0, 0, 0); PG8_SCHED; PG8_LDA(At, 0, 0); PG8_STAGE(PG8_SA(1, 1), a1 + hstep, voffA);
            PG8_WAIT_L(8); PG8_BAR; PG8_WAIT_L(0); PG8_MMA(0, 0, At, B0); PG8_BAR; PG8_SCHED;
            PG8_LDB(B1, 0, 1); PG8_STAGE(PG8_SB(0, 0), b2, voffB);
            PG8_BAR; PG8_WAIT_L(0); PG8_MMA(0, 1, At, B1); PG8_BAR;
            PG8_LDA(At, 0, 1); PG8_STAGE(PG8_SA(0, 0), a2, voffA);
            PG8_BAR; PG8_WAIT_L(0); PG8_MMA(1, 0, At, B0); PG8_BAR; PG8_SCHED;
            PG8_STAGE(PG8_SB(0, 1), b2 + hstep, voffB);
            PG8_WAIT_V(6); PG8_BAR; PG8_MMA(1, 1, At, B1); PG8_BAR;
            PG8_LDB(B0, 1, 0); PG8_SCHED; PG8_LDA(At, 1, 0); PG8_STAGE(PG8_SA(0, 1), a2 + hstep, voffA);
            PG8_WAIT_L(8); PG8_BAR; PG8_WAIT_L(0); PG8_MMA(0, 0, At, B0); PG8_BAR; PG8_SCHED;
            PG8_LDB(B1, 1, 1); PG8_STAGE(PG8_SB(1, 0), b3, voffB);
            PG8_BAR; PG8_WAIT_L(0); PG8_MMA(0, 1, At, B1); PG8_BAR;
            PG8_LDA(At, 1, 1); PG8_STAGE(PG8_SA(1, 0), a3, voffA);
            PG8_BAR; PG8_WAIT_L(0); PG8_MMA(1, 0, At, B0); PG8_BAR; PG8_SCHED;
            PG8_STAGE(PG8_SB(1, 1), b3 + hstep, voffB);
            PG8_WAIT_V(6); PG8_BAR; PG8_MMA(1, 1, At, B1); PG8_BAR;
            }
        }
        if constexpr (ALIGN_EPI) { if (wr == 0) PG8_BAR; }
        if constexpr (!Epi::AFTER_DRAIN) { E(acc, cur, wr, wc, fr, fq);
#if defined(REP_EPI)
            if constexpr (Epi::PERM) { asm volatile("" ::: "memory"); E(acc, cur, wr, wc, fr, fq); }
#endif
            S.done(cur); }
        if (!has_next) break;
#pragma unroll
        for (int a = 0; a < 2; ++a)
#pragma unroll
            for (int b = 0; b < 2; ++b)
#pragma unroll
                for (int m = 0; m < 4; ++m)
#pragma unroll
                    for (int n = 0; n < 2; ++n) acc[a][b][m][n] = (f32x4){0.f, 0.f, 0.f, 0.f};
        cur = nxt; cA = nA; cB = nB; ++ui;
        if constexpr (ALIGN_EPI) { if (wr == 1) PG8_BAR; }
    }
    PG8_WAIT_V(0);
    if constexpr (!ALIGN_EPI) { if (wr == 0) PG8_BAR; }
    PG8_BAR;
    if constexpr (Epi::AFTER_DRAIN) { E.fused(acc, cur, wr, wc, fr, fq, lds, wid, lane); S.done(cur); }
#undef PG8_SA
#undef PG8_SB
#undef PG8_STAGE
#undef PG8_LDA
#undef PG8_LDB
#undef PG8_MMA
#undef PG8_WAIT_V
#undef PG8_WAIT_L
#undef PG8_BAR
#undef PG8_SCHED
}
}
#define GAS __attribute__((address_space(1)))
#define LAS __attribute__((address_space(3)))
typedef unsigned short bf16;
typedef unsigned v4u __attribute__((ext_vector_type(4)));
typedef float f32x4 __attribute__((ext_vector_type(4)));
typedef short bf16x8 __attribute__((ext_vector_type(8)));
typedef GAS unsigned gu32;
typedef GAS unsigned long long gu64;
#define RLX_AGENT __ATOMIC_RELAXED, __HIP_MEMORY_SCOPE_AGENT
#define LDS_WAIT() asm volatile("s_waitcnt lgkmcnt(0)" ::: "memory")
#define VM_WAIT() asm volatile("s_waitcnt vmcnt(0)" ::: "memory")
__device__ __forceinline__ unsigned long long rt() { return __builtin_amdgcn_s_memrealtime(); }
__device__ __forceinline__ unsigned f2bf(float f) { unsigned u = __builtin_bit_cast(unsigned, f); return (u + 0x7fffu + ((u >> 16) & 1u)) >> 16; }
__device__ __forceinline__ unsigned pk2(float lo, float hi) { return f2bf(lo) | (f2bf(hi) << 16); }

#define XB_TMO      128
#define XB_XCNT(j)  (256  + 64 * (j))
#define XB_XSUB(j)  (1280 + 64 * (j))
#define XB_XGEN(j)  (2304 + 64 * (j))
#define XB_TOP      3328
#define XB_TOPGEN   3392
#define XCD_BAR_WORDS 3456
#define XB_SPIN_CAP (1u << 18)

__device__ __forceinline__ unsigned xb_ld(unsigned* p)              { return __hip_atomic_load(p, __ATOMIC_RELAXED, __HIP_MEMORY_SCOPE_AGENT); }
__device__ __forceinline__ unsigned xb_add(unsigned* p, unsigned v) { return __hip_atomic_fetch_add(p, v, __ATOMIC_RELAXED, __HIP_MEMORY_SCOPE_AGENT); }
__device__ __forceinline__ unsigned xb_xcc_id() { return (unsigned)__builtin_amdgcn_s_getreg((3 << 11) | 20) & 0xFu; }
#define XB_SPIN(cond, bar) do { unsigned _sp = 0; while (cond) { __builtin_amdgcn_s_sleep(1); \
    if ((++_sp & 255u) == 0u) { if (xb_ld(&(bar)[XB_TMO])) break; if (_sp > XB_SPIN_CAP) { atomicAdd(&(bar)[XB_TMO], 1u); break; } } } } while (0)

struct XcdBarrier {
    unsigned* bar; unsigned x;
    volatile LAS unsigned* st;
};

__device__ __forceinline__ XcdBarrier xcd_barrier_post(unsigned* bar, volatile LAS unsigned* st) {
    XcdBarrier b; b.bar = bar; b.x = xb_xcc_id(); b.st = st;
    if (threadIdx.x == 0) (void)xb_add(&bar[XB_XCNT(b.x)], 1u);
    return b;
}
__device__ __forceinline__ void xcd_barrier_complete(unsigned* bar, unsigned x, unsigned& nloc, unsigned& nx) {
    const unsigned G = gridDim.x * gridDim.y * gridDim.z;
    unsigned sum, cnt, mine, sp = 0u;
    for (;;) {
        sum = 0u; cnt = 0u; mine = 0u;
#pragma unroll
        for (unsigned j = 0; j < 16; ++j) { const unsigned c = xb_ld(&bar[XB_XCNT(j)]); sum += c; cnt += (c > 0u) ? 1u : 0u; mine = (j == x) ? c : mine; }
        if (sum == G) break;
        __builtin_amdgcn_s_sleep(1);
        if ((++sp & 255u) == 0u) { if (xb_ld(&bar[XB_TMO])) break; if (sp > XB_SPIN_CAP) { atomicAdd(&bar[XB_TMO], 1u); break; } }
    }
    nloc = mine > 0u ? mine : 1u; nx = cnt > 0u ? cnt : 1u;
}

__device__ __forceinline__ void xcd_barrier(const XcdBarrier& b) {
    asm volatile("s_waitcnt vmcnt(0)" ::: "memory");
    __syncthreads();
    if (threadIdx.x == 0) {
        unsigned* bar = b.bar;
        __builtin_amdgcn_s_waitcnt(0);
        unsigned nloc = b.st[0], nx = b.st[1];
        if (nloc == 0u) { xcd_barrier_complete(bar, b.x, nloc, nx); b.st[0] = nloc; b.st[1] = nx; }
        const unsigned old = xb_add(&bar[XB_XSUB(b.x)], 1u);
        const unsigned gen = old / nloc;
        if (old + 1u == (gen + 1u) * nloc) {
            __builtin_amdgcn_fence(__ATOMIC_RELEASE, "agent");
            asm volatile("s_waitcnt vmcnt(0)" ::: "memory");
            const unsigned og = xb_add(&bar[XB_TOP], 1u);
            const unsigned tg = og / nx;
            if (og + 1u == (tg + 1u) * nx) xb_add(&bar[XB_TOPGEN], 1u);
            else XB_SPIN(xb_ld(&bar[XB_TOPGEN]) == tg, bar);
            __builtin_amdgcn_fence(__ATOMIC_ACQUIRE, "agent");
            xb_add(&bar[XB_XGEN(b.x)], 1u);
            asm volatile("s_waitcnt vmcnt(0)" ::: "memory");
        } else {
            XB_SPIN(xb_ld(&bar[XB_XGEN(b.x)]) == gen, bar);
            __builtin_amdgcn_fence(__ATOMIC_ACQUIRE, "agent");
            asm volatile("s_waitcnt vmcnt(0)" ::: "memory");
        }
    }
    __syncthreads();
}

constexpr int NWAVES = 8, NTHR = 512;
constexpr int DM = 2048, DFF = 5632, SEQ = 8192, CTXL = 256, NB = 2;
constexpr int NLAT = NB * SEQ, NCTXR = NB * CTXL, MROWS = NLAT + NCTXR;
constexpr int NMOD = 9, MODW = NMOD * DM;
constexpr int ABW = 4608, RGW = 4096, HD = 128;
constexpr float EPS = 1e-6f;
enum { I_X = 0, I_C, I_CTX, I_CCTX, I_WMOD, I_BMOD, I_NF1, I_NMIX, I_NF2, I_F1IN, I_F1OUT, I_F2IN, I_F2OUT, I_ABIN, I_ABOUT, I_SINK, I_ABCONV,
       I_RGIN, I_RGCONVW, I_RGCONVB, I_RGWA, I_RGBA, I_RGWX, I_RGBX, I_RGLAM, I_RGOUT, I_FNORM, N_IN };

constexpr size_t MiB = 1u << 20;
constexpr size_t WS_CTL = 0, CTL_ZERO_BYTES = 1 * MiB;
constexpr size_t WS_MOD = 1 * MiB;
constexpr size_t WS_ROPE = 1 * MiB + 512 * 1024;
constexpr size_t WS_WIN = 2 * MiB, WIN_BYTES = 44 * MiB;
constexpr size_t WS_WOUT = WS_WIN + 4 * WIN_BYTES, WOUT_BYTES = 22 * MiB;
constexpr size_t WS_WABIN = WS_WOUT + 4 * WOUT_BYTES;
constexpr size_t WS_WABOUT = WS_WABIN + 18 * MiB;
constexpr size_t WS_WRGIN = WS_WABOUT + 8 * MiB;
constexpr size_t WS_WRGOUT = WS_WRGIN + 16 * MiB;
constexpr size_t WS_WGATE = WS_WRGOUT + 8 * MiB;
constexpr size_t WS_X = WS_WGATE + 2 * MiB;
constexpr size_t WS_XN = WS_X + 132 * MiB;
constexpr size_t WS_H = WS_XN + 66 * MiB;
constexpr size_t WS_MIX = WS_H + 182 * MiB;
constexpr size_t WS_CS = WS_MIX + 66 * MiB;
constexpr size_t WS_PS = WS_CS + 17 * MiB;
constexpr size_t WS_SLAB = WS_PS + 3 * MiB;
constexpr size_t WS_ABH = WS_SLAB + 44 * MiB;
constexpr size_t WS_END = WS_ABH + 256 * MiB;
static_assert(WS_END <= 1140 * MiB, "d_ws map");
constexpr int CW_BAR = 4096;

constexpr int RING_OFF = 0, RING_BYTES = 131072;
constexpr int LDSCTL_OFF = RING_BYTES, MISC_OFF = LDSCTL_OFF + 320;
constexpr int LDS_BYTES = 147456;
struct Args { const float* in[27]; float* out; unsigned char* ws; int ph_lo, ph_hi; };

typedef float f32x2 __attribute__((ext_vector_type(2)));
typedef unsigned u32x2 __attribute__((ext_vector_type(2)));
typedef unsigned u32x4 __attribute__((ext_vector_type(4)));
__device__ __forceinline__ float wave_sum(float v) {
#pragma unroll
    for (int o = 1; o < 64; o <<= 1) v += __shfl_xor(v, o);
    return v;
}
__device__ __forceinline__ float bf_lo(unsigned w) { return __builtin_bit_cast(float, w << 16); }
__device__ __forceinline__ float bf_hi(unsigned w) { return __builtin_bit_cast(float, w & 0xffff0000u); }
__device__ __forceinline__ unsigned cvtpk(float lo, float hi) { unsigned r; asm volatile("v_cvt_pk_bf16_f32 %0, %1, %2" : "=v"(r) : "v"(lo), "v"(hi)); return r; }

#ifndef XN_IMG
#define XN_IMG 1
#endif
__device__ __forceinline__ int perm32_inv(int x) { return 16 * ((x >> 2) & 1) + 4 * (x >> 3) + (x & 3); }
__device__ __forceinline__ void conv_tile(const float* __restrict__ W, int N, bf16* __restrict__ Wt, int K, int k0, int n0, int drow0, LAS unsigned* scr, int lane, int tiled_rows = 0, bool perm = false) {
    const int kpl = lane >> 4, ng = lane & 15;
#pragma unroll 4
    for (int i = 0; i < 8; ++i) {
        const int kp = 4 * i + kpl;
        const float* src = W + (size_t)(k0 + 2 * kp) * N + n0 + 4 * ng;
        const f32x4 a = *(const f32x4*)src, b = *(const f32x4*)(src + N);
        LAS unsigned* d = scr + (4 * ng) * 33 + kp;
        d[0] = pk2(a.x, b.x); d[33] = pk2(a.y, b.y); d[66] = pk2(a.z, b.z); d[99] = pk2(a.w, b.w);
    }
    LDS_WAIT(); asm volatile("" ::: "memory");
    const int c = lane & 7;
#pragma unroll
    for (int j = 0; j < 8; ++j) { const int n = (lane >> 3) + 8 * j; const LAS unsigned* s = scr + n * 33 + 4 * c;
        v4u o; o.x = s[0]; o.y = s[1]; o.z = s[2]; o.w = s[3];
        const int jr = drow0 + n, jl = jr & 127, R = perm ? ((jl & ~31) + perm32_inv(jl & 31)) : jl;
        bf16* dp = tiled_rows ? (bf16*)((char*)Wt + ((size_t)(k0 >> 6) * (tiled_rows >> 7) + (jr >> 7)) * pg8::HTB + pg8::lds_byte(R, 8 * c)) : Wt + (size_t)(drow0 + n) * K + k0 + 8 * c;
        *(GAS v4u*)dp = o; }
    LDS_WAIT(); asm volatile("" ::: "memory");
}
__device__ __forceinline__ void conv_mat_tile(const float* W, int K, int N, bf16* Wt, int mode, int r, LAS unsigned* scr, int lane, int tiled_rows = 0, bool perm = false) {
    const int nblk = N / 64, kb = r / nblk, nb = r % nblk, n0 = 64 * nb;
    int drow0 = n0;
    if (mode == 1) { const int half = n0 >= DFF ? 1 : 0, nn = n0 - half * DFF; drow0 = (nn >> 7) * 256 + half * 128 + (nn & 127); }
    conv_tile(W, N, Wt, K, 64 * kb, n0, drow0, scr, lane, tiled_rows, perm);
}
constexpr int T_WIN = (DM / 64) * (2 * DFF / 64), T_WOUT = (DFF / 64) * (DM / 64), T_ABIN = (DM / 64) * (ABW / 64), T_SQ = (DM / 64) * (DM / 64), T_RGIN = (DM / 64) * (RGW / 64), T_GATE = 64 * 4;
constexpr int T_TOTAL = 4 * T_WIN + 4 * T_WOUT + T_ABIN + T_SQ + T_RGIN + T_SQ + T_GATE;

constexpr int TL_WIN = 0, TL_WOUT = 4 * T_WIN, TL_ABIN = TL_WOUT + 4 * T_WOUT, TL_ABOUT = TL_ABIN + T_ABIN, TL_RGIN = TL_ABOUT + T_SQ, TL_RGOUT = TL_RGIN + T_RGIN, TL_GATE = TL_RGOUT + T_SQ;
static_assert(TL_GATE + T_GATE == T_TOTAL, "tile list");
__device__ __forceinline__ void convert_ranges(const Args& a, unsigned char* ws, LAS unsigned char* lds, int a0, int a1, int b0, int b1, int widx, int nw, int wave, int lane) {
    LAS unsigned* scr = (LAS unsigned*)(lds + 49152 + wave * 8704);
    const int na = a1 - a0, ntot = na + (b1 - b0);
    for (int it = widx; it < ntot; it += nw) {
        int r = it < na ? a0 + it : b0 + (it - na);
        if (r < 4 * T_WIN) { const int s = r / T_WIN; r -= s * T_WIN; const int l = s >> 1;
            const float* W = ((s & 1) ? a.in[I_F2IN] : a.in[I_F1IN]) + (size_t)l * DM * 2 * DFF;
            conv_mat_tile(W, DM, 2 * DFF, (bf16*)(ws + WS_WIN + (size_t)s * WIN_BYTES), 1, r, scr, lane, XN_IMG ? 2 * DFF : 0, true); continue; }
        r -= 4 * T_WIN;
        if (r < 4 * T_WOUT) { const int s = r / T_WOUT; r -= s * T_WOUT; const int l = s >> 1;
            const float* W = ((s & 1) ? a.in[I_F2OUT] : a.in[I_F1OUT]) + (size_t)l * DFF * DM;
            conv_mat_tile(W, DFF, DM, (bf16*)(ws + WS_WOUT + (size_t)s * WOUT_BYTES), 0, r, scr, lane, DM, true); continue; }
        r -= 4 * T_WOUT;
        if (r < T_ABIN) { conv_mat_tile(a.in[I_ABIN], DM, ABW, (bf16*)(ws + WS_WABIN), 0, r, scr, lane, XN_IMG ? ABW : 0, true); continue; }
        r -= T_ABIN;
        if (r < T_SQ) { conv_mat_tile(a.in[I_ABOUT], DM, DM, (bf16*)(ws + WS_WABOUT), 0, r, scr, lane); continue; }
        r -= T_SQ;
        if (r < T_RGIN) { conv_mat_tile(a.in[I_RGIN], DM, RGW, (bf16*)(ws + WS_WRGIN), 0, r, scr, lane, XN_IMG ? RGW : 0, true); continue; }
        r -= T_RGIN;
        if (r < T_SQ) { conv_mat_tile(a.in[I_RGOUT], DM, DM, (bf16*)(ws + WS_WRGOUT), 0, r, scr, lane); continue; }
        r -= T_SQ;
        {
            const int mi = r >> 2, t = r & 3, d = mi >> 5, g = (mi >> 4) & 1, h = mi & 15;
            const float* W = (g ? a.in[I_RGWX] : a.in[I_RGWA]) + (size_t)(d * 16 + h) * 128 * 128;
            conv_mat_tile(W, 128, 128, (bf16*)(ws + WS_WGATE) + (size_t)mi * 128 * 128, 0, t, scr, lane);
        }
    }
}
template <int UNR = 16> __device__ __forceinline__ void mod_gemv_task(const Args& a, unsigned char* ws, LAS unsigned char* lds, int t, int tid, int wave, int lane) {
    LAS float* SC = (LAS float*)lds;
    LAS float* RED = (LAS float*)(lds + 24576);
    const int l = t / 144, cb = t % 144, n = 128 * cb + 2 * lane;
    const float* W = a.in[I_WMOD] + ((size_t)l * DM + 256 * wave) * MODW + n;
    f32x2 acc0 = {0.f, 0.f}, acc1 = acc0, acc2 = acc0;
#pragma unroll UNR
    for (int k = 0; k < 256; ++k) {
        const f32x2 w = *(const f32x2*)(W + (size_t)k * MODW);
        const int kk = 256 * wave + k;
        acc0 += w * SC[kk]; acc1 += w * SC[2048 + kk]; acc2 += w * SC[4096 + kk];
    }
    LAS f32x2* R2 = (LAS f32x2*)RED;
    R2[(wave * 3 + 0) * 64 + lane] = acc0; R2[(wave * 3 + 1) * 64 + lane] = acc1; R2[(wave * 3 + 2) * 64 + lane] = acc2;
    __syncthreads();
    for (int o = tid; o < 384; o += NTHR) { const int v = o >> 7, j = o & 127; float s = a.in[I_BMOD][(size_t)l * MODW + 128 * cb + j];
#pragma unroll
        for (int w = 0; w < 8; ++w) s += RED[(w * 3 + v) * 128 + j];
        ((float*)(ws + WS_MOD))[((size_t)l * 3 + v) * MODW + 128 * cb + j] = s; }
    __syncthreads();
}
template <int UNR = 16> __device__ __forceinline__ void mod_gemv_tasks(const Args& a, unsigned char* ws, LAS unsigned char* lds, int t0, int t1, int worker, int nworkers, int tid, int wave, int lane) {
    if (t0 + worker >= t1) return;
    LAS float* SC = (LAS float*)lds;
    for (int i = tid; i < 3 * DM; i += NTHR) { const int v = i / DM, k = i % DM; const float c = (v < 2) ? a.in[I_C][v * DM + k] : a.in[I_CCTX][k];
        SC[i] = c / (1.0f + __expf(-c)); }
    __syncthreads();
    for (int t = t0 + worker; t < t1; t += nworkers) mod_gemv_task<UNR>(a, ws, lds, t, tid, wave, lane);
}
__device__ __forceinline__ void p0_prologue(const Args& a, unsigned char* ws, LAS unsigned char* lds, int G, int bid, int tid, int wave, int lane) {
    constexpr int NG = 144;
    if (bid < NG) mod_gemv_tasks<32>(a, ws, lds, 0, 144, bid, G < NG ? G : NG, tid, wave, lane);
    if (G > NG ? bid >= NG : bid == G - 1) {
        float* ct = (float*)(ws + WS_ROPE); float* st = ct + 4096;
        for (int i = (G > NG ? (bid - NG) * NTHR : 0) + tid; i < 4096; i += (G > NG ? (G - NG) * NTHR : NTHR)) { const int pos = i >> 5, f = i & 31; const float inv = powf(10000.0f, -(float)f / 32.0f); const float ang = (float)pos * inv;
            const float c_ = cosf(ang), s_ = sinf(ang); ct[i] = c_; st[i] = s_;
            typedef _Float16 h2v_ __attribute__((ext_vector_type(2))); const h2v_ hv_ = {(_Float16)c_, (_Float16)s_};
            ((unsigned*)(ct + 8192))[i] = __builtin_bit_cast(unsigned, hv_); }
    }
    __syncthreads();
    { constexpr int SHARE_G = 2, SHARE_O = 4;
      const int wG = NG * NWAVES, wO = (G - NG) * NWAVES, tot = wG * SHARE_G + wO * SHARE_O;
      const int gwave = bid * NWAVES + wave;
      if (G > NG) { const int first = bid < NG ? gwave * SHARE_G : wG * SHARE_G + (gwave - wG) * SHARE_O, cnt = bid < NG ? SHARE_G : SHARE_O;
          for (int q = 0; q < cnt; ++q) convert_ranges(a, ws, lds, TL_WIN, TL_WIN + T_WIN, 0, 0, first + q, tot, wave, lane); }
      else convert_ranges(a, ws, lds, TL_WIN, TL_WIN + T_WIN, 0, 0, gwave, G * NWAVES, wave, lane); }
}

__device__ __forceinline__ int ncol(int lane, int jj) { return 8 * lane + 512 * (jj >> 1) + 4 * (jj & 1); }
__device__ __forceinline__ void norm_load_vec(const float* g, const float* shift, const float* scale, int v, int lane, f32x4 (&gs)[8], f32x4 (&sh)[8]) {
#pragma unroll
    for (int j = 0; j < 8; ++j) { const int c = ncol(lane, j); const f32x4 gg = *(const f32x4*)(g + c), sc = *(const f32x4*)(scale + (size_t)v * MODW + c);
        gs[j] = gg * (sc + 1.0f); sh[j] = *(const f32x4*)(shift + (size_t)v * MODW + c); }
}
__device__ __forceinline__ void norm_finish(f32x4 (&x)[8], const f32x4 (&gs)[8], const f32x4 (&sh)[8], bf16* XNb, int row, int lane) {
    float s = 0.f;
#pragma unroll
    for (int j = 0; j < 8; ++j) s += (x[j].x * x[j].x + x[j].y * x[j].y) + (x[j].z * x[j].z + x[j].w * x[j].w);
    const float rstd = 1.0f / sqrtf(wave_sum(s) * (1.0f / DM) + EPS);
#pragma unroll
    for (int j = 0; j < 4; ++j) { const f32x4 y0 = x[2 * j] * rstd * gs[2 * j] + sh[2 * j], y1 = x[2 * j + 1] * rstd * gs[2 * j + 1] + sh[2 * j + 1];
        v4u w; w.x = cvtpk(y0.x, y0.y); w.y = cvtpk(y0.z, y0.w); w.z = cvtpk(y1.x, y1.y); w.w = cvtpk(y1.z, y1.w);
        const int col = 8 * lane + 512 * j;
        if (XN_IMG) *(v4u*)((char*)XNb + ((size_t)(col >> 6) * (MROWS >> 7) + (row >> 7)) * pg8::HTB + pg8::lds_byte(row & 127, col & 63)) = w;
        else *(v4u*)(XNb + (size_t)row * DM + col) = w; }
}
template <bool F32> __device__ __forceinline__ void norm_load_row(const void* rowp, int lane, f32x4 (&x)[8]) {
    if (F32) { const float* xr = (const float*)rowp;
#pragma unroll
        for (int j = 0; j < 8; ++j) x[j] = *(const f32x4*)(xr + ncol(lane, j)); }
    else { const bf16* xr = (const bf16*)rowp; v4u w[4];
#pragma unroll
        for (int j = 0; j < 4; ++j) w[j] = *(const v4u*)(xr + 8 * lane + 512 * j);
#pragma unroll
        for (int j = 0; j < 4; ++j) { x[2 * j] = (f32x4){bf_lo(w[j].x), bf_hi(w[j].x), bf_lo(w[j].y), bf_hi(w[j].y)}; x[2 * j + 1] = (f32x4){bf_lo(w[j].z), bf_hi(w[j].z), bf_lo(w[j].w), bf_hi(w[j].w)}; } }
}
template <bool LAT_F32, bool CTX_F32>
__device__ __forceinline__ void norm_phase(const void* srcLat, const void* srcCtx, int nrows, const float* g, const float* shift, const float* scale  , bf16* XN, int gw, int ngw, int lane,
                                           int gwalt, const float* slab = nullptr, int nslab = 0, bf16* ctxOut = nullptr, LAS unsigned char* lds_norm = nullptr) {
    f32x4 gs[8], sh[8];
    constexpr size_t LSTR = LAT_F32 ? 4 : 2, CSTR = CTX_F32 ? 4 : 2;
    { const int per = (NLAT + ngw - 1) / ngw; const int r0 = gw * per, r1 = (r0 + per < NLAT) ? r0 + per : NLAT;
      int vcur = -1;
      int row = r0;
      for (; row + 3 < r1 && ((row < SEQ) == (row + 3 < SEQ)); row += 4) {
          const int v = row < SEQ ? 0 : 1;
          if (v != vcur) { vcur = v; norm_load_vec(g, shift, scale, v, lane, gs, sh); }
          f32x4 x0[8], x1[8], x2[8], x3[8];
          norm_load_row<LAT_F32>((const char*)srcLat + (size_t)row * DM * LSTR, lane, x0); norm_load_row<LAT_F32>((const char*)srcLat + (size_t)(row + 1) * DM * LSTR, lane, x1);
          norm_load_row<LAT_F32>((const char*)srcLat + (size_t)(row + 2) * DM * LSTR, lane, x2); norm_load_row<LAT_F32>((const char*)srcLat + (size_t)(row + 3) * DM * LSTR, lane, x3);
          norm_finish(x0, gs, sh, XN, row, lane); norm_finish(x1, gs, sh, XN, row + 1, lane); norm_finish(x2, gs, sh, XN, row + 2, lane); norm_finish(x3, gs, sh, XN, row + 3, lane);
      }
      for (; row + 1 < r1 && ((row < SEQ) == (row + 1 < SEQ)); row += 2) {
          const int v = row < SEQ ? 0 : 1;
          if (v != vcur) { vcur = v; norm_load_vec(g, shift, scale, v, lane, gs, sh); }
          f32x4 x[8], y[8];
          norm_load_row<LAT_F32>((const char*)srcLat + (size_t)row * DM * LSTR, lane, x); norm_load_row<LAT_F32>((const char*)srcLat + (size_t)(row + 1) * DM * LSTR, lane, y);
          norm_finish(x, gs, sh, XN, row, lane); norm_finish(y, gs, sh, XN, row + 1, lane);
      }
      for (; row < r1; ++row) {
          const int v = row < SEQ ? 0 : 1;
          if (v != vcur) { vcur = v; norm_load_vec(g, shift, scale, v, lane, gs, sh); }
          f32x4 x[8]; norm_load_row<LAT_F32>((const char*)srcLat + (size_t)row * DM * LSTR, lane, x);
          norm_finish(x, gs, sh, XN, row, lane);
      } }
    if (nrows > NLAT) {
        LAS float* red = (LAS float*)(lds_norm);
        const int G_ = ngw / NWAVES, bid_ = gw / NWAVES, wv = gw % NWAVES, half = wv >> 2, jq = wv & 3, col = 8 * lane + 512 * jq;
        for (int c0 = bid_; c0 < NCTXR; c0 += 2 * G_) {
            const int cr = c0 + half * G_; const bool live = cr < NCTXR;
            f32x4 xa = {0.f, 0.f, 0.f, 0.f}, xb = xa;
            const f32x4 ga = *(const f32x4*)(g + col), gb = *(const f32x4*)(g + col + 4), sa = *(const f32x4*)(scale + (size_t)2 * MODW + col), sb = *(const f32x4*)(scale + (size_t)2 * MODW + col + 4);
            const f32x4 ha = *(const f32x4*)(shift + (size_t)2 * MODW + col), hb = *(const f32x4*)(shift + (size_t)2 * MODW + col + 4);
            if (live) {
                if (CTX_F32) { const float* xr = (const float*)srcCtx + (size_t)cr * DM + col; xa = *(const f32x4*)xr; xb = *(const f32x4*)(xr + 4); }
                else { const v4u w = *(const v4u*)((const bf16*)srcCtx + (size_t)cr * DM + col); xa = (f32x4){bf_lo(w.x), bf_hi(w.x), bf_lo(w.y), bf_hi(w.y)}; xb = (f32x4){bf_lo(w.z), bf_hi(w.z), bf_lo(w.w), bf_hi(w.w)}; }
                if (nslab > 0) {
                    v4u tw[11];
#pragma unroll
                    for (int q = 0; q < 11; ++q) { const int qq = q < nslab ? q : 0; tw[q] = *(const v4u*)((const bf16*)slab + ((size_t)qq * NCTXR + cr) * DM + col); }
#pragma unroll
                    for (int q = 0; q < 11; ++q) if (q < nslab) { xa += (f32x4){bf_lo(tw[q].x), bf_hi(tw[q].x), bf_lo(tw[q].y), bf_hi(tw[q].y)}; xb += (f32x4){bf_lo(tw[q].z), bf_hi(tw[q].z), bf_lo(tw[q].w), bf_hi(tw[q].w)}; }
                    v4u w; w.x = cvtpk(xa.x, xa.y); w.y = cvtpk(xa.z, xa.w); w.z = cvtpk(xb.x, xb.y); w.w = cvtpk(xb.z, xb.w);
                    *(v4u*)(ctxOut + (size_t)cr * DM + col) = w;
                    xa = (f32x4){bf_lo(w.x), bf_hi(w.x), bf_lo(w.y), bf_hi(w.y)}; xb = (f32x4){bf_lo(w.z), bf_hi(w.z), bf_lo(w.w), bf_hi(w.w)};
                }
            }
            const float part = wave_sum((xa.x * xa.x + xa.y * xa.y) + (xa.z * xa.z + xa.w * xa.w) + (xb.x * xb.x + xb.y * xb.y) + (xb.z * xb.z + xb.w * xb.w));
            if (lane == 0) red[wv] = part;
            __syncthreads();
            if (live) {
                const float tot = (red[4 * half] + red[4 * half + 1]) + (red[4 * half + 2] + red[4 * half + 3]);
                const float rstd = 1.0f / sqrtf(tot * (1.0f / DM) + EPS);
                const f32x4 y0 = xa * rstd * (ga * (sa + 1.0f)) + ha, y1 = xb * rstd * (gb * (sb + 1.0f)) + hb;
                v4u w; w.x = cvtpk(y0.x, y0.y); w.y = cvtpk(y0.z, y0.w); w.z = cvtpk(y1.x, y1.y); w.w = cvtpk(y1.z, y1.w);
                const int row = NLAT + cr;
                if (XN_IMG) *(v4u*)((char*)XN + ((size_t)(col >> 6) * (MROWS >> 7) + (row >> 7)) * pg8::HTB + pg8::lds_byte(row & 127, col & 63)) = w;
                else *(v4u*)(XN + (size_t)row * DM + col) = w;
            }
            __syncthreads();
        }
    }
}
__device__ __forceinline__ void final_norm_phase(const bf16* X, const float* g, float* out, int gw, int ngw, int lane) {
    f32x4 gg[8];
#pragma unroll
    for (int j = 0; j < 8; ++j) gg[j] = *(const f32x4*)(g + ncol(lane, j));
    for (int row = gw; row < NLAT; row += ngw) {
        f32x4 x[8]; float s = 0.f; norm_load_row<false>(X + (size_t)row * DM, lane, x);
#pragma unroll
        for (int j = 0; j < 8; ++j) s += (x[j].x * x[j].x + x[j].y * x[j].y) + (x[j].z * x[j].z + x[j].w * x[j].w);
        const float rstd = 1.0f / sqrtf(wave_sum(s) * (1.0f / DM) + EPS);
#pragma unroll
        for (int j = 0; j < 8; ++j) *(f32x4*)(out + (size_t)row * DM + ncol(lane, j)) = x[j] * rstd * gg[j];
    }
}

typedef float f32x16 __attribute__((ext_vector_type(16)));
typedef short s16x4 __attribute__((ext_vector_type(4)));
constexpr int KSTR = 136, VSTR = 160;
constexpr int AT_K = 0, AT_V = 64 * KSTR * 2, AT_BUF = AT_V + 64 * VSTR * 2  , AT_WS = 2 * AT_BUF, AT_END = AT_WS + NWAVES * 256;
#define AT_LDS_BAR() do { asm volatile("s_waitcnt lgkmcnt(0)" ::: "memory"); __builtin_amdgcn_s_barrier(); asm volatile("" ::: "memory"); } while (0)
constexpr float ATT_C2 = 0.08838834764831845f * 1.4426950408889634f;
constexpr float LOG2E = 1.4426950408889634f;
__device__ __forceinline__ int crow(int r, int hi) { return (r & 3) + 8 * (r >> 2) + 4 * hi; }

__device__ __forceinline__ void rope_pair(v4u& p1, v4u& p2, const float* ropeC, const float* ropeS, int pos, int f0) {
    const f32x4 c0 = *(const f32x4*)(ropeC + pos * 32 + f0), c1 = *(const f32x4*)(ropeC + pos * 32 + f0 + 4);
    const f32x4 s0 = *(const f32x4*)(ropeS + pos * 32 + f0), s1 = *(const f32x4*)(ropeS + pos * 32 + f0 + 4);
    const float cc[8] = {c0.x, c0.y, c0.z, c0.w, c1.x, c1.y, c1.z, c1.w}, ss[8] = {s0.x, s0.y, s0.z, s0.w, s1.x, s1.y, s1.z, s1.w};
    unsigned a[4] = {p1.x, p1.y, p1.z, p1.w}, b[4] = {p2.x, p2.y, p2.z, p2.w};
#pragma unroll
    for (int i = 0; i < 4; ++i) {
        const float x1l = bf_lo(a[i]), x1h = bf_hi(a[i]), x2l = bf_lo(b[i]), x2h = bf_hi(b[i]);
        a[i] = cvtpk(x1l * cc[2 * i] - x2l * ss[2 * i], x1h * cc[2 * i + 1] - x2h * ss[2 * i + 1]);
        b[i] = cvtpk(x2l * cc[2 * i] + x1l * ss[2 * i], x2h * cc[2 * i + 1] + x1h * ss[2 * i + 1]);
    }
    p1 = (v4u){a[0], a[1], a[2], a[3]}; p2 = (v4u){b[0], b[1], b[2], b[3]};
}

__device__ __forceinline__ void rope_pair_pre(v4u& p1, v4u& p2, const f32x4& c0, const f32x4& c1, const f32x4& s0, const f32x4& s1) {
    const float cc[8] = {c0.x, c0.y, c0.z, c0.w, c1.x, c1.y, c1.z, c1.w}, ss[8] = {s0.x, s0.y, s0.z, s0.w, s1.x, s1.y, s1.z, s1.w};
    unsigned a[4] = {p1.x, p1.y, p1.z, p1.w}, b[4] = {p2.x, p2.y, p2.z, p2.w};
#pragma unroll
    for (int i = 0; i < 4; ++i) {
        const float x1l = bf_lo(a[i]), x1h = bf_hi(a[i]), x2l = bf_lo(b[i]), x2h = bf_hi(b[i]);
        a[i] = cvtpk(x1l * cc[2 * i] - x2l * ss[2 * i], x1h * cc[2 * i + 1] - x2h * ss[2 * i + 1]);
        b[i] = cvtpk(x2l * cc[2 * i] + x1l * ss[2 * i], x2h * cc[2 * i + 1] + x1h * ss[2 * i + 1]);
    }
    p1 = (v4u){a[0], a[1], a[2], a[3]}; p2 = (v4u){b[0], b[1], b[2], b[3]};
}

typedef _Float16 h2v __attribute__((ext_vector_type(2)));
__device__ __forceinline__ void rope_pair_h(v4u& p1, v4u& p2, const v4u& ra, const v4u& rb) {
    const unsigned t[8] = {ra.x, ra.y, ra.z, ra.w, rb.x, rb.y, rb.z, rb.w};
    unsigned a[4] = {p1.x, p1.y, p1.z, p1.w}, b[4] = {p2.x, p2.y, p2.z, p2.w};
#pragma unroll
    for (int i = 0; i < 4; ++i) {
        const h2v t0 = __builtin_bit_cast(h2v, t[2 * i]), t1 = __builtin_bit_cast(h2v, t[2 * i + 1]);
        const float c0 = (float)t0.x, s0 = (float)t0.y, c1 = (float)t1.x, s1 = (float)t1.y;
        const float x1l = bf_lo(a[i]), x1h = bf_hi(a[i]), x2l = bf_lo(b[i]), x2h = bf_hi(b[i]);
        a[i] = cvtpk(x1l * c0 - x2l * s0, x1h * c1 - x2h * s1);
        b[i] = cvtpk(x2l * c0 + x1l * s0, x2h * c1 + x1h * s1);
    }
    p1 = (v4u){a[0], a[1], a[2], a[3]}; p2 = (v4u){b[0], b[1], b[2], b[3]};
}

__device__ __forceinline__ void attn_unit(const bf16* __restrict__ PROJ, bf16* __restrict__ MIX, const float* sink, const float* ropeC, const float* ropeS,
                                          LAS unsigned char* lds, int u, int tid, int wave, int lane) {
    const bool isctx = u >= 512;
    int b, kvh, qb;
    if (!isctx) { b = u >> 8; kvh = (u >> 7) & 1; qb = u & 127; } else { const int uu = u - 512; b = uu >> 3; kvh = (uu >> 2) & 1; qb = uu & 3; }
    const int g = wave >> 1, rg = wave & 1, head = kvh * 4 + g;
    const int r32 = lane & 31, hi = lane >> 5;
    const size_t seqbase = isctx ? (size_t)NLAT + (size_t)b * CTXL : (size_t)b * SEQ;
    const size_t ctxbase = (size_t)NLAT + (size_t)b * CTXL;
    const int qpos = 64 * qb + 32 * rg + r32;
    const int srow = tid >> 3, sc = (tid & 3) + 8 * ((tid >> 2) & 1);
    const int t_lo = isctx ? 5 : 0;
    v4u kA, kB, vA, vB; bool kropeS = false; v4u rA, rB; const unsigned* ropeH = (const unsigned*)(ropeC + 8192);
    int tl_lo = 5, nloc = 0;
    if (!isctx) { tl_lo = 0; while (64 * qb - 128 + 64 * tl_lo < 0) ++tl_lo; int tl_hi = 4; while (64 * qb - 128 + 64 * tl_hi >= SEQ) --tl_hi; nloc = tl_hi - tl_lo + 1; }
    const int ntile = nloc + 4;
#define AT_FENCE() do { asm volatile("" ::: "memory"); __builtin_amdgcn_sched_barrier(0); } while (0)
#define AT_KF(j) (*(const LAS bf16x8*)(kb + 32 * ((j) >> 1) + ((j) & 1) * (32 * (KSTR * 2))))
#define AT_VLO(gq, d) __builtin_bit_cast(s16x4, __builtin_amdgcn_ds_read_tr16_b64_v4i16((LAS s16x4*)(vb + (16 * (gq)) * (VSTR * 2) + 64 * (d))))
#define AT_VHH(gq, d) __builtin_bit_cast(s16x4, __builtin_amdgcn_ds_read_tr16_b64_v4i16((LAS s16x4*)(vb + (16 * (gq) + 8) * (VSTR * 2) + 64 * (d))))
#define AT_TILE(i) ((i) < nloc ? tl_lo + (i) : 5 + ((i) - nloc))
#define AT_LOAD(t) do { const bool loc_ = (t) < 5; const int kp_ = loc_ ? (64 * qb - 128 + 64 * (t) + srow) : (64 * ((t) - 5) + srow); \
        const bf16* kr_ = PROJ + ((loc_ ? seqbase : ctxbase) + kp_) * ABW + 1024 + 128 * kvh + 8 * sc; \
        kA = *(const v4u*)kr_; kB = *(const v4u*)(kr_ + 32); vA = *(const v4u*)(kr_ + 256); vB = *(const v4u*)(kr_ + 288); kropeS = loc_; \
        if (loc_) { const int ro_ = ((sc >> 3) ? (kp_ & 63) : (kp_ >> 6)) * 32 + 8 * (sc & 3); rA = *(const v4u*)(ropeH + ro_); rB = *(const v4u*)(ropeH + ro_ + 4); } } while (0)
#define AT_STORE(buf) do { LAS unsigned char* tb_ = lds + (buf) * AT_BUF; \
        if (kropeS) rope_pair_h(kA, kB, rA, rB); \
        *(LAS v4u*)(tb_ + AT_K + srow * (KSTR * 2) + 16 * sc) = kA; *(LAS v4u*)(tb_ + AT_K + srow * (KSTR * 2) + 16 * (sc + 4)) = kB; \
        *(LAS v4u*)(tb_ + AT_V + srow * (VSTR * 2) + 16 * sc) = vA; *(LAS v4u*)(tb_ + AT_V + srow * (VSTR * 2) + 16 * (sc + 4)) = vB; } while (0)
    AT_LOAD(AT_TILE(0));
    v4u qraw[8];
    { const bf16* qrow = PROJ + (seqbase + qpos) * ABW + head * HD + 8 * hi;
#pragma unroll
      for (int kk = 0; kk < 8; ++kk) qraw[kk] = *(const v4u*)(qrow + 16 * kk); }
    if (!isctx) {
        rope_pair(qraw[0], qraw[2], ropeC, ropeS, qpos >> 6, 8 * hi);
        rope_pair(qraw[1], qraw[3], ropeC, ropeS, qpos >> 6, 16 + 8 * hi);
        rope_pair(qraw[4], qraw[6], ropeC, ropeS, qpos & 63, 8 * hi);
        rope_pair(qraw[5], qraw[7], ropeC, ropeS, qpos & 63, 16 + 8 * hi);
    }
    bf16x8 qf[8];
#pragma unroll
    for (int kk = 0; kk < 8; ++kk) qf[kk] = __builtin_bit_cast(bf16x8, qraw[kk]);
    AT_FENCE();
    float m_run = sink[head] * LOG2E, l_run = 1.0f;
    f32x16 O[4];
#pragma unroll
    for (int d = 0; d < 4; ++d)
#pragma unroll
        for (int r = 0; r < 16; ++r) O[d][r] = 0.f;
    LAS float* wsf = (LAS float*)(lds + AT_WS) + wave * 64;
    AT_LDS_BAR();
    AT_STORE(0);
    if (ntile > 1) AT_LOAD(AT_TILE(1));
    AT_LDS_BAR();
#pragma unroll 1
    for (int it = 0; it < ntile; ++it) {
        const int tcur = AT_TILE(it);
        const LAS unsigned char* tb = lds + (it & 1) * AT_BUF;
        const LAS unsigned char* kb = tb + AT_K + r32 * (KSTR * 2) + 16 * hi;
        bf16x8 kf[8];
#pragma unroll
        for (int j = 0; j < 8; ++j) kf[j] = AT_KF(j);
        AT_FENCE();
        if (it + 1 < ntile) AT_STORE((it + 1) & 1);
        if (it + 2 < ntile) AT_LOAD(AT_TILE(it + 2));
        f32x16 p0, p1;
#pragma unroll
        for (int r = 0; r < 16; ++r) { p0[r] = 0.f; p1[r] = 0.f; }
#pragma unroll
        for (int kk = 0; kk < 8; ++kk) {
            p0 = __builtin_amdgcn_mfma_f32_32x32x16_bf16(kf[2 * (kk & 3)], qf[kk], p0, 0, 0, 0);
            p1 = __builtin_amdgcn_mfma_f32_32x32x16_bf16(kf[2 * (kk & 3) + 1], qf[kk], p1, 0, 0, 0);
            if (kk < 4) { kf[2 * kk] = AT_KF(2 * (kk + 4)); kf[2 * kk + 1] = AT_KF(2 * (kk + 4) + 1); AT_FENCE(); }
        }
        AT_FENCE();
        const LAS unsigned char* vb = tb + AT_V + (4 * hi + ((lane & 15) >> 2)) * (VSTR * 2) + (16 * ((lane >> 4) & 1) + 4 * (lane & 3)) * 2;
        s16x4 vlo[2][4], vhh[2][4];
#pragma unroll
        for (int d = 0; d < 4; ++d) { vlo[0][d] = AT_VLO(0, d); vhh[0][d] = AT_VHH(0, d); }
        AT_FENCE();
        const int qrel = 32 * rg + r32;
        if (tcur == 0) {
#pragma unroll
            for (int r = 0; r < 16; ++r) { const int kv0 = crow(r, hi); if (kv0 < qrel) p0[r] = -INFINITY; if (kv0 + 32 < qrel) p1[r] = -INFINITY; } }
        if (tcur == 4) {
#pragma unroll
            for (int r = 0; r < 16; ++r) { const int kv0 = crow(r, hi); if (kv0 > qrel) p0[r] = -INFINITY; if (kv0 + 32 > qrel) p1[r] = -INFINITY; } }
        float mx = fmaxf(p0[0], p1[0]);
#pragma unroll
        for (int r = 1; r < 16; ++r) mx = fmaxf(mx, fmaxf(p0[r], p1[r]));
        { const auto rr = __builtin_amdgcn_permlane32_swap(__float_as_uint(mx), __float_as_uint(mx), false, false); mx = fmaxf(__uint_as_float(rr[0]), __uint_as_float(rr[1])); }
        const float cand = mx * ATT_C2; const bool grow = cand > m_run + 8.0f;
        const float m_new = grow ? cand : m_run;
        float rs = 0.f;
#pragma unroll
        for (int r = 0; r < 16; ++r) { p0[r] = __builtin_amdgcn_exp2f(p0[r] * ATT_C2 - m_new); p1[r] = __builtin_amdgcn_exp2f(p1[r] * ATT_C2 - m_new); rs += p0[r] + p1[r]; }
        { const auto rr = __builtin_amdgcn_permlane32_swap(__float_as_uint(rs), __float_as_uint(rs), false, false); rs = __uint_as_float(rr[0]) + __uint_as_float(rr[1]); }
        if (__any(grow)) {
            const float alpha = __builtin_amdgcn_exp2f(m_run - m_new);
            l_run = l_run * alpha + rs; m_run = m_new;
            if (hi == 0) wsf[r32] = alpha;
            LDS_WAIT(); asm volatile("" ::: "memory");
            float al[16];
#pragma unroll
            for (int r = 0; r < 16; ++r) al[r] = wsf[crow(r, hi)];
#pragma unroll
            for (int d = 0; d < 4; ++d)
#pragma unroll
                for (int r = 0; r < 16; ++r) O[d][r] *= al[r];
            LDS_WAIT(); asm volatile("" ::: "memory");
        } else l_run += rs;
#pragma unroll
        for (int d = 0; d < 4; ++d) { vlo[1][d] = AT_VLO(1, d); vhh[1][d] = AT_VHH(1, d); }
        AT_FENCE();
#pragma unroll
        for (int gq = 0; gq < 4; ++gq) {
            const int half = gq >> 1, s = gq & 1;
            u32x4 pw;
            if (half == 0) { pw.x = cvtpk(p0[8 * s + 0], p0[8 * s + 1]); pw.y = cvtpk(p0[8 * s + 2], p0[8 * s + 3]); pw.z = cvtpk(p0[8 * s + 4], p0[8 * s + 5]); pw.w = cvtpk(p0[8 * s + 6], p0[8 * s + 7]); }
            else           { pw.x = cvtpk(p1[8 * s + 0], p1[8 * s + 1]); pw.y = cvtpk(p1[8 * s + 2], p1[8 * s + 3]); pw.z = cvtpk(p1[8 * s + 4], p1[8 * s + 5]); pw.w = cvtpk(p1[8 * s + 6], p1[8 * s + 7]); }
            const bf16x8 pa = __builtin_bit_cast(bf16x8, pw);
#pragma unroll
            for (int d = 0; d < 4; ++d) {
                const s16x4 lo = vlo[gq & 1][d], hh = vhh[gq & 1][d];
                const bf16x8 vf = (bf16x8){lo[0], lo[1], lo[2], lo[3], hh[0], hh[1], hh[2], hh[3]};
                O[d] = __builtin_amdgcn_mfma_f32_32x32x16_bf16(pa, vf, O[d], 0, 0, 0);
                if (gq < 2) { vlo[gq & 1][d] = AT_VLO(gq + 2, d); vhh[gq & 1][d] = AT_VHH(gq + 2, d); AT_FENCE(); }
            }
        }
        AT_LDS_BAR();
    }
#undef AT_TILE
#undef AT_FENCE
#undef AT_KF
#undef AT_VLO
#undef AT_VHH
#undef AT_STORE
#undef AT_LOAD
    if (hi == 0) wsf[32 + r32] = 1.0f / l_run;
    LDS_WAIT(); asm volatile("" ::: "memory");
    { LAS bf16* stg = (LAS bf16*)(lds + wave * 8704);
#pragma unroll
      for (int r = 0; r < 16; ++r) { const int q = crow(r, hi); const float il = wsf[32 + q];
#pragma unroll
          for (int d = 0; d < 4; ++d) stg[q * 136 + 32 * d + r32] = (bf16)f2bf(O[d][r] * il); }
      LDS_WAIT(); asm volatile("" ::: "memory");
      bf16* obase = MIX + (seqbase + 64 * qb + 32 * rg) * DM + head * HD;
#pragma unroll
      for (int j = 0; j < 8; ++j) { const int i = lane + 64 * j, row = i >> 4, ch = i & 15;
          const v4u w = *(const LAS v4u*)(stg + row * 136 + 8 * ch);
          *(v4u*)(obase + (size_t)row * DM + 8 * ch) = w; }
      LDS_WAIT(); asm volatile("" ::: "memory"); }
}

__device__ __forceinline__ void sconv_item_load(const bf16* __restrict__ PROJ, int it, v4u& bgv, v4u (&cg)[3], v4u (&uu)[3], float (&msk)[3]) {
    const int row = it >> 7, c = (it & 127) * 8;
    int pos, len; if (row < NLAT) { pos = row & (SEQ - 1); len = SEQ; } else { pos = (row - NLAT) & (CTXL - 1); len = CTXL; }
    const bf16* pr = PROJ + (size_t)row * ABW;
    bgv = *(const v4u*)(pr + 1536 + c);
#pragma unroll
    for (int k = 0; k < 3; ++k) { const int p2 = pos + k - 1; const bool ok = (p2 >= 0 && p2 < len); const bf16* q = pr + (ok ? (ptrdiff_t)(k - 1) * ABW : 0);
        cg[k] = *(const v4u*)(q + 2560 + c); uu[k] = *(const v4u*)(q + 3584 + c); msk[k] = ok ? 1.0f : 0.0f; }
}
__device__ __forceinline__ void sconv_item_finish(bf16* __restrict__ MIX, const float* cw, int it, const v4u& bgv, const v4u (&cg)[3], const v4u (&uu)[3], const float (&msk)[3]) {
    const int row = it >> 7, c = (it & 127) * 8;
    float acc[8];
#pragma unroll
    for (int j = 0; j < 8; ++j) acc[j] = 0.f;
#pragma unroll
    for (int k = 0; k < 3; ++k) {
        const f32x4 w0 = *(const f32x4*)(cw + k * 1024 + c) * msk[k], w1 = *(const f32x4*)(cw + k * 1024 + c + 4) * msk[k];
        const unsigned cgw[4] = {cg[k].x, cg[k].y, cg[k].z, cg[k].w}, uw[4] = {uu[k].x, uu[k].y, uu[k].z, uu[k].w};
        const float ww[8] = {w0.x, w0.y, w0.z, w0.w, w1.x, w1.y, w1.z, w1.w};
#pragma unroll
        for (int i = 0; i < 4; ++i) { acc[2 * i] += ww[2 * i] * (bf_lo(cgw[i]) * bf_lo(uw[i])); acc[2 * i + 1] += ww[2 * i + 1] * (bf_hi(cgw[i]) * bf_hi(uw[i])); }
    }
    const unsigned bw[4] = {bgv.x, bgv.y, bgv.z, bgv.w};
    v4u o;
    o.x = cvtpk(acc[0] * bf_lo(bw[0]), acc[1] * bf_hi(bw[0])); o.y = cvtpk(acc[2] * bf_lo(bw[1]), acc[3] * bf_hi(bw[1]));
    o.z = cvtpk(acc[4] * bf_lo(bw[2]), acc[5] * bf_hi(bw[2])); o.w = cvtpk(acc[6] * bf_lo(bw[3]), acc[7] * bf_hi(bw[3]));
    *(v4u*)(MIX + (size_t)row * DM + 1024 + c) = o;
}
__device__ __forceinline__ void sconv_items(const bf16* __restrict__ PROJ, bf16* __restrict__ MIX, const float* cw  , int gtid, int ngt) {
    constexpr int NIT = MROWS * 128;
    int it = gtid;
    for (; it + ngt < NIT; it += 2 * ngt) {
        v4u bA, cA[3], uA[3], bB, cB[3], uB[3]; float mA[3], mB[3];
        sconv_item_load(PROJ, it, bA, cA, uA, mA); sconv_item_load(PROJ, it + ngt, bB, cB, uB, mB);
        sconv_item_finish(MIX, cw, it, bA, cA, uA, mA); sconv_item_finish(MIX, cw, it + ngt, bB, cB, uB, mB);
    }
    if (it < NIT) { v4u bA, cA[3], uA[3]; float mA[3]; sconv_item_load(PROJ, it, bA, cA, uA, mA); sconv_item_finish(MIX, cw, it, bA, cA, uA, mA); }
}

__device__ __forceinline__ void sconv_strips(const bf16* __restrict__ PROJ, bf16* __restrict__ MIX, const float* cw  , int gtid, int ngt) {
    constexpr int R = 18, NGRP = (MROWS + R - 1) / R, NTASK = NGRP * 128;
    for (int task = gtid; task < NTASK; task += ngt) {
        const int grp = __builtin_amdgcn_readfirstlane(task >> 7), c = (task & 127) * 8;
        const int r0 = grp * R;
        float w[3][8];
#pragma unroll
        for (int k = 0; k < 3; ++k) { const f32x4 a = *(const f32x4*)(cw + k * 1024 + c), b = *(const f32x4*)(cw + k * 1024 + c + 4);
            w[k][0] = a.x; w[k][1] = a.y; w[k][2] = a.z; w[k][3] = a.w; w[k][4] = b.x; w[k][5] = b.y; w[k][6] = b.z; w[k][7] = b.w; }
        v4u cgq[4], uq[4], bgq[4];
#define SC_LOAD(slot, j) do { int rr_ = r0 + (j); rr_ = rr_ < 0 ? 0 : (rr_ >= MROWS ? MROWS - 1 : rr_); const bf16* pr_ = PROJ + (size_t)rr_ * ABW + c; \
        bgq[slot] = *(const v4u*)(pr_ + 1536); cgq[slot] = *(const v4u*)(pr_ + 2560); uq[slot] = *(const v4u*)(pr_ + 3584); } while (0)
        SC_LOAD(0, -1); SC_LOAD(1, 0); SC_LOAD(2, 1); SC_LOAD(3, 2);
        float P0[8], P1[8], P2[8]; v4u B1 = (v4u){0u, 0u, 0u, 0u}, B2;
#pragma unroll
        for (int i = 0; i < 8; ++i) { P0[i] = 0.f; P1[i] = 0.f; }
#pragma unroll 1
        for (int jb = -1; jb < R + 1; jb += 4) {
#pragma unroll
            for (int q = 0; q < 4; ++q) {
                const int j = jb + q;
                { const unsigned cgw[4] = {cgq[q].x, cgq[q].y, cgq[q].z, cgq[q].w}, uw[4] = {uq[q].x, uq[q].y, uq[q].z, uq[q].w};
#pragma unroll
                  for (int i = 0; i < 4; ++i) { P2[2 * i] = bf_lo(cgw[i]) * bf_lo(uw[i]); P2[2 * i + 1] = bf_hi(cgw[i]) * bf_hi(uw[i]); }
                  B2 = bgq[q]; }
                if (j + 4 <= R) SC_LOAD(q, j + 4);
                const int orow = r0 + j - 1;
                if (j >= 1 && orow < MROWS) {
                    int pos, len; if (orow < NLAT) { pos = orow & (SEQ - 1); len = SEQ; } else { pos = (orow - NLAT) & (CTXL - 1); len = CTXL; }
                    float acc[8];
#pragma unroll
                    for (int i = 0; i < 8; ++i) acc[i] = 0.f;
                    if (pos > 0) {
#pragma unroll
                        for (int i = 0; i < 8; ++i) acc[i] += w[0][i] * P0[i]; }
#pragma unroll
                    for (int i = 0; i < 8; ++i) acc[i] += w[1][i] * P1[i];
                    if (pos < len - 1) {
#pragma unroll
                        for (int i = 0; i < 8; ++i) acc[i] += w[2][i] * P2[i]; }
                    const unsigned bw[4] = {B1.x, B1.y, B1.z, B1.w};
                    v4u o;
                    o.x = cvtpk(acc[0] * bf_lo(bw[0]), acc[1] * bf_hi(bw[0])); o.y = cvtpk(acc[2] * bf_lo(bw[1]), acc[3] * bf_hi(bw[1]));
                    o.z = cvtpk(acc[4] * bf_lo(bw[2]), acc[5] * bf_hi(bw[2])); o.w = cvtpk(acc[6] * bf_lo(bw[3]), acc[7] * bf_hi(bw[3]));
                    *(v4u*)(MIX + (size_t)orow * DM + 1024 + c) = o;
                }
#pragma unroll
                for (int i = 0; i < 8; ++i) { P0[i] = P1[i]; P1[i] = P2[i]; }
                B1 = B2;
            }
        }
#undef SC_LOAD
    }
}

constexpr int UCF_STR = 132;
constexpr int SC_UC_BYTES = 32 * UCF_STR * 4 + 32 * KSTR * 2;
constexpr int SC_UC0 = 0, SC_Y = 2 * SC_UC_BYTES, SC_END = SC_Y + 2 * 32 * 128 * 4;
static_assert(SC_END <= RING_BYTES && (SC_UC_BYTES % 16) == 0 && ((32 * UCF_STR * 4) % 16) == 0, "scan LDS map");
__device__ __forceinline__ float sigmoid_f(float x) { return __builtin_amdgcn_rcpf(1.0f + __builtin_amdgcn_exp2f(-1.4426950408889634f * x)); }
__device__ __forceinline__ float neg_expm1_small(float x) { float p = 1.0f + x * (1.0f / 6.0f); p = 1.0f + x * (1.0f / 5.0f) * p; p = 1.0f + x * 0.25f * p; p = 1.0f + x * (1.0f / 3.0f) * p; p = 1.0f + x * 0.5f * p; return -x * p; }
__device__ __forceinline__ float gelu_tanh_f(float x) { const float z = 0.7978845608028654f * (x + 0.044715f * x * x * x); const float t = 1.0f - 2.0f * __builtin_amdgcn_rcpf(__builtin_amdgcn_exp2f(2.8853900817779268f * z) + 1.0f); return 0.5f * x * (1.0f + t); }

typedef _Float16 h2_t __attribute__((ext_vector_type(2)));
__device__ __forceinline__ float lane_partner(float x, int hi) {
    const auto rr = __builtin_amdgcn_permlane32_swap(__float_as_uint(x), __float_as_uint(x), false, false);
    return __uint_as_float(hi ? rr[0] : rr[1]);
}
template <bool REV, bool WANT_H, bool WANT_P = false>
__device__ __forceinline__ void lane_scan(const float (&av)[16], const float (&bv)[16], int hi, float carry, float (&hv)[16], float& Atot, float& Htot, float* pv = nullptr) {
    float As[4], Hs[4], Ap[4], Hp[4];
#pragma unroll
    for (int k = 0; k < 4; ++k) {
        float A = 1.0f, H = 0.0f;
#pragma unroll
        for (int i = 0; i < 4; ++i) { const int r = 4 * k + (REV ? 3 - i : i); H = av[r] * H + bv[r]; A *= av[r]; }
        As[k] = A; Hs[k] = H;
    }
#pragma unroll
    for (int k = 0; k < 4; ++k) { Ap[k] = lane_partner(As[k], hi); Hp[k] = lane_partner(Hs[k], hi); }
    const bool ownFirst = REV ? (hi == 1) : (hi == 0);
    float c = carry, c0 = 0.0f, At = 1.0f; float cin[4], pin[4];
#pragma unroll
    for (int kk = 0; kk < 4; ++kk) { const int k = REV ? 3 - kk : kk;
        const float A1 = ownFirst ? As[k] : Ap[k], H1 = ownFirst ? Hs[k] : Hp[k], A2 = ownFirst ? Ap[k] : As[k], H2 = ownFirst ? Hp[k] : Hs[k];
        const float cf = c; c = A1 * c + H1; const float cs = c; c = A2 * c + H2;
        cin[k] = ownFirst ? cf : cs;
        pin[k] = ownFirst ? At : At * A1;
        c0 = A1 * c0 + H1; c0 = A2 * c0 + H2; At *= A1 * A2; }
    Atot = At; Htot = c0;
    if (WANT_H) {
#pragma unroll
        for (int k = 0; k < 4; ++k) { float hcur = cin[k], pcur = pin[k];
#pragma unroll
            for (int i = 0; i < 4; ++i) { const int r = 4 * k + (REV ? 3 - i : i); hcur = av[r] * hcur + bv[r]; hv[r] = hcur; if (WANT_P) { pcur *= av[r]; pv[r] = pcur; } } }
    }
}

#define LDS_BAR() do { asm volatile("s_waitcnt lgkmcnt(0)" ::: "memory"); __builtin_amdgcn_s_barrier(); asm volatile("" ::: "memory"); } while (0)
template <bool PASS3>
__device__ __forceinline__ void scan_unit(const Args& a, unsigned char* ws, LAS unsigned char* lds, int p, int h, int tid, int wave, int lane, int k0 = 0, int k1 = 8) {
    const bf16* PROJ2 = (const bf16*)(ws + WS_H);
    bf16* MIX = (bf16*)(ws + WS_MIX);
    float* CS = (float*)(ws + WS_CS); float* PS = (float*)(ws + WS_PS);
    const bf16* WG = (const bf16*)(ws + WS_WGATE);
    LAS float* Y = (LAS float*)(lds + SC_Y);
    const int r32 = lane & 31, hi = lane >> 5;
    const int d = wave >> 2, cq = wave & 3;
    const int cabs = h * 128 + 32 * cq + r32;
    const int pseq0 = p < 64 ? (p & ~31) : p;
    const int seqlen = p < 64 ? SEQ : CTXL;
    const int pos0 = (p - pseq0) * 256;
    bf16x8 wfa[8], wfx[8];
    { const bf16* wa = WG + ((size_t)((d * 2 + 0) * 16 + h) * 128 + 32 * cq + r32) * 128 + 8 * hi;
      const bf16* wx = WG + ((size_t)((d * 2 + 1) * 16 + h) * 128 + 32 * cq + r32) * 128 + 8 * hi;
#pragma unroll
      for (int kk = 0; kk < 8; ++kk) { wfa[kk] = *(const bf16x8*)(wa + 16 * kk); wfx[kk] = *(const bf16x8*)(wx + 16 * kk); } }
    const float ba = a.in[I_RGBA][d * DM + cabs], bx = a.in[I_RGBX][d * DM + cabs];
    const float sp8 = 8.0f * log1pf(expf(-a.in[I_RGLAM][d * DM + cabs]));
    const int ct = tid >> 4, cc = (tid & 15) * 8;
    float cwv[4][8], cbv[8];
    { const float* cwp = a.in[I_RGCONVW] + h * 128 + cc; const float* cbp = a.in[I_RGCONVB] + h * 128 + cc;
#pragma unroll
      for (int kk = 0; kk < 4; ++kk) { const f32x4 w0 = *(const f32x4*)(cwp + kk * DM), w1 = *(const f32x4*)(cwp + kk * DM + 4);
          cwv[kk][0] = w0.x; cwv[kk][1] = w0.y; cwv[kk][2] = w0.z; cwv[kk][3] = w0.w; cwv[kk][4] = w1.x; cwv[kk][5] = w1.y; cwv[kk][6] = w1.z; cwv[kk][7] = w1.w; }
      const f32x4 b0 = *(const f32x4*)cbp, b1 = *(const f32x4*)(cbp + 4);
      cbv[0] = b0.x; cbv[1] = b0.y; cbv[2] = b0.z; cbv[3] = b0.w; cbv[4] = b1.x; cbv[5] = b1.y; cbv[6] = b1.z; cbv[7] = b1.w; }
    float cin[8];
    float PA = 1.0f, PH = 0.0f;
    if (PASS3) {
        const int b = p >> 5;
        float carry = 0.0f;
        { float ca[8], chh[8];
#pragma unroll
          for (int k = 0; k < 8; ++k) { ca[k] = CS[((size_t)(((64 + b) * 8 + k) * 2 + d) * 2 + 0) * DM + cabs]; chh[k] = CS[((size_t)(((64 + b) * 8 + k) * 2 + d) * 2 + 1) * DM + cabs]; }
#pragma unroll
          for (int k = 0; k < 8; ++k) { const int kk = d ? 7 - k : k; carry = ca[kk] * carry + chh[kk]; } }
        { const int nprev = d ? (32 * b + 31 - p) : (p - 32 * b);
          for (int q0 = 0; q0 < nprev; q0 += 8) { float pa[8], ph[8];
#pragma unroll
              for (int q = 0; q < 8; ++q) { const int qq = (q0 + q < nprev) ? q0 + q : q0; const int pp = d ? (32 * b + 31 - qq) : (32 * b + qq);
                  pa[q] = PS[((size_t)(pp * 2 + d) * 2 + 0) * DM + cabs]; ph[q] = PS[((size_t)(pp * 2 + d) * 2 + 1) * DM + cabs]; }
#pragma unroll
              for (int q = 0; q < 8; ++q) if (q0 + q < nprev) carry = pa[q] * carry + ph[q]; } }
        if (d == 0) { cin[0] = carry;
#pragma unroll
            for (int k = 0; k < 7; ++k) cin[k + 1] = CS[((size_t)((p * 8 + k) * 2 + 0) * 2 + 0) * DM + cabs] * cin[k] + CS[((size_t)((p * 8 + k) * 2 + 0) * 2 + 1) * DM + cabs]; }
        else { cin[7] = carry;
#pragma unroll
            for (int k = 7; k > 0; --k) cin[k - 1] = CS[((size_t)((p * 8 + k) * 2 + 1) * 2 + 0) * DM + cabs] * cin[k] + CS[((size_t)((p * 8 + k) * 2 + 1) * 2 + 1) * DM + cabs]; }
    }
    v4u un[4], gn = {0u, 0u, 0u, 0u};
#define SC_PREFETCH(k) do { const int pos_ = pos0 + 32 * (k) + ct; const size_t row_ = (size_t)p * 256 + 32 * (k) + ct; \
        _Pragma("unroll") for (int kk = 0; kk < 4; ++kk) { const int p2 = pos_ + kk - 2; \
            un[kk] = (p2 >= 0 && p2 < seqlen) ? *(const v4u*)(PROJ2 + (size_t)((ptrdiff_t)row_ + kk - 2) * RGW + 2048 + h * 128 + cc) : (v4u){0u, 0u, 0u, 0u}; } \
        if (PASS3) gn = *(const v4u*)(PROJ2 + row_ * RGW + h * 128 + cc); } while (0)
    SC_PREFETCH(k0);
    LDS_BAR();
#pragma unroll 1
    for (int k = k0; k < k1; ++k) {
        LAS unsigned char* ucb = lds + SC_UC0 + (k & 1) * SC_UC_BYTES;
        LAS float* UCF = (LAS float*)ucb;
        const v4u gcur = gn;
        { float acc[8];
#pragma unroll
          for (int j = 0; j < 8; ++j) acc[j] = cbv[j];
#pragma unroll
          for (int kk = 0; kk < 4; ++kk) {
              const unsigned uw[4] = {un[kk].x, un[kk].y, un[kk].z, un[kk].w};
#pragma unroll
              for (int i = 0; i < 4; ++i) { acc[2 * i] += cwv[kk][2 * i] * bf_lo(uw[i]); acc[2 * i + 1] += cwv[kk][2 * i + 1] * bf_hi(uw[i]); } }
          *(LAS f32x4*)(UCF + ct * UCF_STR + cc) = (f32x4){acc[0], acc[1], acc[2], acc[3]}; *(LAS f32x4*)(UCF + ct * UCF_STR + cc + 4) = (f32x4){acc[4], acc[5], acc[6], acc[7]};
          v4u o; o.x = cvtpk(acc[0], acc[1]); o.y = cvtpk(acc[2], acc[3]); o.z = cvtpk(acc[4], acc[5]); o.w = cvtpk(acc[6], acc[7]);
          *(LAS v4u*)(ucb + 32 * UCF_STR * 4 + ct * (KSTR * 2) + cc * 2) = o; }
        LDS_BAR();
        if (k + 1 < k1) SC_PREFETCH(k + 1);
        float ucv[16];
#pragma unroll
        for (int r = 0; r < 16; ++r) ucv[r] = UCF[crow(r, hi) * UCF_STR + 32 * cq + r32];
        asm volatile("" ::: "memory");
        f32x16 gr, gi;
#pragma unroll
        for (int r = 0; r < 16; ++r) { gr[r] = 0.f; gi[r] = 0.f; }
        { const LAS unsigned char* ub = ucb + 32 * UCF_STR * 4 + r32 * (KSTR * 2) + 16 * hi;
          bf16x8 af[8];
#pragma unroll
          for (int kk = 0; kk < 8; ++kk) af[kk] = *(const LAS bf16x8*)(ub + 32 * kk);
          asm volatile("" ::: "memory"); __builtin_amdgcn_sched_barrier(0);
#pragma unroll
          for (int kk = 0; kk < 8; ++kk) {
              gr = __builtin_amdgcn_mfma_f32_32x32x16_bf16(af[kk], wfa[kk], gr, 0, 0, 0);
              gi = __builtin_amdgcn_mfma_f32_32x32x16_bf16(af[kk], wfx[kk], gi, 0, 0, 0); } }
        float av[16], bv[16]; unsigned abw[16];
#pragma unroll
        for (int r = 0; r < 16; r += 2) {
            const f32x2 xr = (f32x2){gr[r], gr[r + 1]} + ba, xi = (f32x2){gi[r], gi[r + 1]} + bx;
            const f32x2 tr = xr * -1.4426950408889634f, ti = xi * -1.4426950408889634f;
            f32x2 er, ei; er.x = __builtin_amdgcn_exp2f(tr.x); er.y = __builtin_amdgcn_exp2f(tr.y); ei.x = __builtin_amdgcn_exp2f(ti.x); ei.y = __builtin_amdgcn_exp2f(ti.y);
            const f32x2 pr = er + 1.0f, pi = ei + 1.0f, P = pr * pi;
            f32x2 inv; inv.x = __builtin_amdgcn_rcpf(P.x); inv.y = __builtin_amdgcn_rcpf(P.y);
            const f32x2 rr = pi * inv, ii = pr * inv;
            const f32x2 la = rr * -sp8, l2u = la * 1.4426950408889634f;
            f32x2 a2; a2.x = __builtin_amdgcn_exp2f(l2u.x); a2.y = __builtin_amdgcn_exp2f(l2u.y);
            const f32x2 x = la * 2.0f;
            f32x2 pp = x * 0.2f + 1.0f; pp = (x * 0.25f) * pp + 1.0f; pp = (x * (1.0f / 3.0f)) * pp + 1.0f; pp = (x * 0.5f) * pp + 1.0f;
            const f32x2 ser = -x * pp, dir = 1.0f - a2 * a2;
            f32x2 m2; m2.x = la.x > -0.25f ? ser.x : dir.x; m2.y = la.y > -0.25f ? ser.y : dir.y;
            f32x2 mult; mult.x = __builtin_amdgcn_sqrtf(m2.x); mult.y = __builtin_amdgcn_sqrtf(m2.y);
            const f32x2 uc = (f32x2){ucv[r], ucv[r + 1]};
            const f32x2 bbu = mult * ii * uc;
            av[r] = a2.x; av[r + 1] = a2.y; bv[r] = bbu.x; bv[r + 1] = bbu.y;
        }
        float hv[16], At, Ht;
        if (!PASS3) {
            float pv[16];
            if (d == 0) lane_scan<false, true, true>(av, bv, hi, 0.0f, hv, At, Ht, pv); else lane_scan<true, true, true>(av, bv, hi, 0.0f, hv, At, Ht, pv);
            if (p < 64) {
#pragma unroll
                for (int r = 0; r < 16; ++r) { h2_t w; w.x = (_Float16)hv[r]; w.y = (_Float16)pv[r]; abw[r] = __builtin_bit_cast(unsigned, w); }
                unsigned* dst = (unsigned*)(ws + WS_ABH) + ((size_t)((p * 16 + h) * 8 + k) * 8 + wave) * (64 * 16) + lane * 4;
#pragma unroll
                for (int q = 0; q < 4; ++q) *(v4u*)(dst + 256 * q) = (v4u){abw[4 * q], abw[4 * q + 1], abw[4 * q + 2], abw[4 * q + 3]};
            }
            if (hi == 0) { CS[((size_t)((p * 8 + k) * 2 + d) * 2 + 0) * DM + cabs] = At; CS[((size_t)((p * 8 + k) * 2 + d) * 2 + 1) * DM + cabs] = Ht; }
            if (d == 0) { PH = At * PH + Ht; PA *= At; } else { PH = PA * Ht + PH; PA *= At; }
        } else {
            float c0 = cin[0];
#pragma unroll
            for (int j = 1; j < 8; ++j) c0 = (k == j) ? cin[j] : c0;
            if (d == 0) lane_scan<false, true>(av, bv, hi, c0, hv, At, Ht); else lane_scan<true, true>(av, bv, hi, c0, hv, At, Ht);
#pragma unroll
            for (int r = 0; r < 16; ++r) Y[(d * 32 + crow(r, hi)) * 128 + 32 * cq + r32] = hv[r];
            LDS_BAR();
            const size_t row = (size_t)p * 256 + 32 * k + ct;
            const f32x4 y0 = *(const LAS f32x4*)(Y + ct * 128 + cc) + *(const LAS f32x4*)(Y + (32 + ct) * 128 + cc);
            const f32x4 y1 = *(const LAS f32x4*)(Y + ct * 128 + cc + 4) + *(const LAS f32x4*)(Y + (32 + ct) * 128 + cc + 4);
            v4u o;
            o.x = cvtpk(y0.x * gelu_tanh_f(bf_lo(gcur.x)), y0.y * gelu_tanh_f(bf_hi(gcur.x))); o.y = cvtpk(y0.z * gelu_tanh_f(bf_lo(gcur.y)), y0.w * gelu_tanh_f(bf_hi(gcur.y)));
            o.z = cvtpk(y1.x * gelu_tanh_f(bf_lo(gcur.z)), y1.y * gelu_tanh_f(bf_hi(gcur.z))); o.w = cvtpk(y1.z * gelu_tanh_f(bf_lo(gcur.w)), y1.w * gelu_tanh_f(bf_hi(gcur.w)));
            *(v4u*)(MIX + row * DM + h * 128 + cc) = o;
        }
    }
#undef SC_PREFETCH
    if (!PASS3 && hi == 0 && k1 - k0 == 8) { PS[((size_t)(p * 2 + d) * 2 + 0) * DM + cabs] = PA; PS[((size_t)(p * 2 + d) * 2 + 1) * DM + cabs] = PH; }
}

template <int NU>
__device__ __forceinline__ void scan_carry(const float* __restrict__ CS, const float* __restrict__ PS, const int (&pp)[NU], int d, int cabs, float (&cin)[NU][8]) {
    float carry[NU]; int nprev[NU], nmax = 0;
#pragma unroll
    for (int u = 0; u < NU; ++u) { const int b = pp[u] >> 5; float ca[8], chh[8];
#pragma unroll
        for (int k = 0; k < 8; ++k) { ca[k] = CS[((size_t)(((64 + b) * 8 + k) * 2 + d) * 2 + 0) * DM + cabs]; chh[k] = CS[((size_t)(((64 + b) * 8 + k) * 2 + d) * 2 + 1) * DM + cabs]; }
        float c = 0.0f;
#pragma unroll
        for (int k = 0; k < 8; ++k) { const int kk = d ? 7 - k : k; c = ca[kk] * c + chh[kk]; }
        carry[u] = c; nprev[u] = d ? (32 * b + 31 - pp[u]) : (pp[u] - 32 * b); nmax = nprev[u] > nmax ? nprev[u] : nmax; }
    for (int q0 = 0; q0 < nmax; q0 += 8) {
        float pa[NU][8], ph[NU][8];
#pragma unroll
        for (int u = 0; u < NU; ++u) { const int b = pp[u] >> 5;
#pragma unroll
            for (int q = 0; q < 8; ++q) { const int qq = (q0 + q < nprev[u]) ? q0 + q : 0; const int pq = d ? (32 * b + 31 - qq) : (32 * b + qq);
                pa[u][q] = PS[((size_t)(pq * 2 + d) * 2 + 0) * DM + cabs]; ph[u][q] = PS[((size_t)(pq * 2 + d) * 2 + 1) * DM + cabs]; } }
#pragma unroll
        for (int u = 0; u < NU; ++u)
#pragma unroll
            for (int q = 0; q < 8; ++q) if (q0 + q < nprev[u]) carry[u] = pa[u][q] * carry[u] + ph[u][q];
    }
#pragma unroll
    for (int u = 0; u < NU; ++u) { const int p = pp[u]; float cj[8];
        float c = carry[u];
#pragma unroll
        for (int j = 0; j < 8; ++j) { const int k = d ? 7 - j : j; cj[j] = c;
            if (j < 7) c = CS[((size_t)((p * 8 + k) * 2 + d) * 2 + 0) * DM + cabs] * c + CS[((size_t)((p * 8 + k) * 2 + d) * 2 + 1) * DM + cabs]; }
#pragma unroll
        for (int k = 0; k < 8; ++k) cin[u][k] = d ? cj[7 - k] : cj[k]; }
}

__device__ __forceinline__ void scan_carry4(const float* __restrict__ CS, const float* __restrict__ PS, const int (&pp)[4], int d, int cabs, float (&cin)[4][8]) {
    float carry[4] = {0.f, 0.f, 0.f, 0.f};
    float cg[2]; int n0[2], n1[2]; const float* pb[2];
    { float ca[2][8], chh[2][8];
#pragma unroll
      for (int g = 0; g < 2; ++g) { const int b = pp[2 * g] >> 5;
#pragma unroll
          for (int k = 0; k < 8; ++k) { ca[g][k] = CS[((size_t)(((64 + b) * 8 + k) * 2 + d) * 2 + 0) * DM + cabs]; chh[g][k] = CS[((size_t)(((64 + b) * 8 + k) * 2 + d) * 2 + 1) * DM + cabs]; } }
#pragma unroll
      for (int g = 0; g < 2; ++g) { const int b = pp[2 * g] >> 5; float c = 0.0f;
#pragma unroll
          for (int k = 0; k < 8; ++k) { const int kk = d ? 7 - k : k; c = ca[g][kk] * c + chh[g][kk]; }
          cg[g] = c;
          n0[g] = d ? (32 * b + 31 - pp[2 * g]) : (pp[2 * g] - 32 * b); n1[g] = d ? (32 * b + 31 - pp[2 * g + 1]) : (pp[2 * g + 1] - 32 * b);
          pb[g] = PS + ((size_t)((d ? 32 * b + 31 : 32 * b) * 2 + d) * 2) * DM + cabs; } }
    const ptrdiff_t st = d ? -(ptrdiff_t)(4 * DM) : (ptrdiff_t)(4 * DM);
#pragma unroll 1
    for (int q0 = 0; q0 < 32; q0 += 16) {
        float pa[2][16], ph[2][16];
#pragma unroll
        for (int g = 0; g < 2; ++g)
#pragma unroll
            for (int q = 0; q < 16; ++q) { const float* pq = pb[g] + (ptrdiff_t)(q0 + q) * st; pa[g][q] = pq[0]; ph[g][q] = pq[DM]; }
#pragma unroll
        for (int g = 0; g < 2; ++g)
#pragma unroll
            for (int q = 0; q < 16; ++q) { carry[2 * g] = (q0 + q == n0[g]) ? cg[g] : carry[2 * g]; carry[2 * g + 1] = (q0 + q == n1[g]) ? cg[g] : carry[2 * g + 1]; cg[g] = pa[g][q] * cg[g] + ph[g][q]; }
    }
#pragma unroll
    for (int u = 0; u < 4; ++u) { const int p = pp[u]; float cj[8];
        float c = carry[u];
#pragma unroll
        for (int j = 0; j < 8; ++j) { const int k = d ? 7 - j : j; cj[j] = c;
            if (j < 7) c = CS[((size_t)((p * 8 + k) * 2 + d) * 2 + 0) * DM + cabs] * c + CS[((size_t)((p * 8 + k) * 2 + d) * 2 + 1) * DM + cabs]; }
#pragma unroll
        for (int k = 0; k < 8; ++k) cin[u][k] = d ? cj[7 - k] : cj[k]; }
}

__device__ __forceinline__ void sa_prefetch_pair(unsigned char* ws, int p, int h, int k, int tid, int wave, int lane, v4u (&ab0)[4], v4u (&ab1)[4], v4u& g0, v4u& g1) {
    const bf16* PROJ2 = (const bf16*)(ws + WS_H);
    const int ct = tid >> 4, cc = (tid & 15) * 8;
    const unsigned* s0 = (const unsigned*)(ws + WS_ABH) + ((size_t)((p * 16 + h) * 8 + k) * 8 + wave) * (64 * 16) + lane * 4;
#pragma unroll
    for (int q = 0; q < 4; ++q) { ab0[q] = *(const v4u*)(s0 + 256 * q); ab1[q] = *(const v4u*)(s0 + 8 * 64 * 16 + 256 * q); }
    g0 = *(const v4u*)(PROJ2 + ((size_t)p * 256 + 32 * k + ct) * RGW + h * 128 + cc);
    g1 = *(const v4u*)(PROJ2 + ((size_t)p * 256 + 32 * (k + 1) + ct) * RGW + h * 128 + cc);
}

constexpr int SA_Y = 0;
static_assert(SA_Y + 2 * 4 * 32 * 128 * 4 <= RING_BYTES, "scan pass 3 LDS map");
__device__ __forceinline__ void scan_apply_unit(const Args& a, unsigned char* ws, LAS unsigned char* lds, int p, int h, int tid, int wave, int lane,
                                                float ci0, float ci1, float ci2, float ci3, float ci4, float ci5, float ci6, float ci7,
                                                v4u (&ab0)[4], v4u (&ab1)[4], v4u& g0, v4u& g1, int pnext, int hnext) {
    const float cin[8] = {ci0, ci1, ci2, ci3, ci4, ci5, ci6, ci7};
    const bf16* PROJ2 = (const bf16*)(ws + WS_H);
    bf16* MIX = (bf16*)(ws + WS_MIX);
    const int r32 = lane & 31, hi = lane >> 5;
    const int d = wave >> 2, cq = wave & 3;
    const int ct = tid >> 4, cc = (tid & 15) * 8;
    const unsigned* abase = (const unsigned*)(ws + WS_ABH) + ((size_t)((p * 16 + h) * 8) * 8 + wave) * (64 * 16) + lane * 4;
#define SA_PREFETCH(AB, GG, k) do { const unsigned* s_ = abase + (size_t)(k) * (8 * 64 * 16); \
        _Pragma("unroll") for (int q = 0; q < 4; ++q) AB[q] = *(const v4u*)(s_ + 256 * q); \
        GG = *(const v4u*)(PROJ2 + ((size_t)p * 256 + 32 * (k) + ct) * RGW + h * 128 + cc); } while (0)
#define SA_UNPACK(AB, HV, CI) do { _Pragma("unroll") for (int q = 0; q < 4; ++q) { const unsigned w[4] = {AB[q].x, AB[q].y, AB[q].z, AB[q].w}; \
        _Pragma("unroll") for (int e = 0; e < 4; ++e) { const h2_t hv2 = __builtin_bit_cast(h2_t, w[e]); HV[4 * q + e] = (float)hv2.x + (float)hv2.y * (CI); } } } while (0)
#define SA_EMIT(YB, GC, k) do { const size_t row = (size_t)p * 256 + 32 * (k) + ct; \
        const f32x4 y0 = *(const LAS f32x4*)(YB + ct * 128 + cc) + *(const LAS f32x4*)(YB + (32 + ct) * 128 + cc); \
        const f32x4 y1 = *(const LAS f32x4*)(YB + ct * 128 + cc + 4) + *(const LAS f32x4*)(YB + (32 + ct) * 128 + cc + 4); \
        v4u o; \
        o.x = cvtpk(y0.x * gelu_tanh_f(bf_lo(GC.x)), y0.y * gelu_tanh_f(bf_hi(GC.x))); o.y = cvtpk(y0.z * gelu_tanh_f(bf_lo(GC.y)), y0.w * gelu_tanh_f(bf_hi(GC.y))); \
        o.z = cvtpk(y1.x * gelu_tanh_f(bf_lo(GC.z)), y1.y * gelu_tanh_f(bf_hi(GC.z))); o.w = cvtpk(y1.z * gelu_tanh_f(bf_lo(GC.w)), y1.w * gelu_tanh_f(bf_hi(GC.w))); \
        *(v4u*)(MIX + row * DM + h * 128 + cc) = o; } while (0)
    LDS_BAR();
#pragma unroll 1
    for (int k = 0; k < 8; k += 2) {
        LAS float* Y0 = (LAS float*)(lds + SA_Y + ((k >> 1) & 1) * (4 * 32 * 128 * 4));
        LAS float* Y1 = Y0 + 2 * 32 * 128;
        const v4u gc0 = g0, gc1 = g1;
        float c0 = cin[0], c1 = cin[1];
#pragma unroll
        for (int j = 2; j < 8; j += 2) { c0 = (k == j) ? cin[j] : c0; c1 = (k == j) ? cin[j + 1] : c1; }
        float hv0[16], hv1[16];
        SA_UNPACK(ab0, hv0, c0); SA_UNPACK(ab1, hv1, c1);
        if (k + 2 < 8) { SA_PREFETCH(ab0, g0, k + 2); SA_PREFETCH(ab1, g1, k + 3); }
        else if (pnext >= 0) sa_prefetch_pair(ws, pnext, hnext, 0, tid, wave, lane, ab0, ab1, g0, g1);
#pragma unroll
        for (int r = 0; r < 16; ++r) { Y0[(d * 32 + crow(r, hi)) * 128 + 32 * cq + r32] = hv0[r]; Y1[(d * 32 + crow(r, hi)) * 128 + 32 * cq + r32] = hv1[r]; }
        LDS_BAR();
        SA_EMIT(Y0, gc0, k); SA_EMIT(Y1, gc1, k + 1);
    }
#undef SA_UNPACK
#undef SA_EMIT
#undef SA_PREFETCH
}

#ifndef MK_ONE_LAUNCH
#define MK_ONE_LAUNCH 1
#endif
constexpr int N_PHASES = 23;
#define C8(x) x[0], x[1], x[2], x[3], x[4], x[5], x[6], x[7]
#ifndef PG8_SP2
#define PG8_SP2 true
#endif
#ifndef REP_THIN
#define REP_THIN 1
#endif
#ifndef REP_UP
#define REP_UP 1
#endif
#ifndef REP_DOWN
#define REP_DOWN 1
#endif
#ifndef REP_P0
#define REP_P0 REP_THIN
#endif
#ifndef REP_NORM
#define REP_NORM REP_THIN
#endif
#ifndef REP_AT
#define REP_AT 1
#endif
#ifndef REP_CONV
#define REP_CONV 1
#endif
#ifndef REP_ATTN
#define REP_ATTN REP_THIN
#endif
#ifndef REP_SCAN
#define REP_SCAN REP_THIN
#endif
#ifndef REP_SCAN1
#define REP_SCAN1 REP_SCAN
#endif
#define RT_(n) _Pragma("unroll 1") for (int rt_ = 0; rt_ < (n); ++rt_)
#define RU_
#ifndef EXP_THR_PHASE
#define EXP_THR_PHASE -1
#endif
#ifndef EXP_CLK_PHASE
#define EXP_CLK_PHASE -1
#endif
#ifndef TLB_TOUCH_PHASE
#define TLB_TOUCH_PHASE -1
#endif
#ifndef REP_UP_PHASE
#define REP_UP_PHASE -1
#endif
#ifdef DIS_NORM
#define final_norm_phase(...) do {} while (0)
#endif
__device__ __forceinline__ void tlb_touch(const void* p, size_t bytes, int G, int bid, int tid) {
    const size_t id = (size_t)(bid >> 3) * NTHR + tid, n = (size_t)(G >> 3) * NTHR, np = bytes >> 12;
    unsigned acc = 0;
    for (size_t i = id; i < np; i += n) acc += __builtin_nontemporal_load((const unsigned*)((const char*)p + (i << 12)));
    asm volatile("" :: "v"(acc));
}
template <class Epi, class Sched> __device__ __forceinline__ void run_gemm(LAS unsigned char* lds, const bf16* A, const bf16* Bt, int M, int N, int K, int G, int bid, const Epi& E, int slow = -1) {
    pg8::Gemm g{A, Bt, K, 128, 128}; Sched S; S.init(G, bid, slow); pg8::gemm_phase<Epi, Sched, true, PG8_SP2>(lds, g, S, E);
}
template <class Epi, class Sched> __device__ __forceinline__ void run_gemm_kt(LAS unsigned char* lds, const bf16* A, const bf16* Bt, int M, int N, int G, int bid, const Epi& E, int slow = -1, int thr = 0) {
    pg8::Gemm g{A, Bt, 0, (size_t)M * 128, (size_t)N * 128, thr}; Sched S; S.init(G, bid, slow); pg8::gemm_phase<Epi, Sched, true, PG8_SP2>(lds, g, S, E);
}
__global__ void __launch_bounds__(NTHR, 2) fwd_kernel(Args args) {
    extern __shared__ __attribute__((aligned(16))) unsigned char lds_raw[];
    LAS unsigned char* lds = (LAS unsigned char*)lds_raw;
    volatile LAS unsigned* MISC = (volatile LAS unsigned*)(lds + MISC_OFF);
    const int tid = threadIdx.x, lane = tid & 63, wave = __builtin_amdgcn_readfirstlane(tid >> 6);
    const int G = gridDim.x, bid = blockIdx.x;
    unsigned char* ws = args.ws;
    for (int u = tid; u < (LDS_BYTES - LDSCTL_OFF) / 4; u += NTHR) ((LAS unsigned*)(lds + LDSCTL_OFF))[u] = 0u;
    __syncthreads();
    const int lo = args.ph_lo, hi = args.ph_hi;
    XcdBarrier bar; bar.bar = (unsigned*)(ws + WS_CTL) + CW_BAR; bar.x = 0; bar.st = nullptr;
    if (hi - lo > 1) bar = xcd_barrier_post((unsigned*)(ws + WS_CTL) + CW_BAR, MISC + 8);
#define IN(k) (lo <= (k) && (k) < hi)
#ifndef REP_BAR
#define REP_BAR 1
#endif
#if defined(PROBE_WAIT)
#ifndef PROBE_GRP
#define PROBE_GRP 0
#endif
#ifndef PROBE_PHASE
#define PROBE_PHASE 1000
#endif
#ifndef PROBE_CUM
#define PROBE_CUM 0
#endif
#ifndef PROBE_BASE
#define PROBE_BASE 0
#endif
#ifndef PROBE_SCALE
#define PROBE_SCALE 0.1f
#endif
#define SEAM(k) do { if (IN(k) && IN((k) + 1)) { if ((k) == 2) CALIBRATE_ARRIVE(); const unsigned long long t0_ = __builtin_amdgcn_s_memrealtime(); xcd_barrier(bar); \
        if (tid == 0 && ((PROBE_WAIT >> (k)) & 1)) { const unsigned long long dt_ = __builtin_amdgcn_s_memrealtime() - t0_; atomicAdd((unsigned long long*)(ws + WS_CTL) + 4000, dt_); \
            atomicAdd((unsigned long long*)(ws + WS_CTL) + 4010 + 2 * (PROBE_GRP ? (bid & 7) : xb_xcc_id()), dt_); atomicAdd((unsigned long long*)(ws + WS_CTL) + 4011 + 2 * (PROBE_GRP ? (bid & 7) : xb_xcc_id()), 1ull); } if ((k) == 2) CALIBRATE_DECIDE(); \
        if (bid == 0 && tid == 0) { if ((k) == PROBE_PHASE - 1 && !PROBE_CUM) *((unsigned long long*)(ws + WS_CTL) + 4100) = __builtin_amdgcn_s_memrealtime(); if ((k) == PROBE_PHASE) *((unsigned long long*)(ws + WS_CTL) + 4101) = __builtin_amdgcn_s_memrealtime(); } } } while (0)
#else
#define SEAM(k) do { if (IN(k) && IN((k) + 1)) { if ((k) == 2) CALIBRATE_ARRIVE(); _Pragma("unroll 1") for (int rb_ = 0; rb_ < REP_BAR; ++rb_) xcd_barrier(bar); if ((k) == 2) CALIBRATE_DECIDE(); } } while (0)
#endif
#if !defined(USE_ADAPT)
#define NO_ADAPT_HOOK slow = -1;
#else
#define NO_ADAPT_HOOK
#endif
#if defined(USE_ADAPT)
#define CALIBRATE_ARRIVE() do { if (G == 256 && tid == 0) __hip_atomic_store((unsigned long long*)(ws + WS_CTL) + 8192 + bid, (unsigned long long)__builtin_amdgcn_s_memrealtime(), __ATOMIC_RELAXED, __HIP_MEMORY_SCOPE_AGENT); } while (0)
#define CALIBRATE_DECIDE() do { if (G == 256) { if (wave == 0) { const unsigned long long* T_ = (const unsigned long long*)(ws + WS_CTL) + 8192; const unsigned long long b_ = T_[0]; \
            long long v_ = (long long)(T_[lane] - b_) + (long long)(T_[lane + 64] - b_) + (long long)(T_[lane + 128] - b_) + (long long)(T_[lane + 192] - b_); \
            v_ += __shfl_xor(v_, 8); v_ += __shfl_xor(v_, 16); v_ += __shfl_xor(v_, 32); int i_ = lane & 7; \
            _Pragma("unroll") for (int o_ = 1; o_ < 8; o_ <<= 1) { const long long ov_ = __shfl_xor(v_, o_); const int oi_ = __shfl_xor(i_, o_); if (ov_ > v_ || (ov_ == v_ && oi_ < i_)) { v_ = ov_; i_ = oi_; } } \
            const long long tot_ = v_  ; long long all_ = (long long)(T_[lane] - b_) + (long long)(T_[lane + 64] - b_) + (long long)(T_[lane + 128] - b_) + (long long)(T_[lane + 192] - b_); \
            all_ += __shfl_xor(all_, 1); all_ += __shfl_xor(all_, 2); all_ += __shfl_xor(all_, 4); all_ += __shfl_xor(all_, 8); all_ += __shfl_xor(all_, 16); all_ += __shfl_xor(all_, 32); \
              \
            const bool sig_ = (tot_ * 7 - (all_ - tot_)) > 800LL * 224; \
            if (lane == 0) MISC[16] = sig_ ? (unsigned)(i_ + 1) : 0u; } \
        __syncthreads(); slow = __builtin_amdgcn_readfirstlane((int)MISC[16]) - 1; __syncthreads(); NO_ADAPT_HOOK } } while (0)
#else
#define CALIBRATE_ARRIVE() do {} while (0)
#define CALIBRATE_DECIDE() do {} while (0)
#endif
    const int gw = bid * NWAVES + wave, ngw = G * NWAVES, gwalt = wave * G + bid;
    float* MOD = (float*)(ws + WS_MOD);
    bf16* X = (bf16*)(ws + WS_X);
    bf16* XN = (bf16*)(ws + WS_XN);
    bf16* HB = (bf16*)(ws + WS_H);
    bf16* MIX = (bf16*)(ws + WS_MIX);
    float* SLAB = (float*)(ws + WS_SLAB);

#if defined(PROBE_WAIT)
    if ((PROBE_PHASE == 0 || PROBE_PHASE == 23 || PROBE_CUM) && bid == 0 && tid == 0) *((unsigned long long*)(ws + WS_CTL) + 4100) = __builtin_amdgcn_s_memrealtime();
#if defined(EXP_SLEEP_US)
    { const unsigned long long t0_ = __builtin_amdgcn_s_memrealtime(); while (__builtin_amdgcn_s_memrealtime() - t0_ < (unsigned long long)(EXP_SLEEP_US) * 100ull) __builtin_amdgcn_s_sleep(100); }
#endif
#if defined(EXP_STREAM_US)
    { const unsigned long long t0_ = __builtin_amdgcn_s_memrealtime(); unsigned sacc_ = 0; size_t so_ = ((size_t)bid * NTHR + tid) * 16;
      while (__builtin_amdgcn_s_memrealtime() - t0_ < (unsigned long long)(EXP_STREAM_US) * 100ull) {
#pragma unroll
          for (int i = 0; i < 8; ++i) { const v4u v_ = __builtin_nontemporal_load((const v4u*)(ws + WS_H + so_)); sacc_ += v_.x ^ v_.w; so_ += (size_t)G * NTHR * 16; if (so_ >= (size_t)512 * MiB) so_ -= (size_t)512 * MiB; } }
      asm volatile("" :: "v"(sacc_)); }
#endif
#if defined(EXP_HEAT_US)
    { const unsigned long long t0_ = __builtin_amdgcn_s_memrealtime(); f32x16 hacc_; for (int r = 0; r < 16; ++r) hacc_[r] = 0.f;
      v4u ha_ = {0x3f803f80u + tid * 0x10001u, 0xbf80bf80u ^ (tid * 77u), 0x3e803e80u + lane, 0xbe80be80u}, hb_ = {0x3f003f00u + lane * 3u, 0xbf00bf00u, 0x3f803f80u ^ tid, 0x3e003e00u};
      while (__builtin_amdgcn_s_memrealtime() - t0_ < (unsigned long long)(EXP_HEAT_US) * 100ull) {
#pragma unroll
          for (int i = 0; i < 32; ++i) hacc_ = __builtin_amdgcn_mfma_f32_32x32x16_bf16(__builtin_bit_cast(bf16x8, ha_), __builtin_bit_cast(bf16x8, hb_), hacc_, 0, 0, 0); }
      if (hacc_[0] == 12345.678f && hacc_[5] == 3.0f) args.out[1] = hacc_[0]; }
#endif
#if defined(PROBE_WARM)
    unsigned warm_ = 0; if (bid == 0 && tid == 0) warm_ = __hip_atomic_load((unsigned*)(ws + WS_ROPE + 262144), __ATOMIC_RELAXED, __HIP_MEMORY_SCOPE_AGENT);
#endif
#endif
    int slow = -1;
#ifndef DIS_P0
    if (IN(0)) RT_(REP_P0) { p0_prologue(args, ws, lds, G, bid, tid, wave, lane); }
#endif
    SEAM(0);

#define FILL_TAIL(nbusy, a0, a1, b0, b1) do { const int rk_ = pg8::xrank(bid, slow);     \
        if (rk_ >= (nbusy) && rk_ < 0x3fffffff) convert_ranges(args, ws, lds, a0, a1, b0, b1, (rk_ - (nbusy)) * NWAVES + wave, ((slow < 0 ? G : G - G / 8) - (nbusy)) * NWAVES, wave, lane); } while (0)
#define FFN_BLOCK(MP, s, base, nslab_in, FILL) do { \
        const int l_ = (s) >> 1, which_ = (s) & 1; \
        const float* modl_ = MOD + (size_t)l_ * 3 * MODW; \
        if (IN(base)) RT_(REP_NORM) { const float* g_ = (which_ ? args.in[I_NF2] : args.in[I_NF1]) + (size_t)l_ * DM; \
            if ((s) == 0) norm_phase<true, true>(args.in[I_X], args.in[I_CTX], (MP) * 256, g_, modl_ + (which_ ? 6 : 0) * DM, modl_ + (which_ ? 7 : 1) * DM, XN, gw, ngw, lane, gwalt, SLAB, nslab_in, X + (size_t)NLAT * DM, lds); \
            else norm_phase<false, false>(X, X + (size_t)NLAT * DM, (MP) * 256, g_, modl_ + (which_ ? 6 : 0) * DM, modl_ + (which_ ? 7 : 1) * DM, XN, gw, ngw, lane, gwalt, SLAB, nslab_in, X + (size_t)NLAT * DM, lds); } \
        SEAM(base); \
        if (IN((base) + 1)) RU_ { pg8::EpiSwiGLU E_{HB, MROWS}; \
            if (EXP_CLK_PHASE == (base) + 1) { const unsigned long long t0_ = __builtin_amdgcn_s_memrealtime(); f32x16 hacc_; for (int r = 0; r < 16; ++r) hacc_[r] = 0.f; \
                v4u ha_ = {0x3f803f80u + tid * 0x10001u, 0xbf80bf80u ^ (tid * 77u), 0x3e803e80u + lane, 0xbe80be80u}, hb_ = {0x3f003f00u + lane * 3u, 0xbf00bf00u, 0x3f803f80u ^ tid, 0x3e003e00u}; \
                _Pragma("unroll 1") for (int i_ = 0; i_ < 100; ++i_) { _Pragma("unroll") for (int j_ = 0; j_ < 32; ++j_) hacc_ = __builtin_amdgcn_mfma_f32_32x32x16_bf16(__builtin_bit_cast(bf16x8, ha_), __builtin_bit_cast(bf16x8, hb_), hacc_, 0, 0, 0); } \
                if (hacc_[0] == 12345.678f && hacc_[5] == 3.0f) args.out[1] = hacc_[0]; \
                if (bid == 0 && tid == 0) *((unsigned long long*)(ws + WS_CTL) + 4102) = __builtin_amdgcn_s_memrealtime() - t0_; } \
            if (TLB_TOUCH_PHASE == (base) + 1 || TLB_TOUCH_PHASE == -2) { tlb_touch(ws + WS_WIN + (size_t)(s) * WIN_BYTES, WIN_BYTES, G, bid, tid); tlb_touch(XN, (size_t)MROWS * DM * 2, G, bid, tid); tlb_touch(HB, (size_t)MROWS * DFF * 2, G, bid, tid); } \
            run_gemm_kt<pg8::EpiSwiGLU, pg8::StaticOrderC<MP, 44, 32>>(lds + RING_OFF, XN, (const bf16*)(ws + WS_WIN + (size_t)(s) * WIN_BYTES), MROWS, 2 * DFF, G, bid, E_, slow, ((base) + 1 == EXP_THR_PHASE) ? 1 : 0); \
            if (REP_UP > 1 && (REP_UP_PHASE < 0 || (base) + 1 == REP_UP_PHASE)) run_gemm_kt<pg8::EpiSwiGLU, pg8::StaticOrderC<MP, 44, 32>>(lds + RING_OFF, XN, (const bf16*)(ws + WS_WIN + (size_t)(s) * WIN_BYTES), MROWS, 2 * DFF, G, bid, E_, slow); \
            FILL; } \
        SEAM((base) + 1); \
        if (IN((base) + 2)) { pg8::EpiResid E_{((s) == 0) ? args.in[I_X] : nullptr, ((s) == 0) ? args.in[I_CTX] : nullptr, X, modl_ + (which_ ? 8 : 2) * DM, MODW, 0.5f, SLAB}; \
            if ((MP) == 66) run_gemm_kt<pg8::EpiResid, pg8::SplitCtxOrder<8, 88>>(lds + RING_OFF, HB, (const bf16*)(ws + WS_WOUT + (size_t)(s) * WOUT_BYTES), MROWS, DM, G, bid, E_, slow); \
            else run_gemm_kt<pg8::EpiResid, pg8::StaticOrderC<64, 8, 88, 4>>(lds + RING_OFF, HB, (const bf16*)(ws + WS_WOUT + (size_t)(s) * WOUT_BYTES), MROWS, DM, G, bid, E_, slow); \
            if (REP_DOWN == 2) { pg8::EpiResid E2_{nullptr, nullptr, X, modl_ + (which_ ? 8 : 2) * DM, MODW, 0.0f, SLAB}; \
                run_gemm_kt<pg8::EpiResid, pg8::StaticOrderC<64, 8, 88, 4>>(lds + RING_OFF, HB, (const bf16*)(ws + WS_WOUT + (size_t)(s) * WOUT_BYTES), MROWS, DM, G, bid, E2_, slow); } \
            if (REP_DOWN == 3) { pg8::EpiNull E3_{}; \
                run_gemm_kt<pg8::EpiNull, pg8::StaticOrderC<64, 8, 88, 4>>(lds + RING_OFF, HB, (const bf16*)(ws + WS_WOUT + (size_t)(s) * WOUT_BYTES), MROWS, DM, G, bid, E3_, slow); } } \
        SEAM((base) + 2); \
    } while (0)

    FFN_BLOCK(66, 0, 1, 0, do { FILL_TAIL(88, TL_WOUT, TL_WOUT + T_WOUT, TL_ABIN, TL_ABOUT + T_SQ); __syncthreads(); if (bid >= 88) mod_gemv_tasks(args, ws, lds, 144, 288, bid - 88, G - 88, tid, wave, lane); } while (0));
    { const float* modl = MOD;
            if (IN(4)) RT_(REP_NORM) norm_phase<false, true>(X, args.in[I_CTX], MROWS, args.in[I_NMIX], modl + 3 * DM, modl + 4 * DM, XN, gw, ngw, lane, gwalt, SLAB, 11, X + (size_t)NLAT * DM, lds);
            SEAM(4);
            if (IN(5)) RU_ { pg8::EpiBf16 E{HB, ABW};
                run_gemm_kt<pg8::EpiBf16, pg8::StaticOrderC<66, 18, 32>>(lds + RING_OFF, XN, (const bf16*)(ws + WS_WABIN), MROWS, ABW, G, bid, E, slow);
                if (REP_UP > 1) run_gemm_kt<pg8::EpiBf16, pg8::StaticOrderC<66, 18, 32>>(lds + RING_OFF, XN, (const bf16*)(ws + WS_WABIN), MROWS, ABW, G, bid, E, slow);
                FILL_TAIL(164, TL_WIN + T_WIN, TL_WIN + 2 * T_WIN, 0, 0); }
            SEAM(5);
            if (IN(6)) RT_(REP_ATTN) {
                const float* ropeC = (const float*)(ws + WS_ROPE); const float* ropeS = ropeC + 4096;
#ifndef DIS_ATTN
                RT_(REP_AT) for (int u = bid; u < 528; u += G) attn_unit(HB, MIX, args.in[I_SINK], ropeC, ropeS, lds, u, tid, wave, lane);
#endif
                RT_(REP_CONV) { if (G > 32) { if (bid >= 16) sconv_strips(HB, MIX, args.in[I_ABCONV], (bid - 16) * NTHR + tid, (G - 16) * NTHR); }
                else sconv_strips(HB, MIX, args.in[I_ABCONV], bid * NTHR + tid, G * NTHR); }
            }
            SEAM(6);
            if (IN(7)) { pg8::EpiResid E{nullptr, nullptr, X, modl + 5 * DM, MODW, 1.0f, SLAB};
                run_gemm<pg8::EpiResid, pg8::SplitCtxOrder<8, 32>>(lds + RING_OFF, MIX, (const bf16*)(ws + WS_WABOUT), MROWS, DM, DM, G, bid, E, slow); }
            SEAM(7);
    }
    FFN_BLOCK(66, 1, 8, 8, FILL_TAIL(88, TL_WOUT + T_WOUT, TL_WOUT + 2 * T_WOUT, TL_WIN + 2 * T_WIN, TL_WIN + 3 * T_WIN));
    FFN_BLOCK(66, 2, 11, 11, FILL_TAIL(88, TL_WOUT + 2 * T_WOUT, TL_WOUT + 3 * T_WOUT, TL_RGIN, T_TOTAL));
    { const float* modl = MOD + (size_t)3 * MODW;
            if (IN(14)) RT_(REP_NORM) norm_phase<false, false>(X, X + (size_t)NLAT * DM, MROWS, args.in[I_NMIX] + DM, modl + 3 * DM, modl + 4 * DM, XN, gw, ngw, lane, gwalt, SLAB, 11, X + (size_t)NLAT * DM, lds);
            SEAM(14);
            if (IN(15)) RU_ { pg8::EpiBf16 E{HB, RGW};
                run_gemm_kt<pg8::EpiBf16, pg8::StaticOrderC<66, 16, 32>>(lds + RING_OFF, XN, (const bf16*)(ws + WS_WRGIN), MROWS, RGW, G, bid, E, slow);
                if (REP_UP > 1) run_gemm_kt<pg8::EpiBf16, pg8::StaticOrderC<66, 16, 32>>(lds + RING_OFF, XN, (const bf16*)(ws + WS_WRGIN), MROWS, RGW, G, bid, E, slow);
                FILL_TAIL(32, TL_WIN + 3 * T_WIN, TL_WIN + 4 * T_WIN, TL_WOUT + 3 * T_WOUT, TL_WOUT + 4 * T_WOUT); }
            SEAM(15);
#ifndef DIS_SCAN
            if (IN(16)) RT_(REP_SCAN1) { for (int u = bid; u < 64 * 16 + 128; u += G) { if (u < 1024) scan_unit<false>(args, ws, lds, u >> 4, u & 15, tid, wave, lane);
                    else { const int v = u - 1024; scan_unit<false>(args, ws, lds, 64 + (v >> 6), (v >> 2) & 15, tid, wave, lane, 2 * (v & 3), 2 * (v & 3) + 2); } } }
            SEAM(16);
            if (IN(17)) RT_(REP_SCAN) { { const float* CSp = (const float*)(ws + WS_CS); const float* PSp = (const float*)(ws + WS_PS);
                    const int sd_ = wave >> 2, scabs_ = 32 * (wave & 3) + (lane & 31);
                    if (G == 256) {
                        const int hh = bid & 15; const int pp[4] = {bid >> 4, (bid >> 4) + 16, (bid >> 4) + 32, (bid >> 4) + 48}; float cin4[4][8];
                        v4u ab0_[4], ab1_[4], g0_, g1_; sa_prefetch_pair(ws, pp[0], hh, 0, tid, wave, lane, ab0_, ab1_, g0_, g1_);
                        scan_carry4(CSp, PSp, pp, sd_, hh * 128 + scabs_, cin4);
                        scan_apply_unit(args, ws, lds, pp[0], hh, tid, wave, lane, C8(cin4[0]), ab0_, ab1_, g0_, g1_, pp[1], hh); scan_apply_unit(args, ws, lds, pp[1], hh, tid, wave, lane, C8(cin4[1]), ab0_, ab1_, g0_, g1_, pp[2], hh);
                        scan_apply_unit(args, ws, lds, pp[2], hh, tid, wave, lane, C8(cin4[2]), ab0_, ab1_, g0_, g1_, pp[3], hh); scan_apply_unit(args, ws, lds, pp[3], hh, tid, wave, lane, C8(cin4[3]), ab0_, ab1_, g0_, g1_, -1, 0);
                    } else for (int u = bid; u < 64 * 16; u += G) { const int pp[1] = {u >> 4}; float cin1[1][8]; scan_carry<1>(CSp, PSp, pp, sd_, (u & 15) * 128 + scabs_, cin1);
                        v4u ab0_[4], ab1_[4], g0_, g1_; sa_prefetch_pair(ws, u >> 4, u & 15, 0, tid, wave, lane, ab0_, ab1_, g0_, g1_);
                        scan_apply_unit(args, ws, lds, u >> 4, u & 15, tid, wave, lane, C8(cin1[0]), ab0_, ab1_, g0_, g1_, -1, 0); } } }
#endif
            SEAM(17);
            if (IN(18)) { pg8::EpiResid E{nullptr, nullptr, X, modl + 5 * DM, MODW, 1.0f, SLAB};
                run_gemm<pg8::EpiResid, pg8::StaticOrderC<64, 8, 32>>(lds + RING_OFF, MIX, (const bf16*)(ws + WS_WRGOUT), NLAT, DM, DM, G, bid, E, slow); }
            SEAM(18);
    }
    FFN_BLOCK(64, 3, 19, 0, (void)0);
    if (IN(22)) RT_(REP_NORM) final_norm_phase(X, args.in[I_FNORM], args.out, gw, ngw, lane);
#if defined(PROBE_WAIT)
    if (bid == 0 && tid == 0) { __threadfence(); const unsigned long long tw = __hip_atomic_load((unsigned long long*)(ws + WS_CTL) + 4000, __ATOMIC_RELAXED, __HIP_MEMORY_SCOPE_AGENT);
        asm volatile("s_waitcnt vmcnt(0)" ::: "memory");
#if defined(PROBE_RATE)
        args.out[0] += (float)*((int*)(ws + WS_CTL + 8 * 4200)) * 1e-5f;
#elif defined(PROBE_WARM)
        { const bool w_ = warm_ == 0x600DF00Du; __hip_atomic_store((unsigned*)(ws + WS_ROPE + 262144), 0x600DF00Du, __ATOMIC_RELAXED, __HIP_MEMORY_SCOPE_AGENT);
          const unsigned long long p0_ = *((unsigned long long*)(ws + WS_CTL) + 4100), p1_ = (PROBE_PHASE >= 22) ? __builtin_amdgcn_s_memrealtime() : *((unsigned long long*)(ws + WS_CTL) + 4101); const float us_ = (float)(p1_ - p0_) * 0.01f;
          if (PROBE_WARM == 5 || PROBE_WARM == 6) { float* cs_ = (float*)(ws + WS_ROPE + 262144 + 64); const float c_ = (float)*((unsigned long long*)(ws + WS_CTL) + 4102) * 0.01f;
              if (!w_) *cs_ = c_; args.out[0] += ((PROBE_WARM == 5 ? *cs_ : c_) - (float)PROBE_BASE) * PROBE_SCALE; } else
          if (PROBE_WARM == 4) { float* cs_ = (float*)(ws + WS_ROPE + 262144 + 64); if (!w_) *cs_ = us_; args.out[0] += (*cs_ - (float)PROBE_BASE) * PROBE_SCALE; } else
          args.out[0] += PROBE_WARM == 1 ? (w_ ? 3.0f : 0.0f) : PROBE_WARM == 2 ? (w_ ? (us_ - (float)PROBE_BASE) * PROBE_SCALE : 0.0f) : (w_ ? 0.0f : (us_ - (float)PROBE_BASE) * PROBE_SCALE); }
#elif PROBE_PHASE < 1000
        { const unsigned long long p0_ = *((unsigned long long*)(ws + WS_CTL) + 4100), p1_ = (PROBE_PHASE >= 22) ? __builtin_amdgcn_s_memrealtime() : *((unsigned long long*)(ws + WS_CTL) + 4101); args.out[0] += ((float)(p1_ - p0_) * 0.01f - (float)PROBE_BASE) * PROBE_SCALE; }
#elif !defined(PROBE_XCD)
        args.out[0] += (float)tw * (0.01f / 256.0f) * 0.01f;
#else
        float mx = 0.f, mn = 1e30f;
        for (int x = 0; x < 8; ++x) { const unsigned long long s = __hip_atomic_load((unsigned long long*)(ws + WS_CTL) + 4010 + 2 * x, __ATOMIC_RELAXED, __HIP_MEMORY_SCOPE_AGENT), n = __hip_atomic_load((unsigned long long*)(ws + WS_CTL) + 4011 + 2 * x, __ATOMIC_RELAXED, __HIP_MEMORY_SCOPE_AGENT);
            if (n) { const float av = (float)s / (float)n * 0.01f; mx = fmaxf(mx, av); mn = fminf(mn, av); } }
        int imn = 0; { float best = 1e30f; for (int x = 0; x < 8; ++x) { const unsigned long long s = __hip_atomic_load((unsigned long long*)(ws + WS_CTL) + 4010 + 2 * x, __ATOMIC_RELAXED, __HIP_MEMORY_SCOPE_AGENT), n = __hip_atomic_load((unsigned long long*)(ws + WS_CTL) + 4011 + 2 * x, __ATOMIC_RELAXED, __HIP_MEMORY_SCOPE_AGENT); if (n && (float)s / (float)n < best) { best = (float)s / (float)n; imn = x; } } }
        args.out[0] += (PROBE_XCD == 1 ? mx * 0.01f : (PROBE_XCD == 2 ? mn * 0.01f : (float)(imn + 1)));
#endif
        }
#endif
#undef IN
#undef SEAM
}

extern "C" void kernel_launch(void* const* d_in, const int* in_sizes, int n_in, void* d_out, int out_size, void* d_ws, size_t ws_size, hipStream_t stream) {
    static int grid = 0;
    if (grid == 0) {
        if (n_in != N_IN || in_sizes[0] != NLAT * DM || out_size != NLAT * DM || ws_size < WS_END) { fprintf(stderr, "kernel_launch: unexpected shapes (n_in %d, ws %zu)\n", n_in, ws_size); grid = -1; return; }
        int dev = 0, cus = 0, per_cu = 0;
        if (hipGetDevice(&dev) != hipSuccess || hipDeviceGetAttribute(&cus, hipDeviceAttributeMultiprocessorCount, dev) != hipSuccess) { grid = -1; return; }
        if (hipFuncSetAttribute((const void*)fwd_kernel, hipFuncAttributeMaxDynamicSharedMemorySize, LDS_BYTES) != hipSuccess) { fprintf(stderr, "kernel_launch: hipFuncSetAttribute failed\n"); grid = -1; return; }
        if (hipOccupancyMaxActiveBlocksPerMultiprocessor(&per_cu, (const void*)fwd_kernel, NTHR, LDS_BYTES) != hipSuccess || per_cu < 1) fprintf(stderr, "kernel_launch: occupancy query reports %d\n", per_cu);
        (void)hipGetLastError();
        grid = cus;
    }
    if (grid < 0) return;
    if (hipMemsetAsync((char*)d_ws + WS_CTL, 0, CTL_ZERO_BYTES, stream) != hipSuccess) return;
#if defined(PROBE_RATE)
    { int dev_ = 0, khz_ = 0; (void)hipGetDevice(&dev_); (void)hipDeviceGetAttribute(&khz_, hipDeviceAttributeWallClockRate, dev_);
      (void)hipMemsetD32Async((hipDeviceptr_t)((char*)d_ws + WS_CTL + 8 * 4200), khz_, 1, stream); }
#endif
    Args a{};
    for (int i = 0; i < N_IN; ++i) a.in[i] = (const float*)d_in[i];
    a.out = (float*)d_out; a.ws = (unsigned char*)d_ws;
#if MK_ONE_LAUNCH
    a.ph_lo = 0; a.ph_hi = N_PHASES;
    hipLaunchKernelGGL(fwd_kernel, dim3(grid), dim3(NTHR), LDS_BYTES, stream, a);
#else
    for (int p = 0; p < N_PHASES; ++p) { a.ph_lo = p; a.ph_hi = p + 1; hipLaunchKernelGGL(fwd_kernel, dim3(grid), dim3(NTHR), LDS_BYTES, stream, a); }
#endif
}
```
